# Optimizing an MI355X kernel written in HIP

```python
import math
import jax, jax.numpy as jnp
from jax import lax
import numpy as np

D_MODEL = 1024
BATCH = 8
SEQ = 2048
DEPTH = 4

ATTN_WIDTH = D_MODEL // 2
HEAD_DIM = 64
ATTN_HEADS = ATTN_WIDTH // HEAD_DIM
DILATED_PAIRS = ((128, 1), (512, 4), (2048, 16))
SSM_WIDTH = D_MODEL - ATTN_WIDTH
SSM_GROUP_CH = 16
SSM_GROUPS = SSM_WIDTH // SSM_GROUP_CH
SSM_STATE = 64
IN_WIDTH = 3 * ATTN_WIDTH + SSM_WIDTH
MOE_GROUPS = 4
EXPERTS_PER_GROUP = 4
N_EXPERTS = MOE_GROUPS * EXPERTS_PER_GROUP
EXPERT_FF = D_MODEL // 4
TOP_K_INNER = 2
RMS_EPS = 1e-6
DT_MIN = 1e-3
DT_MAX = 1e-1

kernel_name = "hymba_s5_dilated_hmoe_trunk"


def rmsnorm(x, g):
    xf = x.astype(jnp.float32)
    y = xf * lax.rsqrt(jnp.mean(xf * xf, axis=-1, keepdims=True) + RMS_EPS)
    return (y * g.astype(jnp.float32)).astype(x.dtype)


def dilated_branch(q, k, v, dil, span):
    B, S, H, Dh = q.shape
    M = S // dil
    nb = -(-M // span)
    Mp = nb * span

    def blocks(a):
        a = a.reshape(B, M, dil, H, Dh)
        a = jnp.pad(a, ((0, 0), (0, Mp - M), (0, 0), (0, 0), (0, 0)))
        return a.reshape(B, nb, span, dil, H, Dh)

    def with_prev(a):
        prev = jnp.pad(a, ((0, 0), (1, 0), (0, 0), (0, 0), (0, 0), (0, 0)))[:, :-1]
        return jnp.concatenate([prev, a], axis=2)

    qb = blocks(q)
    kk = with_prev(blocks(k))
    vv = with_prev(blocks(v))
    s = jnp.einsum('bnqrhc,bnkrhc->bnrhqk', qb.astype(jnp.float32), kk.astype(jnp.float32))
    s = s * (1.0 / math.sqrt(Dh))
    qpos = jnp.arange(span)[:, None]
    kpos = jnp.arange(2 * span)[None, :]
    dist = span + qpos - kpos
    band = (dist >= 0) & (dist <= span)
    not_first = (jnp.arange(nb) > 0)[:, None, None] | (kpos >= span)[None]
    valid = band[None] & not_first
    s = jnp.where(valid[None, :, None, None], s, -jnp.inf)
    mx = jnp.max(s, axis=-1, keepdims=True)
    p = jnp.exp(s - mx)
    den = jnp.sum(p, axis=-1)
    o = jnp.einsum('bnrhqk,bnkrhc->bnqrhc', p, vv.astype(jnp.float32))
    o = o / jnp.transpose(den, (0, 1, 4, 2, 3))[..., None]
    lse = jnp.transpose(mx[..., 0] + jnp.log(den), (0, 1, 4, 2, 3))
    o = o.reshape(B, Mp, dil, H, Dh)[:, :M].reshape(B, S, H, Dh)
    lse = lse.reshape(B, Mp, dil, H)[:, :M].reshape(B, S, H)
    return o, lse


def dilated_attention(q, k, v):
    B, S, H, Dh = q.shape
    outs, lses = [], []
    for window, dil in DILATED_PAIRS:
        o, lse = dilated_branch(q, k, v, dil, window // dil)
        outs.append(o)
        lses.append(lse)
    w = jax.nn.softmax(jnp.stack(lses, axis=0), axis=0)
    o = jnp.sum(w[..., None] * jnp.stack(outs, axis=0), axis=0)
    return o.reshape(B, S, H * Dh).astype(q.dtype)


def s5_mixer(u, lam_re, lam_im, log_dt, b_re, b_im, c_re, c_im, d_skip, w_glu):
    B, S, _ = u.shape
    f32 = jnp.float32
    uf = u.astype(f32).reshape(B, S, SSM_GROUPS, SSM_GROUP_CH)
    lam = lax.complex(lam_re.astype(f32), lam_im.astype(f32))
    dt = jnp.exp(log_dt.astype(f32))[:, None]
    lam_bar = jnp.exp(lam * dt)
    b_t = lax.complex(b_re.astype(f32), b_im.astype(f32))
    b_bar = ((lam_bar - 1.0) / lam)[..., None] * b_t
    c_t = lax.complex(c_re.astype(f32), c_im.astype(f32))
    bu = jnp.einsum('gph,bsgh->sbgp', b_bar, uf.astype(jnp.complex64))
    a = jnp.broadcast_to(lam_bar[None, None], (S, 1) + lam_bar.shape)

    def combine(left, right):
        a_l, b_l = left
        a_r, b_r = right
        return a_r * a_l, a_r * b_l + b_r

    _, states = lax.associative_scan(combine, (a, bu), axis=0)
    y = jnp.einsum('ghp,sbgp->bsgh', c_t, states).real + d_skip.astype(f32) * uf
    y = jax.nn.gelu(y.reshape(B, S, SSM_WIDTH))
    y = y * jax.nn.sigmoid(y @ w_glu.astype(f32))
    return y.astype(u.dtype)


def hier_moe(h, w_rg, b_rg, w_re, b_re_, w_gate, w_up, w_down):
    B, S, D = h.shape
    t = h.reshape(-1, D)
    grp_prob = jax.nn.softmax((t @ w_rg + b_rg).astype(jnp.float32), axis=-1)
    grp = jnp.argmax(grp_prob, axis=-1)
    g1 = jnp.take_along_axis(grp_prob, grp[:, None], axis=-1)
    exp_logits = (jnp.einsum('td,gde->tge', t, w_re) + b_re_).astype(jnp.float32)
    sel = jnp.take_along_axis(exp_logits, grp[:, None, None], axis=1)[:, 0]
    top_v, top_i = lax.top_k(sel, TOP_K_INNER)
    w2 = jax.nn.softmax(top_v, axis=-1) * g1
    expert_idx = grp[:, None] * EXPERTS_PER_GROUP + top_i
    gates = jnp.sum(jax.nn.one_hot(expert_idx, N_EXPERTS, dtype=jnp.float32) * w2[..., None], axis=1)
    hg = jnp.einsum('td,edf->tef', t, w_gate)
    hu = jnp.einsum('td,edf->tef', t, w_up)
    act = jax.nn.silu(hg) * hu * gates.astype(t.dtype)[..., None]
    out = jnp.einsum('tef,efd->td', act, w_down)
    return out.reshape(B, S, D)


def setup_inputs(seed: int = 0) -> dict:
    key = jax.random.key(seed)
    ks = jax.random.split(key, 24)
    nrm = jax.random.normal
    L, D = DEPTH, D_MODEL
    G, P, H = SSM_GROUPS, SSM_STATE, SSM_GROUP_CH
    return {
        "x": nrm(ks[0], (BATCH, SEQ, D), jnp.float32),
        "ln1_g": 1.0 + 0.02 * nrm(ks[1], (L, D), jnp.float32),
        "w_in": nrm(ks[2], (L, D, IN_WIDTH), jnp.float32) * D ** -0.5,
        "lam_re": -0.5 + 0.01 * nrm(ks[3], (L, G, P), jnp.float32),
        "lam_im": jnp.pi * jnp.arange(P, dtype=jnp.float32) + 0.01 * nrm(ks[4], (L, G, P), jnp.float32),
        "log_dt": jax.random.uniform(ks[5], (L, G), jnp.float32, math.log(DT_MIN), math.log(DT_MAX)),
        "b_re": nrm(ks[6], (L, G, P, H), jnp.float32) * (2 * H) ** -0.5,
        "b_im": nrm(ks[7], (L, G, P, H), jnp.float32) * (2 * H) ** -0.5,
        "c_re": nrm(ks[8], (L, G, H, P), jnp.float32) * (2 * P) ** -0.5,
        "c_im": nrm(ks[9], (L, G, H, P), jnp.float32) * (2 * P) ** -0.5,
        "d_skip": nrm(ks[10], (L, G, H), jnp.float32),
        "w_glu": nrm(ks[11], (L, SSM_WIDTH, SSM_WIDTH), jnp.float32) * SSM_WIDTH ** -0.5,
        "gn_attn": 1.0 + 0.02 * nrm(ks[12], (L, ATTN_WIDTH), jnp.float32),
        "gn_ssm": 1.0 + 0.02 * nrm(ks[13], (L, SSM_WIDTH), jnp.float32),
        "w_out": nrm(ks[14], (L, ATTN_WIDTH + SSM_WIDTH, D), jnp.float32) * (ATTN_WIDTH + SSM_WIDTH) ** -0.5,
        "ln2_g": 1.0 + 0.02 * nrm(ks[15], (L, D), jnp.float32),
        "w_router_grp": nrm(ks[16], (L, D, MOE_GROUPS), jnp.float32) * D ** -0.5,
        "b_router_grp": 0.01 * nrm(ks[17], (L, MOE_GROUPS), jnp.float32),
        "w_router_exp": nrm(ks[18], (L, MOE_GROUPS, D, EXPERTS_PER_GROUP), jnp.float32) * D ** -0.5,
        "b_router_exp": 0.01 * nrm(ks[19], (L, MOE_GROUPS, EXPERTS_PER_GROUP), jnp.float32),
        "w_gate": nrm(ks[20], (L, N_EXPERTS, D, EXPERT_FF), jnp.float32) * D ** -0.5,
        "w_up": nrm(ks[21], (L, N_EXPERTS, D, EXPERT_FF), jnp.float32) * D ** -0.5,
        "w_down": nrm(ks[22], (L, N_EXPERTS, EXPERT_FF, D), jnp.float32) * EXPERT_FF ** -0.5,
        "final_g": 1.0 + 0.02 * nrm(ks[23], (D,), jnp.float32),
    }


def reference(x, ln1_g, w_in, lam_re, lam_im, log_dt, b_re, b_im, c_re, c_im, d_skip, w_glu,
              gn_attn, gn_ssm, w_out, ln2_g, w_router_grp, b_router_grp, w_router_exp,
              b_router_exp, w_gate, w_up, w_down, final_g):
    B, S, D = x.shape
    for l in range(DEPTH):
        h = rmsnorm(x, ln1_g[l])
        proj = h @ w_in[l]
        q = proj[..., :ATTN_WIDTH].reshape(B, S, ATTN_HEADS, HEAD_DIM)
        k = proj[..., ATTN_WIDTH:2 * ATTN_WIDTH].reshape(B, S, ATTN_HEADS, HEAD_DIM)
        v = proj[..., 2 * ATTN_WIDTH:3 * ATTN_WIDTH].reshape(B, S, ATTN_HEADS, HEAD_DIM)
        u = proj[..., 3 * ATTN_WIDTH:]
        attn_out = dilated_attention(q, k, v)
        ssm_out = s5_mixer(u, lam_re[l], lam_im[l], log_dt[l], b_re[l], b_im[l],
                           c_re[l], c_im[l], d_skip[l], w_glu[l])
        mixed = jnp.concatenate([rmsnorm(attn_out, gn_attn[l]), rmsnorm(ssm_out, gn_ssm[l])], axis=-1)
        x = x + mixed @ w_out[l]
        h = rmsnorm(x, ln2_g[l])
        x = x + hier_moe(h, w_router_grp[l], b_router_grp[l], w_router_exp[l], b_router_exp[l],
                         w_gate[l], w_up[l], w_down[l])
    return rmsnorm(x, final_g)
```

```cpp
#include <hip/hip_runtime.h>
#include <cstdio>
#include <cstdint>

typedef unsigned short bf16;
typedef float f32x4 __attribute__((ext_vector_type(4)));
typedef unsigned u32x4 __attribute__((ext_vector_type(4)));
typedef unsigned u32x2 __attribute__((ext_vector_type(2)));
#define LAS __attribute__((address_space(3)))

constexpr int NB = 8, SEQ = 2048, DM = 1024, NL = 4, NT = NB * SEQ;
constexpr int AW = 512, HD = 64, NH = 8, SW = 512, GC = 16, NG = 32, NP = 64, INW = 2048;
constexpr int NE = 16, EFF = 256, NCLS = 24;
constexpr float RMS_EPS = 1e-6f;
constexpr int CL = 32;
constexpr int NCH = SEQ / CL;

constexpr size_t al256(size_t x) { return (x + 255) & ~(size_t)255; }
constexpr size_t WS_CTL = 0, CTL_BYTES = 1u << 20;
constexpr size_t WS_WIN  = WS_CTL + CTL_BYTES;
constexpr size_t WS_WGLU = WS_WIN  + (size_t)NL * INW * DM * 2;
constexpr size_t WS_WOUT = WS_WGLU + (size_t)NL * SW * SW * 2;
constexpr size_t WS_WGU  = WS_WOUT + (size_t)NL * DM * DM * 2;
constexpr size_t WS_WD   = WS_WGU  + (size_t)NL * NE * 512 * DM * 2;
constexpr size_t WS_KTAB = WS_WD   + (size_t)NL * NE * DM * EFF * 2;
constexpr size_t WS_BMAT = WS_KTAB + al256((size_t)NL * NG * 33 * 256 * 2);
constexpr size_t WS_CMAT = WS_BMAT + (size_t)NL * NG * 128 * 512 * 2;
constexpr size_t WS_LAML = WS_CMAT + (size_t)NL * NG * 512 * 128 * 2;
constexpr size_t WS_AB   = WS_LAML + (size_t)NL * NG * 64 * 2 * 4;
constexpr size_t WS_YG   = WS_AB;
constexpr size_t WS_PROJ = WS_AB + (size_t)NT * DM * 2;
constexpr size_t WS_SSMO = WS_PROJ;
constexpr size_t WS_ACT  = WS_PROJ;
constexpr size_t WS_OB   = WS_PROJ + (size_t)NT * INW * 2;
constexpr size_t WS_TROUTE = WS_OB + (size_t)3 * NT * AW * 2;
constexpr size_t WS_TW   = WS_TROUTE + (size_t)NT * 4;
constexpr size_t WS_LTOK = WS_TW + (size_t)NT * 8;
constexpr size_t WS_LW   = WS_LTOK + (size_t)NCLS * NT * 4;
constexpr size_t WS_LSE  = WS_LW + (size_t)NCLS * NT * 8;
constexpr size_t WS_END  = WS_LSE + (size_t)3 * NT * NH * 4;
static_assert(WS_END <= 325000000, "workspace map exceeds the guaranteed size");
constexpr int CW_CNT = 1024;

__device__ __forceinline__ unsigned f2bf(float f) { unsigned u = __builtin_bit_cast(unsigned, f); return (u + 0x7fffu + ((u >> 16) & 1u)) >> 16; }
__device__ __forceinline__ float bf2f(unsigned h) { return __builtin_bit_cast(float, h << 16); }
__device__ __forceinline__ unsigned pk2(float lo, float hi) { return f2bf(lo) | (f2bf(hi) << 16); }
__device__ __forceinline__ float wave_sum(float v) {
#pragma unroll
    for (int o = 1; o < 64; o <<= 1) v += __shfl_xor(v, o);
    return v;
}
__device__ __forceinline__ float gelu_tanh(float y) {
    const float u = 0.7978845608028654f * (y + 0.044715f * y * y * y);
    const float e = __expf(2.f * u);
    const float th = 1.f - 2.f / (e + 1.f);
    return 0.5f * y * (1.f + th);
}
__device__ __forceinline__ float sigmoidf_(float z) { return 1.f / (1.f + __expf(-z)); }

struct Ptrs {
    const float *x, *ln1_g, *w_in, *lam_re, *lam_im, *log_dt, *b_re, *b_im, *c_re, *c_im, *d_skip, *w_glu, *gn_attn, *gn_ssm, *w_out, *ln2_g,
        *w_rg, *b_rg, *w_re, *b_re_, *w_gate, *w_up, *w_down, *final_g;
    float* out; unsigned char* ws;
};

__device__ __forceinline__ void p0_transpose_item(const float* W, int N, const float* gain, bf16* WT, int K, LAS float* scr, int kb, int nb, int dst_row0, int lane) {
    const int k0 = 64 * kb, n0 = 32 * nb;
#pragma unroll 8
    for (int i = 0; i < 32; ++i) { const int kk = 2 * i + (lane >> 5); float v = W[(size_t)(k0 + kk) * N + n0 + (lane & 31)]; if (gain) v *= gain[k0 + kk]; scr[kk * 33 + (lane & 31)] = v; }
    asm volatile("s_waitcnt lgkmcnt(0)" ::: "memory");
    const int c = lane & 7;
#pragma unroll
    for (int j = 0; j < 4; ++j) { const int n = (lane >> 3) + 8 * j; const LAS float* s = scr + (8 * c) * 33 + n;
        u32x4 o; o.x = pk2(s[0 * 33], s[1 * 33]); o.y = pk2(s[2 * 33], s[3 * 33]); o.z = pk2(s[4 * 33], s[5 * 33]); o.w = pk2(s[6 * 33], s[7 * 33]);
        *(u32x4*)(WT + (size_t)(dst_row0 + n) * K + k0 + 8 * c) = o; }
    asm volatile("s_waitcnt lgkmcnt(0)" ::: "memory");
}
constexpr int IT_WIN = (DM / 64) * (INW / 32);
constexpr int IT_WGLU = (SW / 64) * (SW / 32);
constexpr int IT_WOUT = (DM / 64) * (DM / 32);
constexpr int IT_WG = (DM / 64) * (EFF / 32);
constexpr int IT_WDN = (EFF / 64) * (DM / 32);
constexpr int IT_PER_LAYER = IT_WIN + IT_WGLU + IT_WOUT + NE * (2 * IT_WG + IT_WDN);
constexpr int IT_TOTAL = NL * IT_PER_LAYER;
__device__ __forceinline__ void p0_transposes(const Ptrs& P, LAS float* scr, int gw, int ngw, int lane) {
    unsigned char* ws = P.ws;
    for (int it = gw; it < IT_TOTAL; it += ngw) {
        const int l = it / IT_PER_LAYER; int r = it % IT_PER_LAYER;
        if (r < IT_WIN) { const int nblk = INW / 32; p0_transpose_item(P.w_in + (size_t)l * DM * INW, INW, P.ln1_g + l * DM, (bf16*)(ws + WS_WIN) + (size_t)l * INW * DM, DM, scr, r / nblk, r % nblk, 32 * (r % nblk), lane); continue; }
        r -= IT_WIN;
        if (r < IT_WGLU) { const int nblk = SW / 32; p0_transpose_item(P.w_glu + (size_t)l * SW * SW, SW, nullptr, (bf16*)(ws + WS_WGLU) + (size_t)l * SW * SW, SW, scr, r / nblk, r % nblk, 32 * (r % nblk), lane); continue; }
        r -= IT_WGLU;
        if (r < IT_WOUT) { const int nblk = DM / 32; const int kb = r / nblk; const float* g = (kb < 8) ? (P.gn_attn + l * AW) : (P.gn_ssm + l * SW - AW);
            p0_transpose_item(P.w_out + (size_t)l * DM * DM, DM, g, (bf16*)(ws + WS_WOUT) + (size_t)l * DM * DM, DM, scr, kb, r % nblk, 32 * (r % nblk), lane); continue; }
        r -= IT_WOUT;
        const int e = r / (2 * IT_WG + IT_WDN); r %= (2 * IT_WG + IT_WDN);
        if (r < 2 * IT_WG) { const int up = r / IT_WG; r %= IT_WG; const int nblk = EFF / 32; const int kb = r / nblk, nb = r % nblk; const int f0 = 32 * nb;
            const float* src = (up ? P.w_up : P.w_gate) + ((size_t)l * NE + e) * DM * EFF;
            bf16* dst = (bf16*)(ws + WS_WGU) + ((size_t)l * NE + e) * 512 * DM;
            p0_transpose_item(src, EFF, P.ln2_g + l * DM, dst, DM, scr, kb, nb, (f0 / 128) * 256 + up * 128 + (f0 % 128), lane); continue; }
        r -= 2 * IT_WG;
        { const int nblk = DM / 32; p0_transpose_item(P.w_down + ((size_t)l * NE + e) * EFF * DM, DM, nullptr, (bf16*)(ws + WS_WD) + ((size_t)l * NE + e) * DM * EFF, EFF, scr, r / nblk, r % nblk, 32 * (r % nblk), lane); }
    }
}

__device__ __forceinline__ void p0_tables_item(const Ptrs& P, int lg, LAS float* scr, int tid, int nthr) {
    typedef float f32x2 __attribute__((ext_vector_type(2)));
    LAS f32x2* pw = (LAS f32x2*)scr; LAS f32x2* Bb = pw + 33 * 64; LAS f32x2* Cc = Bb + 64 * 16;
    const int l = lg / NG, g = lg % NG;
    const float dt = expf(P.log_dt[lg]);
    const float* lre = P.lam_re + (size_t)lg * NP; const float* lim = P.lam_im + (size_t)lg * NP;
    for (int i = tid; i < 33 * 64; i += nthr) { const int tau = i / 64, p = i % 64;
        const float a = lre[p] * dt * (float)tau; const float turns = lim[p] * dt * 0.15915494309189535f;
        const float xh = (float)tau * turns, xl = fmaf((float)tau, turns, -xh); const float fr = (xh - rintf(xh)) + xl;
        float sn, cs; sincosf(6.283185307179586f * fr, &sn, &cs); const float mg = expf(a);
        pw[i] = (f32x2){mg * cs, mg * sn}; }
    for (int i = tid; i < 64 * 16; i += nthr) { const int p = i / 16, h = i % 16;
        const float a = lre[p] * dt, th = lim[p] * dt; float sn, cs; sincosf(th, &sn, &cs); float sh, ch; sincosf(0.5f * th, &sh, &ch); (void)ch;
        const float em1 = expm1f(a), ea = em1 + 1.f;
        const float nr = em1 * cs - 2.f * sh * sh, ni = ea * sn;
        const float c = lre[p], d = lim[p], den = 1.f / (c * c + d * d);
        const float qr = (nr * c + ni * d) * den, qi = (ni * c - nr * d) * den;
        const float br = P.b_re[((size_t)lg * NP + p) * GC + h], bi = P.b_im[((size_t)lg * NP + p) * GC + h];
        Bb[i] = (f32x2){qr * br - qi * bi, qr * bi + qi * br}; }
    for (int i = tid; i < 16 * 64; i += nthr) { const int h = i / 64, p = i % 64;
        Cc[i] = (f32x2){P.c_re[((size_t)lg * GC + h) * NP + p], P.c_im[((size_t)lg * GC + h) * NP + p]}; }
    __syncthreads();
    unsigned char* ws = P.ws;
    bf16* Bmat = (bf16*)(ws + WS_BMAT) + (size_t)lg * 128 * 512;
    bf16* Cmat = (bf16*)(ws + WS_CMAT) + (size_t)lg * 512 * 128;
    bf16* Kt = (bf16*)(ws + WS_KTAB) + (size_t)lg * 33 * 256;
    float* LamL = (float*)(ws + WS_LAML) + (size_t)lg * 128;
    for (int i = tid; i < 128 * 64; i += nthr) { const int row = i / 64, c8 = i % 64; const int p = row & 63, cc = row >> 6; const int j = c8 >> 1, h0 = (c8 & 1) * 8;
        const f32x2 w = pw[(31 - j) * 64 + p]; unsigned o[4];
#pragma unroll
        for (int q = 0; q < 4; ++q) { const f32x2 b0 = Bb[p * 16 + h0 + 2 * q], b1 = Bb[p * 16 + h0 + 2 * q + 1];
            const float v0 = cc ? (w.x * b0.y + w.y * b0.x) : (w.x * b0.x - w.y * b0.y); const float v1 = cc ? (w.x * b1.y + w.y * b1.x) : (w.x * b1.x - w.y * b1.y); o[q] = pk2(v0, v1); }
        *(u32x4*)(Bmat + (size_t)row * 512 + c8 * 8) = (u32x4){o[0], o[1], o[2], o[3]}; }
    for (int i = tid; i < 512 * 16; i += nthr) { const int row = i / 16, s8 = i % 16; const int ii = row >> 4, h = row & 15; const int cc = s8 >> 3, p0 = (s8 & 7) * 8; unsigned o[4];
#pragma unroll
        for (int q = 0; q < 4; ++q) { float v[2];
#pragma unroll
            for (int e = 0; e < 2; ++e) { const int p = p0 + 2 * q + e; const f32x2 w = pw[(ii + 1) * 64 + p], c = Cc[h * 64 + p]; v[e] = cc ? -(c.x * w.y + c.y * w.x) : (c.x * w.x - c.y * w.y); }
            o[q] = pk2(v[0], v[1]); }
        *(u32x4*)(Cmat + (size_t)row * 128 + s8 * 8) = (u32x4){o[0], o[1], o[2], o[3]}; }
    for (int i = tid; i < 33 * 256; i += nthr) { const int t1 = i / 256, h = (i >> 4) & 15, hp = i & 15; float s = 0.f;
        if (t1 > 0) { const int tau = t1 - 1;
            for (int p = 0; p < 64; ++p) { const f32x2 c = Cc[h * 64 + p], w = pw[tau * 64 + p], b = Bb[p * 16 + hp]; const float cr = c.x * w.x - c.y * w.y, ci = c.x * w.y + c.y * w.x; s += cr * b.x - ci * b.y; }
            if (tau == 0 && h == hp) s += P.d_skip[(size_t)lg * GC + h]; }
        Kt[i] = (bf16)f2bf(s); }
    for (int i = tid; i < 64; i += nthr) { const f32x2 w = pw[32 * 64 + i]; LamL[2 * i] = w.x; LamL[2 * i + 1] = w.y; }
    __syncthreads();
    (void)l; (void)g;
}

__global__ void __launch_bounds__(256) k_p0(Ptrs P) {
    __shared__ __attribute__((aligned(16))) float scr[4 * 64 * 33 > 9216 ? 4 * 64 * 33 : 9216];
    const int tid = threadIdx.x, lane = tid & 63, wave = tid >> 6;
    for (int lg = blockIdx.x; lg < NL * NG; lg += gridDim.x) p0_tables_item(P, lg, (LAS float*)scr, tid, 256);
    __syncthreads();
    p0_transposes(P, (LAS float*)scr + wave * 64 * 33, blockIdx.x * 4 + wave, gridDim.x * 4, lane);
}

__global__ void __launch_bounds__(256) k_norm(const float* x, bf16* xn, float* outf, const float* g, int mode) {
    const int lane = threadIdx.x & 63; const int row = blockIdx.x * 4 + (threadIdx.x >> 6);
    const f32x4* xr = (const f32x4*)(x + (size_t)row * DM) + lane; f32x4 v[4]; float s = 0.f;
#pragma unroll
    for (int j = 0; j < 4; ++j) { v[j] = xr[64 * j]; s += v[j].x * v[j].x + v[j].y * v[j].y + v[j].z * v[j].z + v[j].w * v[j].w; }
    const float rstd = 1.f / sqrtf(wave_sum(s) * (1.f / DM) + RMS_EPS);
    if (mode == 0) { u32x2* o = (u32x2*)(xn + (size_t)row * DM) + lane;
#pragma unroll
        for (int j = 0; j < 4; ++j) o[64 * j] = (u32x2){pk2(v[j].x * rstd, v[j].y * rstd), pk2(v[j].z * rstd, v[j].w * rstd)};
    } else { f32x4* o = (f32x4*)(outf + (size_t)row * DM) + lane; const f32x4* gg = (const f32x4*)g + lane;
#pragma unroll
        for (int j = 0; j < 4; ++j) { const f32x4 gv = gg[64 * j]; o[64 * j] = (f32x4){v[j].x * rstd * gv.x, v[j].y * rstd * gv.y, v[j].z * rstd * gv.z, v[j].w * rstd * gv.w}; } }
}

__device__ __forceinline__ void route_row(const Ptrs& P, int l, int row, int lane, const float* X, bf16* XN, unsigned* troute, float* tw, int* ltok, float* lw, unsigned* cnt) {
    const f32x4* xr = (const f32x4*)(X + (size_t)row * DM) + lane; f32x4 v[4]; float s = 0.f;
#pragma unroll
    for (int j = 0; j < 4; ++j) { v[j] = xr[64 * j]; s += v[j].x * v[j].x + v[j].y * v[j].y + v[j].z * v[j].z + v[j].w * v[j].w; }
    const float rstd = 1.f / sqrtf(wave_sum(s) * (1.f / DM) + RMS_EPS);
    u32x2* o = (u32x2*)(XN + (size_t)row * DM) + lane;
#pragma unroll
    for (int j = 0; j < 4; ++j) o[64 * j] = (u32x2){pk2(v[j].x * rstd, v[j].y * rstd), pk2(v[j].z * rstd, v[j].w * rstd)};
    const f32x4* gg = (const f32x4*)(P.ln2_g + l * DM) + lane;
#pragma unroll
    for (int j = 0; j < 4; ++j) { const f32x4 gv = gg[64 * j]; v[j] = (f32x4){v[j].x * rstd * gv.x, v[j].y * rstd * gv.y, v[j].z * rstd * gv.z, v[j].w * rstd * gv.w}; }
    const f32x4* wg = (const f32x4*)(P.w_rg + (size_t)l * DM * 4);
    f32x4 acc = (f32x4){0.f, 0.f, 0.f, 0.f};
#pragma unroll
    for (int j = 0; j < 4; ++j) { const int k = 4 * lane + 256 * j; acc += v[j].x * wg[k] + v[j].y * wg[k + 1] + v[j].z * wg[k + 2] + v[j].w * wg[k + 3]; }
    float gl[4];
#pragma unroll
    for (int e = 0; e < 4; ++e) gl[e] = wave_sum(acc[e]) + P.b_rg[l * 4 + e];
    int grp = 0; float gm = gl[0];
#pragma unroll
    for (int e = 1; e < 4; ++e) if (gl[e] > gm) { gm = gl[e]; grp = e; }
    float gs = 0.f;
#pragma unroll
    for (int e = 0; e < 4; ++e) gs += expf(gl[e] - gm);
    const float g1 = 1.f / gs;
    const f32x4* we = (const f32x4*)(P.w_re + ((size_t)l * 4 + grp) * DM * 4);
    acc = (f32x4){0.f, 0.f, 0.f, 0.f};
#pragma unroll
    for (int j = 0; j < 4; ++j) { const int k = 4 * lane + 256 * j; acc += v[j].x * we[k] + v[j].y * we[k + 1] + v[j].z * we[k + 2] + v[j].w * we[k + 3]; }
    float el[4];
#pragma unroll
    for (int e = 0; e < 4; ++e) el[e] = wave_sum(acc[e]) + P.b_re_[(l * 4 + grp) * 4 + e];
    int i1 = 0; float v1 = el[0];
#pragma unroll
    for (int e = 1; e < 4; ++e) if (el[e] > v1) { v1 = el[e]; i1 = e; }
    int i2 = -1; float v2 = -INFINITY;
#pragma unroll
    for (int e = 0; e < 4; ++e) if (e != i1 && el[e] > v2) { v2 = el[e]; i2 = e; }
    const float e2 = expf(v2 - v1); const float w1 = g1 / (1.f + e2), w2 = g1 * e2 / (1.f + e2);
    const int a = i1 < i2 ? i1 : i2, b = i1 < i2 ? i2 : i1; const float wa = i1 < i2 ? w1 : w2, wb = i1 < i2 ? w2 : w1;
    const int pair = (a == 0) ? (b - 1) : (a == 1 ? (b + 1) : 5);
    const int cls = grp * 6 + pair;
    if (lane == 0) {
        troute[row] = (unsigned)(grp * 4 + a) | ((unsigned)(grp * 4 + b) << 8) | ((unsigned)cls << 16);
        tw[2 * row] = wa; tw[2 * row + 1] = wb;
        const unsigned slot = atomicAdd(cnt + cls, 1u);
        ltok[(size_t)cls * NT + slot] = row; lw[((size_t)cls * NT + slot) * 2] = wa; lw[((size_t)cls * NT + slot) * 2 + 1] = wb;
    }
}
__global__ void __launch_bounds__(256) k_route(Ptrs P, int l) {
    const int lane = threadIdx.x & 63; const int row = blockIdx.x * 4 + (threadIdx.x >> 6); unsigned char* ws = P.ws;
    route_row(P, l, row, lane, P.out, (bf16*)(ws + WS_AB), (unsigned*)(ws + WS_TROUTE), (float*)(ws + WS_TW), (int*)(ws + WS_LTOK), (float*)(ws + WS_LW), (unsigned*)(ws + WS_CTL) + CW_CNT + l * 32);
}

__device__ __forceinline__ void mix_row(int row, int lane, const bf16* OB, const float* LSE, const bf16* SSMO, bf16* AB) {
    const int h = lane >> 3;
    float ls[3], m = -INFINITY;
#pragma unroll
    for (int b = 0; b < 3; ++b) { ls[b] = LSE[((size_t)b * NT + row) * NH + h]; m = fmaxf(m, ls[b]); }
    float w[3], ws_ = 0.f;
#pragma unroll
    for (int b = 0; b < 3; ++b) { w[b] = expf(ls[b] - m); ws_ += w[b]; }
    float o[8];
#pragma unroll
    for (int i = 0; i < 8; ++i) o[i] = 0.f;
#pragma unroll
    for (int b = 0; b < 3; ++b) { const u32x4 q = *((const u32x4*)(OB + ((size_t)b * NT + row) * AW) + lane); const float wb = w[b] / ws_;
        o[0] += wb * bf2f(q.x & 0xffffu); o[1] += wb * bf2f(q.x >> 16); o[2] += wb * bf2f(q.y & 0xffffu); o[3] += wb * bf2f(q.y >> 16);
        o[4] += wb * bf2f(q.z & 0xffffu); o[5] += wb * bf2f(q.z >> 16); o[6] += wb * bf2f(q.w & 0xffffu); o[7] += wb * bf2f(q.w >> 16); }
    float s = 0.f;
#pragma unroll
    for (int i = 0; i < 8; ++i) s += o[i] * o[i];
    float rstd = 1.f / sqrtf(wave_sum(s) * (1.f / AW) + RMS_EPS);
    *((u32x4*)(AB + (size_t)row * DM) + lane) = (u32x4){pk2(o[0] * rstd, o[1] * rstd), pk2(o[2] * rstd, o[3] * rstd), pk2(o[4] * rstd, o[5] * rstd), pk2(o[6] * rstd, o[7] * rstd)};
    const u32x4 q = *((const u32x4*)(SSMO + (size_t)row * SW) + lane);
    o[0] = bf2f(q.x & 0xffffu); o[1] = bf2f(q.x >> 16); o[2] = bf2f(q.y & 0xffffu); o[3] = bf2f(q.y >> 16); o[4] = bf2f(q.z & 0xffffu); o[5] = bf2f(q.z >> 16); o[6] = bf2f(q.w & 0xffffu); o[7] = bf2f(q.w >> 16);
    s = 0.f;
#pragma unroll
    for (int i = 0; i < 8; ++i) s += o[i] * o[i];
    rstd = 1.f / sqrtf(wave_sum(s) * (1.f / SW) + RMS_EPS);
    *((u32x4*)(AB + (size_t)row * DM + AW) + lane) = (u32x4){pk2(o[0] * rstd, o[1] * rstd), pk2(o[2] * rstd, o[3] * rstd), pk2(o[4] * rstd, o[5] * rstd), pk2(o[6] * rstd, o[7] * rstd)};
}
__global__ void __launch_bounds__(256) k_mix(Ptrs P) {
    const int lane = threadIdx.x & 63; const int row = blockIdx.x * 4 + (threadIdx.x >> 6); unsigned char* ws = P.ws;
    mix_row(row, lane, (const bf16*)(ws + WS_OB), (const float*)(ws + WS_LSE), (const bf16*)(ws + WS_SSMO), (bf16*)(ws + WS_AB));
}

template <int EPI> __global__ void __launch_bounds__(256) nv_gemm(const bf16* A, int lda, const bf16* Bt, int ldb, int K, bf16* Cb, float* Cf, int ldc, const bf16* auxb, const float* base) {
    __shared__ float As[16][65], Bs[16][65];
    const int tx = threadIdx.x & 15, ty = threadIdx.x >> 4; const int m0 = blockIdx.y * 64, n0 = blockIdx.x * 64;
    float acc[4][4];
#pragma unroll
    for (int i = 0; i < 4; ++i)
#pragma unroll
        for (int j = 0; j < 4; ++j) acc[i][j] = 0.f;
    for (int k0 = 0; k0 < K; k0 += 16) {
#pragma unroll
        for (int i = 0; i < 4; ++i) { const int idx = threadIdx.x + 256 * i, r = idx >> 4, c = idx & 15;
            As[c][r] = bf2f(A[(size_t)(m0 + r) * lda + k0 + c]); Bs[c][r] = bf2f(Bt[(size_t)(n0 + r) * ldb + k0 + c]); }
        __syncthreads();
#pragma unroll
        for (int kk = 0; kk < 16; ++kk) { float a[4], b[4];
#pragma unroll
            for (int i = 0; i < 4; ++i) { a[i] = As[kk][ty * 4 + i]; b[i] = Bs[kk][tx * 4 + i]; }
#pragma unroll
            for (int i = 0; i < 4; ++i)
#pragma unroll
                for (int j = 0; j < 4; ++j) acc[i][j] += a[i] * b[j]; }
        __syncthreads();
    }
#pragma unroll
    for (int i = 0; i < 4; ++i)
#pragma unroll
        for (int j = 0; j < 4; ++j) { const int m = m0 + ty * 4 + i, n = n0 + tx * 4 + j; const size_t o = (size_t)m * ldc + n;
            if (EPI == 0) Cb[o] = (bf16)f2bf(acc[i][j]);
            else if (EPI == 1) Cb[o] = (bf16)f2bf(bf2f(auxb[o]) * sigmoidf_(acc[i][j]));
            else Cf[o] = base[o] + acc[i][j]; }
}

__global__ void __launch_bounds__(64) nv_attn(const bf16* PROJ, bf16* OB, float* LSE) {
    const int gid = blockIdx.x * 64 + threadIdx.x; const int t = gid / NH, h = gid % NH; const int b = t / SEQ, s = t % SEQ;
    float q[HD];
    const bf16* qp = PROJ + (size_t)t * INW + h * HD;
#pragma unroll
    for (int d = 0; d < HD; ++d) q[d] = bf2f(qp[d]) * 0.125f;
    for (int br = 0; br < 3; ++br) { const int dil = br == 0 ? 1 : (br == 1 ? 4 : 16); const int m = s / dil, r = s % dil; const int mlo = m - 128 > 0 ? m - 128 : 0;
        float o[HD]; float mx = -INFINITY, l = 0.f;
#pragma unroll
        for (int d = 0; d < HD; ++d) o[d] = 0.f;
        for (int mm = mlo; mm <= m; ++mm) { const size_t tk = (size_t)b * SEQ + (size_t)mm * dil + r; const bf16* kp = PROJ + tk * INW + AW + h * HD; const bf16* vp = PROJ + tk * INW + 2 * AW + h * HD;
            float sc = 0.f;
#pragma unroll
            for (int d = 0; d < HD; ++d) sc += q[d] * bf2f(kp[d]);
            const float mn = fmaxf(mx, sc), f = expf(mx - mn), p = expf(sc - mn); l = l * f + p;
#pragma unroll
            for (int d = 0; d < HD; ++d) o[d] = o[d] * f + p * bf2f(vp[d]);
            mx = mn; }
        const float il = 1.f / l; bf16* op = OB + ((size_t)br * NT + t) * AW + h * HD;
#pragma unroll
        for (int d = 0; d < HD; ++d) op[d] = (bf16)f2bf(o[d] * il);
        LSE[((size_t)br * NT + t) * NH + h] = mx + logf(l); }
}

__global__ void __launch_bounds__(64) nv_ssm(Ptrs P, int l) {
    const int b = blockIdx.x / NG, g = blockIdx.x % NG, p = threadIdx.x; const int lg = l * NG + g; unsigned char* ws = P.ws;
    const bf16* PROJ = (const bf16*)(ws + WS_PROJ); bf16* YG = (bf16*)(ws + WS_YG);
    const float dt = expf(P.log_dt[lg]); const float lr = P.lam_re[(size_t)lg * NP + p], li = P.lam_im[(size_t)lg * NP + p];
    const float mg = expf(lr * dt); float sn, cs; sincosf(li * dt, &sn, &cs); const float ar = mg * cs, ai = mg * sn;
    const float nr = ar - 1.f, ni = ai, den = 1.f / (lr * lr + li * li); const float qr = (nr * lr + ni * li) * den, qi = (ni * lr - nr * li) * den;
    float bbr[GC], bbi[GC], cr[GC], ci[GC];
#pragma unroll
    for (int h = 0; h < GC; ++h) { const float br = P.b_re[((size_t)lg * NP + p) * GC + h], bi = P.b_im[((size_t)lg * NP + p) * GC + h]; bbr[h] = qr * br - qi * bi; bbi[h] = qr * bi + qi * br;
        cr[h] = P.c_re[((size_t)lg * GC + h) * NP + p]; ci[h] = P.c_im[((size_t)lg * GC + h) * NP + p]; }
    const float dsk = p < GC ? P.d_skip[(size_t)lg * GC + p] : 0.f;
    float sr = 0.f, si = 0.f;
    for (int t = 0; t < SEQ; ++t) { const size_t tok = (size_t)b * SEQ + t;
        const float um = p < GC ? bf2f(PROJ[tok * INW + 3 * AW + g * GC + p]) : 0.f;
        float bur = 0.f, bui = 0.f;
#pragma unroll
        for (int h = 0; h < GC; ++h) { const float u = __shfl(um, h); bur += bbr[h] * u; bui += bbi[h] * u; }
        const float nsr = ar * sr - ai * si + bur, nsi = ar * si + ai * sr + bui; sr = nsr; si = nsi;
        float yv = 0.f;
#pragma unroll
        for (int h = 0; h < GC; ++h) { const float v = wave_sum(cr[h] * sr - ci[h] * si); if (p == h) yv = v; }
        if (p < GC) YG[tok * SW + g * GC + p] = (bf16)f2bf(gelu_tanh(yv + dsk * um)); }
}

__global__ void __launch_bounds__(256) nv_moe(Ptrs P, int l) {
    __shared__ float sh[DM]; __shared__ float sa[2][EFF];
    const int t = blockIdx.x, tid = threadIdx.x; unsigned char* ws = P.ws;
    const bf16* XN = (const bf16*)(ws + WS_AB) + (size_t)t * DM;
    for (int i = tid; i < DM; i += 256) sh[i] = bf2f(XN[i]);
    __syncthreads();
    const unsigned rt = ((const unsigned*)(ws + WS_TROUTE))[t]; const int ex[2] = {(int)(rt & 255u), (int)((rt >> 8) & 255u)}; const float* tw = (const float*)(ws + WS_TW) + 2 * t;
#pragma unroll
    for (int q = 0; q < 2; ++q) { const int f = tid; const bf16* wg = (const bf16*)(ws + WS_WGU) + (((size_t)l * NE + ex[q]) * 512 + (f / 128) * 256 + (f % 128)) * DM; const bf16* wu = wg + (size_t)128 * DM;
        float hg = 0.f, hu = 0.f;
        for (int k = 0; k < DM; ++k) { hg += sh[k] * bf2f(wg[k]); hu += sh[k] * bf2f(wu[k]); }
        sa[q][f] = bf2f(f2bf(hg * sigmoidf_(hg) * hu * tw[q])); }
    __syncthreads();
    for (int j = 0; j < 4; ++j) { const int n = tid + 256 * j; float o = 0.f;
#pragma unroll
        for (int q = 0; q < 2; ++q) { const bf16* wd = (const bf16*)(ws + WS_WD) + (((size_t)l * NE + ex[q]) * DM + n) * EFF; for (int f = 0; f < EFF; ++f) o += sa[q][f] * bf2f(wd[f]); }
        P.out[(size_t)t * DM + n] += o; }
}

extern "C" void kernel_launch(void* const* d_in, const int* in_sizes, int n_in, void* d_out, int out_size, void* d_ws, size_t ws_size, hipStream_t stream) {
    if (n_in != 24 || out_size != NT * DM || ws_size < WS_END) { fprintf(stderr, "kernel_launch: unexpected shapes n_in %d out %d ws %zu (need %zu)\n", n_in, out_size, ws_size, (size_t)WS_END); return; }
    Ptrs P{};
    const float** pf = (const float**)&P;
    for (int i = 0; i < 24; ++i) pf[i] = (const float*)d_in[i];
    P.out = (float*)d_out; P.ws = (unsigned char*)d_ws;
    unsigned char* ws = P.ws;
    (void)hipMemsetAsync(ws + WS_CTL, 0, CTL_BYTES, stream);
    hipLaunchKernelGGL(k_p0, dim3(256), dim3(256), 0, stream, P);
    for (int l = 0; l < NL; ++l) {
        const float* xin = l == 0 ? P.x : P.out;
        hipLaunchKernelGGL(k_norm, dim3(NT / 4), dim3(256), 0, stream, xin, (bf16*)(ws + WS_AB), (float*)nullptr, (const float*)nullptr, 0);
        hipLaunchKernelGGL(nv_gemm<0>, dim3(INW / 64, NT / 64), dim3(256), 0, stream, (const bf16*)(ws + WS_AB), DM, (const bf16*)(ws + WS_WIN) + (size_t)l * INW * DM, DM, DM, (bf16*)(ws + WS_PROJ), (float*)nullptr, INW, (const bf16*)nullptr, (const float*)nullptr);
        hipLaunchKernelGGL(nv_attn, dim3(NT * NH / 64), dim3(64), 0, stream, (const bf16*)(ws + WS_PROJ), (bf16*)(ws + WS_OB), (float*)(ws + WS_LSE));
        hipLaunchKernelGGL(nv_ssm, dim3(NB * NG), dim3(64), 0, stream, P, l);
        hipLaunchKernelGGL(nv_gemm<1>, dim3(SW / 64, NT / 64), dim3(256), 0, stream, (const bf16*)(ws + WS_YG), SW, (const bf16*)(ws + WS_WGLU) + (size_t)l * SW * SW, SW, SW, (bf16*)(ws + WS_SSMO), (float*)nullptr, SW, (const bf16*)(ws + WS_YG), (const float*)nullptr);
        hipLaunchKernelGGL(k_mix, dim3(NT / 4), dim3(256), 0, stream, P);
        hipLaunchKernelGGL(nv_gemm<2>, dim3(DM / 64, NT / 64), dim3(256), 0, stream, (const bf16*)(ws + WS_AB), DM, (const bf16*)(ws + WS_WOUT) + (size_t)l * DM * DM, DM, DM, (bf16*)nullptr, P.out, DM, (const bf16*)nullptr, xin);
        hipLaunchKernelGGL(k_route, dim3(NT / 4), dim3(256), 0, stream, P, l);
        hipLaunchKernelGGL(nv_moe, dim3(NT), dim3(256), 0, stream, P, l);
    }
    hipLaunchKernelGGL(k_norm, dim3(NT / 4), dim3(256), 0, stream, (const float*)P.out, (bf16*)nullptr, P.out, P.final_g, 2);
}
```

```cpp
#include <hip/hip_runtime.h>
#include <cstdio>
#include <cstdint>

typedef unsigned short bf16;
typedef float f32x4 __attribute__((ext_vector_type(4)));
typedef unsigned u32x4 __attribute__((ext_vector_type(4)));
typedef unsigned u32x2 __attribute__((ext_vector_type(2)));
#define LAS __attribute__((address_space(3)))

constexpr int NB = 8, SEQ = 2048, DM = 1024, NL = 4, NT = NB * SEQ;
constexpr int AW = 512, HD = 64, NH = 8, SW = 512, GC = 16, NG = 32, NP = 64, INW = 2048;
constexpr int NE = 16, EFF = 256, NCLS = 24;
constexpr float RMS_EPS = 1e-6f;
constexpr int CL = 32;
constexpr int NCH = SEQ / CL;

constexpr size_t al256(size_t x) { return (x + 255) & ~(size_t)255; }
constexpr size_t WS_CTL = 0, CTL_BYTES = 1u << 20;
constexpr size_t WS_WIN  = WS_CTL + CTL_BYTES;
constexpr size_t WS_WGLU = WS_WIN  + (size_t)NL * INW * DM * 2;
constexpr size_t WS_WOUT = WS_WGLU + (size_t)NL * SW * SW * 2;
constexpr size_t WS_WGU  = WS_WOUT + (size_t)NL * DM * DM * 2;
constexpr size_t WS_WD   = WS_WGU  + (size_t)NL * NE * 512 * DM * 2;
constexpr size_t WS_KTAB = WS_WD   + (size_t)NL * NE * DM * EFF * 2;
constexpr size_t WS_BMAT = WS_KTAB + al256((size_t)NL * NG * 33 * 256 * 2);
constexpr size_t WS_CMAT = WS_BMAT + (size_t)NL * NG * 128 * 512 * 2;
constexpr size_t WS_LAML = WS_CMAT + (size_t)NL * NG * 512 * 128 * 2;
constexpr size_t WS_AB   = WS_LAML + (size_t)NL * NG * 64 * 2 * 4;
constexpr size_t WS_YG   = WS_AB;
constexpr size_t WS_PROJ = WS_AB + (size_t)NT * DM * 2;
constexpr size_t WS_SSMO = WS_PROJ;
constexpr size_t WS_ACT  = WS_PROJ;
constexpr size_t WS_OB   = WS_PROJ + (size_t)NT * INW * 2;
constexpr size_t WS_TROUTE = WS_OB + (size_t)3 * NT * AW * 2;
constexpr size_t WS_TW   = WS_TROUTE + (size_t)NT * 4;
constexpr size_t WS_LTOK = WS_TW + (size_t)NT * 8;
constexpr size_t WS_LW   = WS_LTOK + (size_t)NCLS * NT * 4;
constexpr size_t WS_LSE  = WS_LW + (size_t)NCLS * NT * 8;
constexpr size_t WS_END  = WS_LSE + (size_t)3 * NT * NH * 4;
static_assert(WS_END <= 325000000, "workspace map exceeds the guaranteed size");
constexpr int CW_CNT = 1024;

__device__ __forceinline__ unsigned f2bf(float f) { unsigned u = __builtin_bit_cast(unsigned, f); return (u + 0x7fffu + ((u >> 16) & 1u)) >> 16; }
__device__ __forceinline__ float bf2f(unsigned h) { return __builtin_bit_cast(float, h << 16); }
__device__ __forceinline__ unsigned pk2(float lo, float hi) { return f2bf(lo) | (f2bf(hi) << 16); }
__device__ __forceinline__ float wave_sum(float v) {
#pragma unroll
    for (int o = 1; o < 64; o <<= 1) v += __shfl_xor(v, o);
    return v;
}
__device__ __forceinline__ float gelu_tanh(float y) {
    const float u = 0.7978845608028654f * (y + 0.044715f * y * y * y);
    const float e = __expf(2.f * u);
    const float th = 1.f - 2.f / (e + 1.f);
    return 0.5f * y * (1.f + th);
}
__device__ __forceinline__ float sigmoidf_(float z) { return 1.f / (1.f + __expf(-z)); }

struct Ptrs {
    const float *x, *ln1_g, *w_in, *lam_re, *lam_im, *log_dt, *b_re, *b_im, *c_re, *c_im, *d_skip, *w_glu, *gn_attn, *gn_ssm, *w_out, *ln2_g,
        *w_rg, *b_rg, *w_re, *b_re_, *w_gate, *w_up, *w_down, *final_g;
    float* out; unsigned char* ws;
};

__device__ __forceinline__ void p0_transpose_item(const float* W, int N, const float* gain, bf16* WT, int K, LAS float* scr, int kb, int nb, int dst_row0, int lane) {
    const int k0 = 64 * kb, n0 = 32 * nb;
#pragma unroll 8
    for (int i = 0; i < 32; ++i) { const int kk = 2 * i + (lane >> 5); float v = W[(size_t)(k0 + kk) * N + n0 + (lane & 31)]; if (gain) v *= gain[k0 + kk]; scr[kk * 33 + (lane & 31)] = v; }
    asm volatile("s_waitcnt lgkmcnt(0)" ::: "memory");
    const int c = lane & 7;
#pragma unroll
    for (int j = 0; j < 4; ++j) { const int n = (lane >> 3) + 8 * j; const LAS float* s = scr + (8 * c) * 33 + n;
        u32x4 o; o.x = pk2(s[0 * 33], s[1 * 33]); o.y = pk2(s[2 * 33], s[3 * 33]); o.z = pk2(s[4 * 33], s[5 * 33]); o.w = pk2(s[6 * 33], s[7 * 33]);
        *(u32x4*)(WT + (size_t)(dst_row0 + n) * K + k0 + 8 * c) = o; }
    asm volatile("s_waitcnt lgkmcnt(0)" ::: "memory");
}
constexpr int IT_WIN = (DM / 64) * (INW / 32);
constexpr int IT_WGLU = (SW / 64) * (SW / 32);
constexpr int IT_WOUT = (DM / 64) * (DM / 32);
constexpr int IT_WG = (DM / 64) * (EFF / 32);
constexpr int IT_WDN = (EFF / 64) * (DM / 32);
constexpr int IT_PER_LAYER = IT_WIN + IT_WGLU + IT_WOUT + NE * (2 * IT_WG + IT_WDN);
constexpr int IT_TOTAL = NL * IT_PER_LAYER;
__device__ __forceinline__ void p0_transposes(const Ptrs& P, LAS float* scr, int gw, int ngw, int lane) {
    unsigned char* ws = P.ws;
    for (int it = gw; it < IT_TOTAL; it += ngw) {
        const int l = it / IT_PER_LAYER; int r = it % IT_PER_LAYER;
        if (r < IT_WIN) { const int nblk = INW / 32; p0_transpose_item(P.w_in + (size_t)l * DM * INW, INW, P.ln1_g + l * DM, (bf16*)(ws + WS_WIN) + (size_t)l * INW * DM, DM, scr, r / nblk, r % nblk, 32 * (r % nblk), lane); continue; }
        r -= IT_WIN;
        if (r < IT_WGLU) { const int nblk = SW / 32; p0_transpose_item(P.w_glu + (size_t)l * SW * SW, SW, nullptr, (bf16*)(ws + WS_WGLU) + (size_t)l * SW * SW, SW, scr, r / nblk, r % nblk, 32 * (r % nblk), lane); continue; }
        r -= IT_WGLU;
        if (r < IT_WOUT) { const int nblk = DM / 32; const int kb = r / nblk; const float* g = (kb < 8) ? (P.gn_attn + l * AW) : (P.gn_ssm + l * SW - AW);
            p0_transpose_item(P.w_out + (size_t)l * DM * DM, DM, g, (bf16*)(ws + WS_WOUT) + (size_t)l * DM * DM, DM, scr, kb, r % nblk, 32 * (r % nblk), lane); continue; }
        r -= IT_WOUT;
        const int e = r / (2 * IT_WG + IT_WDN); r %= (2 * IT_WG + IT_WDN);
        if (r < 2 * IT_WG) { const int up = r / IT_WG; r %= IT_WG; const int nblk = EFF / 32; const int kb = r / nblk, nb = r % nblk; const int f0 = 32 * nb;
            const float* src = (up ? P.w_up : P.w_gate) + ((size_t)l * NE + e) * DM * EFF;
            bf16* dst = (bf16*)(ws + WS_WGU) + ((size_t)l * NE + e) * 512 * DM;
            p0_transpose_item(src, EFF, P.ln2_g + l * DM, dst, DM, scr, kb, nb, (f0 / 128) * 256 + up * 128 + (f0 % 128), lane); continue; }
        r -= 2 * IT_WG;
        { const int nblk = DM / 32; p0_transpose_item(P.w_down + ((size_t)l * NE + e) * EFF * DM, DM, nullptr, (bf16*)(ws + WS_WD) + ((size_t)l * NE + e) * DM * EFF, EFF, scr, r / nblk, r % nblk, 32 * (r % nblk), lane); }
    }
}

__device__ __forceinline__ void p0_tables_item(const Ptrs& P, int lg, LAS float* scr, int tid, int nthr) {
    typedef float f32x2 __attribute__((ext_vector_type(2)));
    LAS f32x2* pw = (LAS f32x2*)scr; LAS f32x2* Bb = pw + 33 * 64; LAS f32x2* Cc = Bb + 64 * 16;
    const int l = lg / NG, g = lg % NG;
    const float dt = expf(P.log_dt[lg]);
    const float* lre = P.lam_re + (size_t)lg * NP; const float* lim = P.lam_im + (size_t)lg * NP;
    for (int i = tid; i < 33 * 64; i += nthr) { const int tau = i / 64, p = i % 64;
        const float a = lre[p] * dt * (float)tau; const float turns = lim[p] * dt * 0.15915494309189535f;
        const float xh = (float)tau * turns, xl = fmaf((float)tau, turns, -xh); const float fr = (xh - rintf(xh)) + xl;
        float sn, cs; sincosf(6.283185307179586f * fr, &sn, &cs); const float mg = expf(a);
        pw[i] = (f32x2){mg * cs, mg * sn}; }
    for (int i = tid; i < 64 * 16; i += nthr) { const int p = i / 16, h = i % 16;
        const float a = lre[p] * dt, th = lim[p] * dt; float sn, cs; sincosf(th, &sn, &cs); float sh, ch; sincosf(0.5f * th, &sh, &ch); (void)ch;
        const float em1 = expm1f(a), ea = em1 + 1.f;
        const float nr = em1 * cs - 2.f * sh * sh, ni = ea * sn;
        const float c = lre[p], d = lim[p], den = 1.f / (c * c + d * d);
        const float qr = (nr * c + ni * d) * den, qi = (ni * c - nr * d) * den;
        const float br = P.b_re[((size_t)lg * NP + p) * GC + h], bi = P.b_im[((size_t)lg * NP + p) * GC + h];
        Bb[i] = (f32x2){qr * br - qi * bi, qr * bi + qi * br}; }
    for (int i = tid; i < 16 * 64; i += nthr) { const int h = i / 64, p = i % 64;
        Cc[i] = (f32x2){P.c_re[((size_t)lg * GC + h) * NP + p], P.c_im[((size_t)lg * GC + h) * NP + p]}; }
    __syncthreads();
    unsigned char* ws = P.ws;
    bf16* Bmat = (bf16*)(ws + WS_BMAT) + (size_t)lg * 128 * 512;
    bf16* Cmat = (bf16*)(ws + WS_CMAT) + (size_t)lg * 512 * 128;
    bf16* Kt = (bf16*)(ws + WS_KTAB) + (size_t)lg * 33 * 256;
    float* LamL = (float*)(ws + WS_LAML) + (size_t)lg * 128;
    for (int i = tid; i < 128 * 64; i += nthr) { const int row = i / 64, c8 = i % 64; const int p = row & 63, cc = row >> 6; const int j = c8 >> 1, h0 = (c8 & 1) * 8;
        const f32x2 w = pw[(31 - j) * 64 + p]; unsigned o[4];
#pragma unroll
        for (int q = 0; q < 4; ++q) { const f32x2 b0 = Bb[p * 16 + h0 + 2 * q], b1 = Bb[p * 16 + h0 + 2 * q + 1];
            const float v0 = cc ? (w.x * b0.y + w.y * b0.x) : (w.x * b0.x - w.y * b0.y); const float v1 = cc ? (w.x * b1.y + w.y * b1.x) : (w.x * b1.x - w.y * b1.y); o[q] = pk2(v0, v1); }
        *(u32x4*)(Bmat + (size_t)row * 512 + c8 * 8) = (u32x4){o[0], o[1], o[2], o[3]}; }
    for (int i = tid; i < 512 * 16; i += nthr) { const int row = i / 16, s8 = i % 16; const int ii = row >> 4, h = row & 15; const int cc = s8 >> 3, p0 = (s8 & 7) * 8; unsigned o[4];
#pragma unroll
        for (int q = 0; q < 4; ++q) { float v[2];
#pragma unroll
            for (int e = 0; e < 2; ++e) { const int p = p0 + 2 * q + e; const f32x2 w = pw[(ii + 1) * 64 + p], c = Cc[h * 64 + p]; v[e] = cc ? -(c.x * w.y + c.y * w.x) : (c.x * w.x - c.y * w.y); }
            o[q] = pk2(v[0], v[1]); }
        *(u32x4*)(Cmat + (size_t)row * 128 + s8 * 8) = (u32x4){o[0], o[1], o[2], o[3]}; }
    for (int i = tid; i < 33 * 256; i += nthr) { const int t1 = i / 256, h = (i >> 4) & 15, hp = i & 15; float s = 0.f;
        if (t1 > 0) { const int tau = t1 - 1;
            for (int p = 0; p < 64; ++p) { const f32x2 c = Cc[h * 64 + p], w = pw[tau * 64 + p], b = Bb[p * 16 + hp]; const float cr = c.x * w.x - c.y * w.y, ci = c.x * w.y + c.y * w.x; s += cr * b.x - ci * b.y; }
            if (tau == 0 && h == hp) s += P.d_skip[(size_t)lg * GC + h]; }
        Kt[i] = (bf16)f2bf(s); }
    for (int i = tid; i < 64; i += nthr) { const f32x2 w = pw[32 * 64 + i]; LamL[2 * i] = w.x; LamL[2 * i + 1] = w.y; }
    __syncthreads();
    (void)l; (void)g;
}

__global__ void __launch_bounds__(256) k_p0(Ptrs P) {
    __shared__ __attribute__((aligned(16))) float scr[4 * 64 * 33 > 9216 ? 4 * 64 * 33 : 9216];
    const int tid = threadIdx.x, lane = tid & 63, wave = tid >> 6;
    for (int lg = blockIdx.x; lg < NL * NG; lg += gridDim.x) p0_tables_item(P, lg, (LAS float*)scr, tid, 256);
    __syncthreads();
    p0_transposes(P, (LAS float*)scr + wave * 64 * 33, blockIdx.x * 4 + wave, gridDim.x * 4, lane);
}

__global__ void __launch_bounds__(256) k_norm(const float* x, bf16* xn, float* outf, const float* g, int mode) {
    const int lane = threadIdx.x & 63; const int row = blockIdx.x * 4 + (threadIdx.x >> 6);
    const f32x4* xr = (const f32x4*)(x + (size_t)row * DM) + lane; f32x4 v[4]; float s = 0.f;
#pragma unroll
    for (int j = 0; j < 4; ++j) { v[j] = xr[64 * j]; s += v[j].x * v[j].x + v[j].y * v[j].y + v[j].z * v[j].z + v[j].w * v[j].w; }
    const float rstd = 1.f / sqrtf(wave_sum(s) * (1.f / DM) + RMS_EPS);
    if (mode == 0) { u32x2* o = (u32x2*)(xn + (size_t)row * DM) + lane;
#pragma unroll
        for (int j = 0; j < 4; ++j) o[64 * j] = (u32x2){pk2(v[j].x * rstd, v[j].y * rstd), pk2(v[j].z * rstd, v[j].w * rstd)};
    } else { f32x4* o = (f32x4*)(outf + (size_t)row * DM) + lane; const f32x4* gg = (const f32x4*)g + lane;
#pragma unroll
        for (int j = 0; j < 4; ++j) { const f32x4 gv = gg[64 * j]; o[64 * j] = (f32x4){v[j].x * rstd * gv.x, v[j].y * rstd * gv.y, v[j].z * rstd * gv.z, v[j].w * rstd * gv.w}; } }
}

__device__ __forceinline__ void route_row(const Ptrs& P, int l, int row, int lane, const float* X, bf16* XN, unsigned* troute, float* tw, int* ltok, float* lw, unsigned* cnt) {
    const f32x4* xr = (const f32x4*)(X + (size_t)row * DM) + lane; f32x4 v[4]; float s = 0.f;
#pragma unroll
    for (int j = 0; j < 4; ++j) { v[j] = xr[64 * j]; s += v[j].x * v[j].x + v[j].y * v[j].y + v[j].z * v[j].z + v[j].w * v[j].w; }
    const float rstd = 1.f / sqrtf(wave_sum(s) * (1.f / DM) + RMS_EPS);
    u32x2* o = (u32x2*)(XN + (size_t)row * DM) + lane;
#pragma unroll
    for (int j = 0; j < 4; ++j) o[64 * j] = (u32x2){pk2(v[j].x * rstd, v[j].y * rstd), pk2(v[j].z * rstd, v[j].w * rstd)};
    const f32x4* gg = (const f32x4*)(P.ln2_g + l * DM) + lane;
#pragma unroll
    for (int j = 0; j < 4; ++j) { const f32x4 gv = gg[64 * j]; v[j] = (f32x4){v[j].x * rstd * gv.x, v[j].y * rstd * gv.y, v[j].z * rstd * gv.z, v[j].w * rstd * gv.w}; }
    const f32x4* wg = (const f32x4*)(P.w_rg + (size_t)l * DM * 4);
    f32x4 acc = (f32x4){0.f, 0.f, 0.f, 0.f};
#pragma unroll
    for (int j = 0; j < 4; ++j) { const int k = 4 * lane + 256 * j; acc += v[j].x * wg[k] + v[j].y * wg[k + 1] + v[j].z * wg[k + 2] + v[j].w * wg[k + 3]; }
    float gl[4];
#pragma unroll
    for (int e = 0; e < 4; ++e) gl[e] = wave_sum(acc[e]) + P.b_rg[l * 4 + e];
    int grp = 0; float gm = gl[0];
#pragma unroll
    for (int e = 1; e < 4; ++e) if (gl[e] > gm) { gm = gl[e]; grp = e; }
    float gs = 0.f;
#pragma unroll
    for (int e = 0; e < 4; ++e) gs += expf(gl[e] - gm);
    const float g1 = 1.f / gs;
    const f32x4* we = (const f32x4*)(P.w_re + ((size_t)l * 4 + grp) * DM * 4);
    acc = (f32x4){0.f, 0.f, 0.f, 0.f};
#pragma unroll
    for (int j = 0; j < 4; ++j) { const int k = 4 * lane + 256 * j; acc += v[j].x * we[k] + v[j].y * we[k + 1] + v[j].z * we[k + 2] + v[j].w * we[k + 3]; }
    float el[4];
#pragma unroll
    for (int e = 0; e < 4; ++e) el[e] = wave_sum(acc[e]) + P.b_re_[(l * 4 + grp) * 4 + e];
    int i1 = 0; float v1 = el[0];
#pragma unroll
    for (int e = 1; e < 4; ++e) if (el[e] > v1) { v1 = el[e]; i1 = e; }
    int i2 = -1; float v2 = -INFINITY;
#pragma unroll
    for (int e = 0; e < 4; ++e) if (e != i1 && el[e] > v2) { v2 = el[e]; i2 = e; }
    const float e2 = expf(v2 - v1); const float w1 = g1 / (1.f + e2), w2 = g1 * e2 / (1.f + e2);
    const int a = i1 < i2 ? i1 : i2, b = i1 < i2 ? i2 : i1; const float wa = i1 < i2 ? w1 : w2, wb = i1 < i2 ? w2 : w1;
    const int pair = (a == 0) ? (b - 1) : (a == 1 ? (b + 1) : 5);
    const int cls = grp * 6 + pair;
    if (lane == 0) {
        troute[row] = (unsigned)(grp * 4 + a) | ((unsigned)(grp * 4 + b) << 8) | ((unsigned)cls << 16);
        tw[2 * row] = wa; tw[2 * row + 1] = wb;
        const unsigned slot = atomicAdd(cnt + cls, 1u);
        ltok[(size_t)cls * NT + slot] = row; lw[((size_t)cls * NT + slot) * 2] = wa; lw[((size_t)cls * NT + slot) * 2 + 1] = wb;
    }
}
__global__ void __launch_bounds__(256) k_route(Ptrs P, int l) {
    const int lane = threadIdx.x & 63; const int row = blockIdx.x * 4 + (threadIdx.x >> 6); unsigned char* ws = P.ws;
    route_row(P, l, row, lane, P.out, (bf16*)(ws + WS_AB), (unsigned*)(ws + WS_TROUTE), (float*)(ws + WS_TW), (int*)(ws + WS_LTOK), (float*)(ws + WS_LW), (unsigned*)(ws + WS_CTL) + CW_CNT + l * 32);
}

__device__ __forceinline__ void mix_row(int row, int lane, const bf16* OB, const float* LSE, const bf16* SSMO, bf16* AB) {
    const int h = lane >> 3;
    float ls[3], m = -INFINITY;
#pragma unroll
    for (int b = 0; b < 3; ++b) { ls[b] = LSE[((size_t)b * NT + row) * NH + h]; m = fmaxf(m, ls[b]); }
    float w[3], ws_ = 0.f;
#pragma unroll
    for (int b = 0; b < 3; ++b) { w[b] = expf(ls[b] - m); ws_ += w[b]; }
    float o[8];
#pragma unroll
    for (int i = 0; i < 8; ++i) o[i] = 0.f;
#pragma unroll
    for (int b = 0; b < 3; ++b) { const u32x4 q = *((const u32x4*)(OB + ((size_t)b * NT + row) * AW) + lane); const float wb = w[b] / ws_;
        o[0] += wb * bf2f(q.x & 0xffffu); o[1] += wb * bf2f(q.x >> 16); o[2] += wb * bf2f(q.y & 0xffffu); o[3] += wb * bf2f(q.y >> 16);
        o[4] += wb * bf2f(q.z & 0xffffu); o[5] += wb * bf2f(q.z >> 16); o[6] += wb * bf2f(q.w & 0xffffu); o[7] += wb * bf2f(q.w >> 16); }
    float s = 0.f;
#pragma unroll
    for (int i = 0; i < 8; ++i) s += o[i] * o[i];
    float rstd = 1.f / sqrtf(wave_sum(s) * (1.f / AW) + RMS_EPS);
    *((u32x4*)(AB + (size_t)row * DM) + lane) = (u32x4){pk2(o[0] * rstd, o[1] * rstd), pk2(o[2] * rstd, o[3] * rstd), pk2(o[4] * rstd, o[5] * rstd), pk2(o[6] * rstd, o[7] * rstd)};
    const u32x4 q = *((const u32x4*)(SSMO + (size_t)row * SW) + lane);
    o[0] = bf2f(q.x & 0xffffu); o[1] = bf2f(q.x >> 16); o[2] = bf2f(q.y & 0xffffu); o[3] = bf2f(q.y >> 16); o[4] = bf2f(q.z & 0xffffu); o[5] = bf2f(q.z >> 16); o[6] = bf2f(q.w & 0xffffu); o[7] = bf2f(q.w >> 16);
    s = 0.f;
#pragma unroll
    for (int i = 0; i < 8; ++i) s += o[i] * o[i];
    rstd = 1.f / sqrtf(wave_sum(s) * (1.f / SW) + RMS_EPS);
    *((u32x4*)(AB + (size_t)row * DM + AW) + lane) = (u32x4){pk2(o[0] * rstd, o[1] * rstd), pk2(o[2] * rstd, o[3] * rstd), pk2(o[4] * rstd, o[5] * rstd), pk2(o[6] * rstd, o[7] * rstd)};
}
__global__ void __launch_bounds__(256) k_mix(Ptrs P) {
    const int lane = threadIdx.x & 63; const int row = blockIdx.x * 4 + (threadIdx.x >> 6); unsigned char* ws = P.ws;
    mix_row(row, lane, (const bf16*)(ws + WS_OB), (const float*)(ws + WS_LSE), (const bf16*)(ws + WS_SSMO), (bf16*)(ws + WS_AB));
}

template <int EPI> __global__ void __launch_bounds__(256) nv_gemm(const bf16* A, int lda, const bf16* Bt, int ldb, int K, bf16* Cb, float* Cf, int ldc, const bf16* auxb, const float* base) {
    __shared__ float As[16][65], Bs[16][65];
    const int tx = threadIdx.x & 15, ty = threadIdx.x >> 4; const int m0 = blockIdx.y * 64, n0 = blockIdx.x * 64;
    float acc[4][4];
#pragma unroll
    for (int i = 0; i < 4; ++i)
#pragma unroll
        for (int j = 0; j < 4; ++j) acc[i][j] = 0.f;
    for (int k0 = 0; k0 < K; k0 += 16) {
#pragma unroll
        for (int i = 0; i < 4; ++i) { const int idx = threadIdx.x + 256 * i, r = idx >> 4, c = idx & 15;
            As[c][r] = bf2f(A[(size_t)(m0 + r) * lda + k0 + c]); Bs[c][r] = bf2f(Bt[(size_t)(n0 + r) * ldb + k0 + c]); }
        __syncthreads();
#pragma unroll
        for (int kk = 0; kk < 16; ++kk) { float a[4], b[4];
#pragma unroll
            for (int i = 0; i < 4; ++i) { a[i] = As[kk][ty * 4 + i]; b[i] = Bs[kk][tx * 4 + i]; }
#pragma unroll
            for (int i = 0; i < 4; ++i)
#pragma unroll
                for (int j = 0; j < 4; ++j) acc[i][j] += a[i] * b[j]; }
        __syncthreads();
    }
#pragma unroll
    for (int i = 0; i < 4; ++i)
#pragma unroll
        for (int j = 0; j < 4; ++j) { const int m = m0 + ty * 4 + i, n = n0 + tx * 4 + j; const size_t o = (size_t)m * ldc + n;
            if (EPI == 0) Cb[o] = (bf16)f2bf(acc[i][j]);
            else if (EPI == 1) Cb[o] = (bf16)f2bf(bf2f(auxb[o]) * sigmoidf_(acc[i][j]));
            else Cf[o] = base[o] + acc[i][j]; }
}

__global__ void __launch_bounds__(64) nv_attn(const bf16* PROJ, bf16* OB, float* LSE) {
    const int gid = blockIdx.x * 64 + threadIdx.x; const int t = gid / NH, h = gid % NH; const int b = t / SEQ, s = t % SEQ;
    float q[HD];
    const bf16* qp = PROJ + (size_t)t * INW + h * HD;
#pragma unroll
    for (int d = 0; d < HD; ++d) q[d] = bf2f(qp[d]) * 0.125f;
    for (int br = 0; br < 3; ++br) { const int dil = br == 0 ? 1 : (br == 1 ? 4 : 16); const int m = s / dil, r = s % dil; const int mlo = m - 128 > 0 ? m - 128 : 0;
        float o[HD]; float mx = -INFINITY, l = 0.f;
#pragma unroll
        for (int d = 0; d < HD; ++d) o[d] = 0.f;
        for (int mm = mlo; mm <= m; ++mm) { const size_t tk = (size_t)b * SEQ + (size_t)mm * dil + r; const bf16* kp = PROJ + tk * INW + AW + h * HD; const bf16* vp = PROJ + tk * INW + 2 * AW + h * HD;
            float sc = 0.f;
#pragma unroll
            for (int d = 0; d < HD; ++d) sc += q[d] * bf2f(kp[d]);
            const float mn = fmaxf(mx, sc), f = expf(mx - mn), p = expf(sc - mn); l = l * f + p;
#pragma unroll
            for (int d = 0; d < HD; ++d) o[d] = o[d] * f + p * bf2f(vp[d]);
            mx = mn; }
        const float il = 1.f / l; bf16* op = OB + ((size_t)br * NT + t) * AW + h * HD;
#pragma unroll
        for (int d = 0; d < HD; ++d) op[d] = (bf16)f2bf(o[d] * il);
        LSE[((size_t)br * NT + t) * NH + h] = mx + logf(l); }
}

__global__ void __launch_bounds__(64) nv_ssm(Ptrs P, int l) {
    const int b = blockIdx.x / NG, g = blockIdx.x % NG, p = threadIdx.x; const int lg = l * NG + g; unsigned char* ws = P.ws;
    const bf16* PROJ = (const bf16*)(ws + WS_PROJ); bf16* YG = (bf16*)(ws + WS_YG);
    const float dt = expf(P.log_dt[lg]); const float lr = P.lam_re[(size_t)lg * NP + p], li = P.lam_im[(size_t)lg * NP + p];
    const float mg = expf(lr * dt); float sn, cs; sincosf(li * dt, &sn, &cs); const float ar = mg * cs, ai = mg * sn;
    const float nr = ar - 1.f, ni = ai, den = 1.f / (lr * lr + li * li); const float qr = (nr * lr + ni * li) * den, qi = (ni * lr - nr * li) * den;
    float bbr[GC], bbi[GC], cr[GC], ci[GC];
#pragma unroll
    for (int h = 0; h < GC; ++h) { const float br = P.b_re[((size_t)lg * NP + p) * GC + h], bi = P.b_im[((size_t)lg * NP + p) * GC + h]; bbr[h] = qr * br - qi * bi; bbi[h] = qr * bi + qi * br;
        cr[h] = P.c_re[((size_t)lg * GC + h) * NP + p]; ci[h] = P.c_im[((size_t)lg * GC + h) * NP + p]; }
    const float dsk = p < GC ? P.d_skip[(size_t)lg * GC + p] : 0.f;
    float sr = 0.f, si = 0.f;
    for (int t = 0; t < SEQ; ++t) { const size_t tok = (size_t)b * SEQ + t;
        const float um = p < GC ? bf2f(PROJ[tok * INW + 3 * AW + g * GC + p]) : 0.f;
        float bur = 0.f, bui = 0.f;
#pragma unroll
        for (int h = 0; h < GC; ++h) { const float u = __shfl(um, h); bur += bbr[h] * u; bui += bbi[h] * u; }
        const float nsr = ar * sr - ai * si + bur, nsi = ar * si + ai * sr + bui; sr = nsr; si = nsi;
        float yv = 0.f;
#pragma unroll
        for (int h = 0; h < GC; ++h) { const float v = wave_sum(cr[h] * sr - ci[h] * si); if (p == h) yv = v; }
        if (p < GC) YG[tok * SW + g * GC + p] = (bf16)f2bf(gelu_tanh(yv + dsk * um)); }
}

__global__ void __launch_bounds__(256) nv_moe(Ptrs P, int l) {
    __shared__ float sh[DM]; __shared__ float sa[2][EFF];
    const int t = blockIdx.x, tid = threadIdx.x; unsigned char* ws = P.ws;
    const bf16* XN = (const bf16*)(ws + WS_AB) + (size_t)t * DM;
    for (int i = tid; i < DM; i += 256) sh[i] = bf2f(XN[i]);
    __syncthreads();
    const unsigned rt = ((const unsigned*)(ws + WS_TROUTE))[t]; const int ex[2] = {(int)(rt & 255u), (int)((rt >> 8) & 255u)}; const float* tw = (const float*)(ws + WS_TW) + 2 * t;
#pragma unroll
    for (int q = 0; q < 2; ++q) { const int f = tid; const bf16* wg = (const bf16*)(ws + WS_WGU) + (((size_t)l * NE + ex[q]) * 512 + (f / 128) * 256 + (f % 128)) * DM; const bf16* wu = wg + (size_t)128 * DM;
        float hg = 0.f, hu = 0.f;
        for (int k = 0; k < DM; ++k) { hg += sh[k] * bf2f(wg[k]); hu += sh[k] * bf2f(wu[k]); }
        sa[q][f] = bf2f(f2bf(hg * sigmoidf_(hg) * hu * tw[q])); }
    __syncthreads();
    for (int j = 0; j < 4; ++j) { const int n = tid + 256 * j; float o = 0.f;
#pragma unroll
        for (int q = 0; q < 2; ++q) { const bf16* wd = (const bf16*)(ws + WS_WD) + (((size_t)l * NE + ex[q]) * DM + n) * EFF; for (int f = 0; f < EFF; ++f) o += sa[q][f] * bf2f(wd[f]); }
        P.out[(size_t)t * DM + n] += o; }
}


namespace pg8 {
typedef short bf16x8 __attribute__((ext_vector_type(8)));
constexpr int BM = 256, BK = 64, HALF = 128, HTB = HALF * BK * 2, STAGE_BYTES = 8 * HTB, NXCD = 8, WGM = 8;
__host__ __device__ __forceinline__ int lds_byte(int r, int c) { const int st = (r >> 4) * 2 + (c >> 5), rr = r & 15, cc = c & 31, ob = rr * 64 + cc * 2; return st * 1024 + (ob ^ (((ob >> 9) & 1) << 5)); }
__host__ __device__ __forceinline__ void stage_rc(int b, int& R, int& C) { const int st = b / 1024, sb = b % 1024, swz = sb ^ (((sb >> 9) & 1) << 5); R = (st >> 1) * 16 + swz / 64; C = (st & 1) * 32 + (swz % 64) / 2; }
__host__ __device__ __forceinline__ int perm32(int rho) { const int n = rho >> 4, i = rho & 15; return 8 * (i >> 2) + 4 * n + (i & 3); }
struct Unit { int pm, pn; const char* a; const char* b0; const char* b1; int x0, x1, x2, x3; };
__device__ __forceinline__ bool static_order(int nM, int nN, int G, int c, int i, int& pm, int& pn) {
    const int nwg = nM * nN; const long L = (long)i * G + c; if (L >= nwg) return false;
    int wgid = (int)L; { const int q = nwg / NXCD, r = nwg % NXCD, xcd = wgid % NXCD, off = wgid / NXCD; wgid = (xcd < r ? xcd * (q + 1) : r * (q + 1) + (xcd - r) * q) + off; }
    const int nig = WGM * nN, gid = wgid / nig, fm = gid * WGM, gsz = (nM - fm) < WGM ? (nM - fm) : WGM;
    pm = fm + ((wgid % nig) % gsz); pn = (wgid % nig) / gsz; return true;
}
__device__ __forceinline__ unsigned cvt_pk_bf16(float lo, float hi) { unsigned r; asm volatile("v_cvt_pk_bf16_f32 %0, %1, %2" : "=v"(r) : "v"(lo), "v"(hi)); return r; }
template <class Epi, class Sched, bool GATHER, bool ALIGN_EPI>
__device__ __forceinline__ void gemm_phase(LAS unsigned char* lds, const int lda, const int ldb, const int K, const int ksplit, const Sched& S, const Epi& E) {
    const int tid = threadIdx.x, wid = __builtin_amdgcn_readfirstlane(tid >> 6), lane = tid & 63, wr = wid >> 2, wc = wid & 3, fr = lane & 15, fq = lane >> 4;
    const int nt = K / BK;
    int Rr[2], Cc[2]; unsigned voffB[2], cvA0[2], cvA1[2], nvA0[2], nvA1[2];
#pragma unroll
    for (int i = 0; i < 2; ++i) { stage_rc(tid * 16 + i * 8192, Rr[i], Cc[i]); const int Rb = Epi::PERM ? ((Rr[i] & ~31) + perm32(Rr[i] & 31)) : Rr[i]; voffB[i] = (unsigned)(Rb * ldb + Cc[i]) * 2u; }
    const size_t kstep = (size_t)(BK * 2);
    const size_t hstepB = (size_t)HALF * ldb * 2;
    const unsigned ldsw = (unsigned)wid * 1024u;
    const int aoff = lds_byte(wr * 64 + fr, fq * 8), boff = lds_byte(wc * 32 + fr, fq * 8);
#define PG8_SA(b, h) (((b) * 2 + (h)) * HTB)
#define PG8_SB(b, h) ((4 + (b) * 2 + (h)) * HTB)
#define PG8_STAGE(bufoff, gbase, voff) do { _Pragma("unroll") for (int _i = 0; _i < 2; ++_i) \
        __builtin_amdgcn_global_load_lds((const unsigned*)((const char*)(gbase) + (voff)[_i]), (LAS unsigned*)(lds + (bufoff) + ldsw + _i * 8192), 16, 0, 0); } while (0)
#define PG8_LDA(dst, b, h) do { _Pragma("unroll") for (int m = 0; m < 4; ++m) _Pragma("unroll") for (int k = 0; k < 2; ++k) dst[m][k] = *(const LAS bf16x8*)(lds + PG8_SA(b, h) + aoff + m * 2048 + k * 1024); } while (0)
#define PG8_LDB(dst, b, h) do { _Pragma("unroll") for (int n = 0; n < 2; ++n) _Pragma("unroll") for (int k = 0; k < 2; ++k) dst[n][k] = *(const LAS bf16x8*)(lds + PG8_SB(b, h) + boff + n * 2048 + k * 1024); } while (0)
#define PG8_MMA(ai, bj, At, Bt) do { __builtin_amdgcn_s_setprio(1); _Pragma("unroll") for (int m = 0; m < 4; ++m) _Pragma("unroll") for (int n = 0; n < 2; ++n) _Pragma("unroll") for (int k = 0; k < 2; ++k) \
        acc[ai][bj][m][n] = __builtin_amdgcn_mfma_f32_16x16x32_bf16(Bt[n][k], At[m][k], acc[ai][bj][m][n], 0, 0, 0); __builtin_amdgcn_s_setprio(0); } while (0)
#define PG8_WAIT_V(n) asm volatile("s_waitcnt vmcnt(" #n ")" ::: "memory")
#define PG8_WAIT_L(n) asm volatile("s_waitcnt lgkmcnt(" #n ")" ::: "memory")
#define PG8_BAR __builtin_amdgcn_s_barrier()
#define PG8_SCHED __builtin_amdgcn_sched_barrier(0)
#define PG8_BP(u, tile) (((tile) < ksplit ? (u).b0 : (u).b1) + (size_t)(tile) * kstep)
#define PG8_SETA(u, v0, v1) do { _Pragma("unroll") for (int _i = 0; _i < 2; ++_i) { \
        if (GATHER) { v0[_i] = S.rowoff(u, Rr[_i]) + (unsigned)Cc[_i] * 2u; v1[_i] = S.rowoff(u, HALF + Rr[_i]) + (unsigned)Cc[_i] * 2u; } \
        else { v0[_i] = (unsigned)(Rr[_i] * lda + Cc[_i]) * 2u; v1[_i] = v0[_i] + (unsigned)(HALF * lda * 2); } } } while (0)
    Unit cur, nxt; int ui = 0;
    if (!S.next(0, cur)) return;
    PG8_SETA(cur, cvA0, cvA1);
    f32x4 acc[2][2][4][2];
#pragma unroll
    for (int a = 0; a < 2; ++a)
#pragma unroll
        for (int b = 0; b < 2; ++b)
#pragma unroll
            for (int m = 0; m < 4; ++m)
#pragma unroll
                for (int n = 0; n < 2; ++n) acc[a][b][m][n] = (f32x4){0.f, 0.f, 0.f, 0.f};
    bf16x8 At[4][2], B0[2][2], B1[2][2];
    {   const char* cB = PG8_BP(cur, 0); const char* cB1 = PG8_BP(cur, 1);
        PG8_STAGE(PG8_SB(0, 0), cB, voffB); PG8_STAGE(PG8_SB(0, 1), cB + hstepB, voffB); PG8_STAGE(PG8_SA(0, 0), cur.a, cvA0); PG8_STAGE(PG8_SA(0, 1), cur.a, cvA1);
        if (wr == 1) PG8_BAR;
        PG8_WAIT_V(2); PG8_BAR;
        PG8_STAGE(PG8_SB(1, 0), cB1, voffB); PG8_STAGE(PG8_SA(1, 0), cur.a + kstep, cvA0); PG8_STAGE(PG8_SB(1, 1), cB1 + hstepB, voffB);
        PG8_WAIT_V(6); PG8_BAR; }
    for (;;) {
        const bool has_next = S.next(ui + 1, nxt);
        if (has_next) { PG8_SETA(nxt, nvA0, nvA1); } else {
#pragma unroll
            for (int i = 0; i < 2; ++i) { nvA0[i] = cvA0[i]; nvA1[i] = cvA1[i]; } }
        const char* nA = has_next ? nxt.a : cur.a; const char* nB = has_next ? PG8_BP(nxt, 0) : PG8_BP(cur, 0);
        for (int t = 0; t < nt; t += 2) {
            const bool last = (t == nt - 2);
            const char* a1 = cur.a + (size_t)(t + 1) * kstep;
            const char* a2 = last ? nA : cur.a + (size_t)(t + 2) * kstep; const char* b2 = last ? nB : PG8_BP(cur, t + 2);
            const char* a3 = a2 + kstep; const char* b3 = b2 + kstep;
            unsigned vo0[2], vo1[2];
#pragma unroll
            for (int i = 0; i < 2; ++i) { vo0[i] = last ? nvA0[i] : cvA0[i]; vo1[i] = last ? nvA1[i] : cvA1[i]; }
            PG8_LDB(B0, 0, 0); PG8_LDB(B1, 0, 1); PG8_SCHED; PG8_LDA(At, 0, 0); PG8_STAGE(PG8_SA(1, 1), a1, cvA1);
            PG8_WAIT_V(8); PG8_WAIT_L(0); PG8_BAR; PG8_MMA(0, 0, At, B0); PG8_MMA(0, 1, At, B1); PG8_BAR; PG8_SCHED;
            PG8_LDA(At, 0, 1); PG8_STAGE(PG8_SB(0, 0), b2, voffB); PG8_STAGE(PG8_SB(0, 1), b2 + hstepB, voffB); PG8_STAGE(PG8_SA(0, 0), a2, vo0);
            PG8_WAIT_V(8); PG8_WAIT_L(0); PG8_BAR; PG8_MMA(1, 0, At, B0); PG8_MMA(1, 1, At, B1); PG8_BAR; PG8_SCHED;
            PG8_LDB(B0, 1, 0); PG8_LDB(B1, 1, 1); PG8_SCHED; PG8_LDA(At, 1, 0); PG8_STAGE(PG8_SA(0, 1), a2, vo1);
            PG8_WAIT_V(8); PG8_WAIT_L(0); PG8_BAR; PG8_MMA(0, 0, At, B0); PG8_MMA(0, 1, At, B1); PG8_BAR; PG8_SCHED;
            PG8_LDA(At, 1, 1); PG8_STAGE(PG8_SB(1, 0), b3, voffB); PG8_STAGE(PG8_SB(1, 1), b3 + hstepB, voffB); PG8_STAGE(PG8_SA(1, 0), a3, vo0);
            PG8_WAIT_V(8); PG8_WAIT_L(0); PG8_BAR; PG8_MMA(1, 0, At, B0); PG8_MMA(1, 1, At, B1); PG8_BAR; PG8_SCHED;
        }
        if constexpr (ALIGN_EPI) { if (wr == 0) PG8_BAR; }
        E(acc, cur, wr, wc, fr, fq);
        if (!has_next) break;
#pragma unroll
        for (int a = 0; a < 2; ++a)
#pragma unroll
            for (int b = 0; b < 2; ++b)
#pragma unroll
                for (int m = 0; m < 4; ++m)
#pragma unroll
                    for (int n = 0; n < 2; ++n) acc[a][b][m][n] = (f32x4){0.f, 0.f, 0.f, 0.f};
        cur = nxt; ++ui;
#pragma unroll
        for (int i = 0; i < 2; ++i) { cvA0[i] = nvA0[i]; cvA1[i] = nvA1[i]; }
        if constexpr (ALIGN_EPI) { if (wr == 1) PG8_BAR; }
    }
    PG8_WAIT_V(0);
    if constexpr (!ALIGN_EPI) { if (wr == 0) PG8_BAR; }
    PG8_BAR;
#undef PG8_SA
#undef PG8_SB
#undef PG8_STAGE
#undef PG8_LDA
#undef PG8_LDB
#undef PG8_MMA
#undef PG8_WAIT_V
#undef PG8_WAIT_L
#undef PG8_BAR
#undef PG8_SCHED
#undef PG8_BP
#undef PG8_SETA
}

struct DenseSched {
    const char* A; const char* Bt; int nM, nN, G, c; size_t atile, btile;
    __device__ __forceinline__ bool next(int i, Unit& u) const { int pm, pn; if (!static_order(nM, nN, G, c, i, pm, pn)) return false;
        u.pm = pm; u.pn = pn; u.a = A + (size_t)pm * atile; u.b0 = Bt + (size_t)pn * btile; u.b1 = u.b0; u.x0 = u.x1 = u.x2 = u.x3 = 0; return true; }
    __device__ __forceinline__ unsigned rowoff(const Unit&, int) const { return 0u; }
};
struct EpiStoreBf16 {
    static constexpr bool PERM = true; bf16* C; int ldc;
    __device__ __forceinline__ void operator()(const f32x4 (&acc)[2][2][4][2], const Unit& u, int wr, int wc, int fr, int fq) const {
        const int row0 = u.pm * BM + wr * 64 + fr, col0 = u.pn * BM + wc * 32 + 8 * fq;
#pragma unroll
        for (int ai = 0; ai < 2; ++ai)
#pragma unroll
            for (int m = 0; m < 4; ++m) { bf16* rowp = C + (size_t)(row0 + ai * HALF + m * 16) * ldc + col0;
#pragma unroll
                for (int bj = 0; bj < 2; ++bj) { const f32x4 v0 = acc[ai][bj][m][0], v1 = acc[ai][bj][m][1];
                    *(u32x4*)(rowp + bj * HALF) = (u32x4){cvt_pk_bf16(v0[0], v0[1]), cvt_pk_bf16(v0[2], v0[3]), cvt_pk_bf16(v1[0], v1[1]), cvt_pk_bf16(v1[2], v1[3])}; } }
    }
};
struct EpiGlu {
    static constexpr bool PERM = true; bf16* C; const bf16* aux; int ldc;
    __device__ __forceinline__ void operator()(const f32x4 (&acc)[2][2][4][2], const Unit& u, int wr, int wc, int fr, int fq) const {
        const int row0 = u.pm * BM + wr * 64 + fr, col0 = u.pn * BM + wc * 32 + 8 * fq;
#pragma unroll
        for (int ai = 0; ai < 2; ++ai)
#pragma unroll
            for (int m = 0; m < 4; ++m) { const size_t ro = (size_t)(row0 + ai * HALF + m * 16) * ldc + col0;
#pragma unroll
                for (int bj = 0; bj < 2; ++bj) { const f32x4 v0 = acc[ai][bj][m][0], v1 = acc[ai][bj][m][1]; const u32x4 y = *(const u32x4*)(aux + ro + bj * HALF);
                    float r[8]; r[0] = bf2f(y.x & 0xffffu) * sigmoidf_(v0[0]); r[1] = bf2f(y.x >> 16) * sigmoidf_(v0[1]); r[2] = bf2f(y.y & 0xffffu) * sigmoidf_(v0[2]); r[3] = bf2f(y.y >> 16) * sigmoidf_(v0[3]);
                    r[4] = bf2f(y.z & 0xffffu) * sigmoidf_(v1[0]); r[5] = bf2f(y.z >> 16) * sigmoidf_(v1[1]); r[6] = bf2f(y.w & 0xffffu) * sigmoidf_(v1[2]); r[7] = bf2f(y.w >> 16) * sigmoidf_(v1[3]);
                    *(u32x4*)(C + ro + bj * HALF) = (u32x4){cvt_pk_bf16(r[0], r[1]), cvt_pk_bf16(r[2], r[3]), cvt_pk_bf16(r[4], r[5]), cvt_pk_bf16(r[6], r[7])}; } }
    }
};
struct EpiResid {
    static constexpr bool PERM = false; float* C; const float* base; int ldc;
    __device__ __forceinline__ void operator()(const f32x4 (&acc)[2][2][4][2], const Unit& u, int wr, int wc, int fr, int fq) const {
        const int row0 = u.pm * BM + wr * 64 + fr, col0 = u.pn * BM + wc * 32 + 4 * fq;
#pragma unroll
        for (int ai = 0; ai < 2; ++ai)
#pragma unroll
            for (int m = 0; m < 4; ++m) { const size_t ro = (size_t)(row0 + ai * HALF + m * 16) * ldc + col0;
#pragma unroll
                for (int bj = 0; bj < 2; ++bj)
#pragma unroll
                    for (int n = 0; n < 2; ++n) { const f32x4 bs = *(const f32x4*)(base + ro + bj * HALF + n * 16); *(f32x4*)(C + ro + bj * HALF + n * 16) = bs + acc[ai][bj][m][n]; } }
    }
};

__device__ __forceinline__ void moe_build_prefix(LAS int* tpre, const unsigned* cnt) {
    if (threadIdx.x == 0) { int s = 0; for (int c = 0; c < NCLS; ++c) { tpre[c] = s; s += ((int)cnt[c] + 255) >> 8; } tpre[NCLS] = s; }
    __syncthreads();
}
__device__ __forceinline__ void pair_decode(int pair, int& a, int& b) { a = pair < 3 ? 0 : (pair < 5 ? 1 : 2); b = pair < 3 ? pair + 1 : (pair < 5 ? pair - 1 : 3); }
struct MoeSched {
    const LAS int* tpre; const unsigned* cnt; const int* ltok; const char* A; const char* W; int G, c, l, up;
    __device__ __forceinline__ bool next(int i, Unit& u) const {
        const int MT = __builtin_amdgcn_readfirstlane(tpre[NCLS]); int pm, pn; if (!static_order(MT, 4, G, c, i, pm, pn)) return false;
        int cls = 0;
#pragma unroll 1
        for (int q = 1; q < NCLS; ++q) if (pm >= __builtin_amdgcn_readfirstlane(tpre[q])) cls = q;
        const int grp = cls / 6; int ea, eb; pair_decode(cls % 6, ea, eb); ea += grp * 4; eb += grp * 4;
        u.pm = pm; u.pn = pn; u.x0 = cls; u.x1 = (pm - __builtin_amdgcn_readfirstlane(tpre[cls])) * 256; u.x2 = __builtin_amdgcn_readfirstlane((int)cnt[cls]); u.x3 = 0;
        if (up) { const int e = pn < 2 ? ea : eb; u.a = A; u.b0 = W + ((size_t)((l * NE + e) * 2 + (pn & 1))) * 256 * DM * 2; u.b1 = u.b0; }
        else { u.a = A + (size_t)pm * 256 * 512 * 2; u.b0 = W + ((size_t)(l * NE + ea) * DM + pn * 256) * EFF * 2; u.b1 = W + ((size_t)(l * NE + eb) * DM + pn * 256) * EFF * 2 - 4 * 128; }
        return true;
    }
    __device__ __forceinline__ unsigned rowoff(const Unit& u, int r) const { int i = u.x1 + r; i = i < u.x2 ? i : u.x2 - 1; return (unsigned)ltok[(size_t)u.x0 * NT + i] * (unsigned)(DM * 2); }
};
struct EpiMoeUp {
    static constexpr bool PERM = true; bf16* ACT; const float* lw;
    __device__ __forceinline__ void operator()(const f32x4 (&acc)[2][2][4][2], const Unit& u, int wr, int wc, int fr, int fq) const {
        const int col0 = (u.pn >> 1) * 256 + (u.pn & 1) * 128 + wc * 32 + 8 * fq;
#pragma unroll
        for (int ai = 0; ai < 2; ++ai)
#pragma unroll
            for (int m = 0; m < 4; ++m) { const int r = ai * HALF + wr * 64 + m * 16 + fr; int i = u.x1 + r; i = i < u.x2 ? i : u.x2 - 1;
                const float w = lw[((size_t)u.x0 * NT + i) * 2 + (u.pn >> 1)];
                const f32x4 g0 = acc[ai][0][m][0], g1 = acc[ai][0][m][1], u0 = acc[ai][1][m][0], u1 = acc[ai][1][m][1]; float v[8];
#pragma unroll
                for (int j = 0; j < 4; ++j) { v[j] = g0[j] * sigmoidf_(g0[j]) * u0[j] * w; v[4 + j] = g1[j] * sigmoidf_(g1[j]) * u1[j] * w; }
                *(u32x4*)(ACT + (size_t)(u.pm * BM + r) * 512 + col0) = (u32x4){cvt_pk_bf16(v[0], v[1]), cvt_pk_bf16(v[2], v[3]), cvt_pk_bf16(v[4], v[5]), cvt_pk_bf16(v[6], v[7])}; }
    }
};
struct EpiMoeDown {
    static constexpr bool PERM = false; float* X; const int* ltok;
    __device__ __forceinline__ void operator()(const f32x4 (&acc)[2][2][4][2], const Unit& u, int wr, int wc, int fr, int fq) const {
        const int col0 = u.pn * BM + wc * 32 + 4 * fq;
#pragma unroll
        for (int ai = 0; ai < 2; ++ai)
#pragma unroll
            for (int m = 0; m < 4; ++m) { const int r = ai * HALF + wr * 64 + m * 16 + fr; const int i = u.x1 + r;
                if (i < u.x2) { const int tok = ltok[(size_t)u.x0 * NT + i]; float* rowp = X + (size_t)tok * DM + col0;
#pragma unroll
                    for (int bj = 0; bj < 2; ++bj)
#pragma unroll
                        for (int n = 0; n < 2; ++n) { f32x4* p = (f32x4*)(rowp + bj * HALF + n * 16); *p = *p + acc[ai][bj][m][n]; } }
                asm volatile("" ::: "memory"); }
    }
};
}


namespace attn {
typedef short bf16x8 __attribute__((ext_vector_type(8)));
typedef short s16x4 __attribute__((ext_vector_type(4)));
typedef float f32x16 __attribute__((ext_vector_type(16)));
__device__ __forceinline__ unsigned cvtpk(float lo, float hi) { typedef float f2 __attribute__((ext_vector_type(2))); typedef __bf16 b2 __attribute__((ext_vector_type(2))); f2 v = {lo, hi}; b2 b = __builtin_convertvector(v, b2); return __builtin_bit_cast(unsigned, b); }
__device__ __forceinline__ s16x4 vtr(const LAS unsigned char* p) { return __builtin_bit_cast(s16x4, __builtin_amdgcn_ds_read_tr16_b64_v4i16((LAS s16x4*)p)); }
constexpr int N_ITEMS = NB * NH * 48, N_STEPS = N_ITEMS / 2;
__device__ __forceinline__ void attn_phase(LAS unsigned char* lds, const bf16* PROJ, bf16* OB, float* LSE, int G, int bx) {
    const int tid = threadIdx.x, lane = tid & 63, wid = __builtin_amdgcn_readfirstlane(tid >> 6), half = wid >> 2, w = wid & 3, tid4 = tid & 255;
    const int r32 = lane & 31, hi = lane >> 5;
    LAS unsigned char* Kt = lds + half * 65536;
    LAS unsigned char* Vt = Kt + 32768;
    for (int step = bx; step < N_STEPS; step += G) {
        const int it = step * 2 + half; const int bh = it / 48, rem = it % 48, br = rem >> 4, tile = rem & 15;
        const int b = bh >> 3, h = bh & 7;
        const int dil = br == 0 ? 1 : (br == 1 ? 4 : 16); const int rr = br == 0 ? 0 : (br == 1 ? (tile & 3) : tile); const int blk = br == 0 ? tile : (br == 1 ? (tile >> 2) : 0);
        const bool first = (blk == 0);
        const size_t tokbase = (size_t)b * SEQ;
#pragma unroll
        for (int j = 0; j < 8; ++j) { const int row = j * 32 + (tid4 >> 3), ch = tid4 & 7; const bool valid = !(first && row < 128);
            u32x4 kv = (u32x4){0u, 0u, 0u, 0u}, vv = (u32x4){0u, 0u, 0u, 0u};
            if (valid) { const int pos = dil * (128 * (blk - 1) + row) + rr; const bf16* src = PROJ + (tokbase + pos) * INW + AW + h * HD + ch * 8; kv = *(const u32x4*)src; vv = *(const u32x4*)(src + AW); }
            *(LAS u32x4*)(Kt + ch * 4096 + ((row ^ ch) * 16)) = kv;
            *(LAS u32x4*)(Vt + (ch >> 2) * 16384 + row * 64 + (ch & 3) * 16) = vv; }
        const int qrow = 32 * w + r32; const int qpos = dil * (128 * blk + qrow) + rr;
        const bf16* qp = PROJ + (tokbase + qpos) * INW + h * HD + hi * 8;
        bf16x8 qf[4];
#pragma unroll
        for (int d0 = 0; d0 < 4; ++d0) qf[d0] = *(const bf16x8*)(qp + d0 * 16);
        __syncthreads();
        const int kt_lo = first ? (4 - w) : 0;
        f32x16 p[5];
#pragma unroll
        for (int kt = 0; kt < 5; ++kt) { p[kt] = f32x16{};
            if (kt >= kt_lo) {
#pragma unroll
                for (int d0 = 0; d0 < 4; ++d0) { const int ch = 2 * d0 + hi; const int kpos = 32 * w + 32 * kt + r32;
                    const bf16x8 kf = *(const LAS bf16x8*)(Kt + ch * 4096 + ((kpos ^ ch) * 16));
                    p[kt] = __builtin_amdgcn_mfma_f32_32x32x16_bf16(kf, qf[d0], p[kt], 0, 0, 0); } } }
        const float SC = 0.125f * 1.4426950408889634f;
        float mx = -INFINITY;
#pragma unroll
        for (int kt = 0; kt < 5; ++kt) if (kt >= kt_lo) {
#pragma unroll
            for (int r = 0; r < 16; ++r) { const int c = (r & 3) + 8 * (r >> 2) + 4 * hi; bool ok = true; if (kt == 0) ok = (c >= r32); if (kt == 4) ok = (c <= r32);
                const float sv = ok ? p[kt][r] * SC : -INFINITY; p[kt][r] = sv; mx = fmaxf(mx, sv); } }
        mx = fmaxf(mx, __shfl_xor(mx, 32));
        float lsum = 0.f;
#pragma unroll
        for (int kt = 0; kt < 5; ++kt) if (kt >= kt_lo) {
#pragma unroll
            for (int r = 0; r < 16; ++r) { const float e = __builtin_amdgcn_exp2f(p[kt][r] - mx); p[kt][r] = e; lsum += e; } }
        lsum += __shfl_xor(lsum, 32);
        f32x16 o[2]; o[0] = f32x16{}; o[1] = f32x16{};
        const LAS unsigned char* vbase = Vt + (32 * w + 4 * hi + ((lane & 15) >> 2)) * 64 + ((lane >> 4) & 1) * 32 + (lane & 3) * 8;
#pragma unroll
        for (int kt = 0; kt < 5; ++kt) if (kt >= kt_lo) {
#pragma unroll
            for (int ks = 0; ks < 2; ++ks) {
                u32x4 pw; pw.x = cvtpk(p[kt][8 * ks + 0], p[kt][8 * ks + 1]); pw.y = cvtpk(p[kt][8 * ks + 2], p[kt][8 * ks + 3]); pw.z = cvtpk(p[kt][8 * ks + 4], p[kt][8 * ks + 5]); pw.w = cvtpk(p[kt][8 * ks + 6], p[kt][8 * ks + 7]);
                const bf16x8 pf = __builtin_bit_cast(bf16x8, pw);
#pragma unroll
                for (int dh = 0; dh < 2; ++dh) { const LAS unsigned char* va = vbase + dh * 16384 + (32 * kt + 16 * ks) * 64;
                    const s16x4 lo = vtr(va), hi8 = vtr(va + 512);
                    const bf16x8 vf = (bf16x8){lo[0], lo[1], lo[2], lo[3], hi8[0], hi8[1], hi8[2], hi8[3]};
                    o[dh] = __builtin_amdgcn_mfma_f32_32x32x16_bf16(vf, pf, o[dh], 0, 0, 0); } } }
        const float inv = 1.f / lsum; const size_t tok = tokbase + qpos;
        bf16* op = OB + ((size_t)br * NT + tok) * AW + h * HD + 4 * hi;
#pragma unroll
        for (int dh = 0; dh < 2; ++dh)
#pragma unroll
            for (int g4 = 0; g4 < 4; ++g4) *(u32x2*)(op + 32 * dh + 8 * g4) = (u32x2){cvtpk(o[dh][4 * g4] * inv, o[dh][4 * g4 + 1] * inv), cvtpk(o[dh][4 * g4 + 2] * inv, o[dh][4 * g4 + 3] * inv)};
        if (hi == 0) LSE[((size_t)br * NT + tok) * NH + h] = (mx + __builtin_amdgcn_logf(lsum)) * 0.6931471805599453f;
        __syncthreads();
    }
}
}

namespace ssm {
typedef short bf16x8 __attribute__((ext_vector_type(8)));
__device__ __forceinline__ void ssm_phase(LAS unsigned char* lds, unsigned char* ws, int l, int G, int bx) {
    typedef float f32x2 __attribute__((ext_vector_type(2)));
    const int tid = threadIdx.x, lane = tid & 63, wid = __builtin_amdgcn_readfirstlane(tid >> 6), nt4 = wid & 3, ih = wid >> 2;
    const bf16* PROJ = (const bf16*)(ws + WS_PROJ); bf16* YG = (bf16*)(ws + WS_YG);
    LAS float* Ef = (LAS float*)lds;
    LAS bf16* Sin = (LAS bf16*)(lds + 32768);
    LAS f32x2* Tot = (LAS f32x2*)(lds + 49152);
    for (int it = bx; it < NG * NB; it += G) {
        const int g = it % NG, b = it / NG, lg = l * NG + g;
        const bf16* Bmat = (const bf16*)(ws + WS_BMAT) + (size_t)lg * 128 * 512; const bf16* Cmat = (const bf16*)(ws + WS_CMAT) + (size_t)lg * 512 * 128;
        const bf16* Kt = (const bf16*)(ws + WS_KTAB) + (size_t)lg * 33 * 256; const float* LamL = (const float*)(ws + WS_LAML) + (size_t)lg * 128;
        const int c = 16 * nt4 + (lane & 15), jj = lane >> 5, h0 = 8 * ((lane >> 4) & 1);
        bf16x8 Uf[16];
        { const bf16* up = PROJ + ((size_t)b * SEQ + (size_t)c * CL + jj) * INW + 3 * AW + g * GC + h0;
#pragma unroll
          for (int ks = 0; ks < 16; ++ks) Uf[ks] = *(const bf16x8*)(up + (size_t)(2 * ks) * INW); }
#pragma unroll 1
        for (int mi = 0; mi < 4; ++mi) { const int m = ih * 4 + mi; f32x4 acc = (f32x4){0.f, 0.f, 0.f, 0.f};
            const bf16* ap = Bmat + (size_t)(16 * m + (lane & 15)) * 512 + 8 * (lane >> 4);
#pragma unroll
            for (int ks = 0; ks < 16; ++ks) { const bf16x8 af = *(const bf16x8*)(ap + 32 * ks); acc = __builtin_amdgcn_mfma_f32_16x16x32_bf16(af, Uf[ks], acc, 0, 0, 0); }
            *(LAS f32x4*)(Ef + c * 128 + 16 * m + 4 * (lane >> 4)) = acc; }
        __syncthreads();
        { const int p = tid & 63, seg = tid >> 6; const float ar = LamL[2 * p], ai = LamL[2 * p + 1];
          float lr[8], li[8]; float sr = 0.f, si = 0.f;
#pragma unroll
          for (int cc = 0; cc < 8; ++cc) { lr[cc] = sr; li[cc] = si; const int cidx = seg * 8 + cc; const float er = Ef[cidx * 128 + p], ei = Ef[cidx * 128 + 64 + p];
              const float nr = ar * sr - ai * si + er, ni = ar * si + ai * sr + ei; sr = nr; si = ni; }
          Tot[seg * 64 + p] = (f32x2){sr, si};
          float a8r = ar, a8i = ai;
#pragma unroll
          for (int q = 0; q < 3; ++q) { const float tr = a8r * a8r - a8i * a8i, ti = 2.f * a8r * a8i; a8r = tr; a8i = ti; }
          __syncthreads();
          float cr = 0.f, ci = 0.f;
          for (int s2 = 0; s2 < seg; ++s2) { const f32x2 t = Tot[s2 * 64 + p]; const float nr = a8r * cr - a8i * ci + t.x, ni = a8r * ci + a8i * cr + t.y; cr = nr; ci = ni; }
          float pr = 1.f, pi = 0.f;
#pragma unroll
          for (int cc = 0; cc < 8; ++cc) { const int cidx = seg * 8 + cc; const float vr = lr[cc] + pr * cr - pi * ci, vi = li[cc] + pr * ci + pi * cr;
              Sin[cidx * 128 + p] = (bf16)f2bf(vr); Sin[cidx * 128 + 64 + p] = (bf16)f2bf(vi);
              const float tr = pr * ar - pi * ai, ti = pr * ai + pi * ar; pr = tr; pi = ti; } }
        __syncthreads();
        bf16x8 Sf[4];
#pragma unroll
        for (int k2 = 0; k2 < 4; ++k2) Sf[k2] = *(const LAS bf16x8*)(Sin + c * 128 + 32 * k2 + 8 * (lane >> 4));
#pragma unroll 1
        for (int ii = 0; ii < 16; ++ii) { const int i = 2 * ii + ih; f32x4 acc = (f32x4){0.f, 0.f, 0.f, 0.f};
            const bf16* cp = Cmat + (size_t)(16 * i + (lane & 15)) * 128 + 8 * (lane >> 4);
#pragma unroll
            for (int k2 = 0; k2 < 4; ++k2) { const bf16x8 af = *(const bf16x8*)(cp + 32 * k2); acc = __builtin_amdgcn_mfma_f32_16x16x32_bf16(af, Sf[k2], acc, 0, 0, 0); }
            const bf16* kp = Kt + (size_t)(i - jj + 1) * 256 + (lane & 15) * 16 + h0;
#pragma unroll
            for (int ks = 0; ks < 16; ++ks) if (2 * ks <= i) { const bf16x8 af = *(const bf16x8*)(kp - (size_t)(2 * ks) * 256); acc = __builtin_amdgcn_mfma_f32_16x16x32_bf16(af, Uf[ks], acc, 0, 0, 0); }
            const size_t tok = (size_t)b * SEQ + (size_t)c * CL + i;
            *(u32x2*)(YG + tok * SW + g * GC + 4 * (lane >> 4)) = (u32x2){pk2(gelu_tanh(acc[0]), gelu_tanh(acc[1])), pk2(gelu_tanh(acc[2]), gelu_tanh(acc[3]))}; }
        __syncthreads();
    }
}
}

constexpr int MK_THREADS = 512, MK_LDS = 147456;
enum { ST_P0 = 0, ST_NORM = 1, ST_INPROJ = 2, ST_MIXERS = 3, ST_GLU = 4, ST_MIX = 5, ST_OUT = 6, ST_ROUTE = 7, ST_MOEUP = 8, ST_MOEDN = 9, ST_FINAL = 10 };
struct MkArgs { Ptrs P; int step, layer, pad0, pad1; };
__global__ void __launch_bounds__(MK_THREADS, 2) mk(MkArgs args) {
    extern __shared__ __attribute__((aligned(16))) unsigned char lds_raw[];
    LAS unsigned char* lds = (LAS unsigned char*)lds_raw;
    const Ptrs& P = args.P; unsigned char* ws = P.ws; const int l = args.layer;
    const int G = gridDim.x; const int bx = blockIdx.x;
    const float* xin = l == 0 ? P.x : P.out;
    switch (args.step) {
    case ST_INPROJ: { pg8::DenseSched S{(const char*)(ws + WS_AB), (const char*)(ws + WS_WIN) + (size_t)l * INW * DM * 2, NT / 256, INW / 256, G, bx, (size_t)256 * DM * 2, (size_t)256 * DM * 2};
        pg8::EpiStoreBf16 E{(bf16*)(ws + WS_PROJ), INW};
        pg8::gemm_phase<pg8::EpiStoreBf16, pg8::DenseSched, false, true>(lds, DM, DM, DM, DM / 64, S, E); } break;
    case ST_GLU: { pg8::DenseSched S{(const char*)(ws + WS_YG), (const char*)(ws + WS_WGLU) + (size_t)l * SW * SW * 2, NT / 256, SW / 256, G, bx, (size_t)256 * SW * 2, (size_t)256 * SW * 2};
        pg8::EpiGlu E{(bf16*)(ws + WS_SSMO), (const bf16*)(ws + WS_YG), SW};
        pg8::gemm_phase<pg8::EpiGlu, pg8::DenseSched, false, true>(lds, SW, SW, SW, SW / 64, S, E); } break;
    case ST_OUT: { pg8::DenseSched S{(const char*)(ws + WS_AB), (const char*)(ws + WS_WOUT) + (size_t)l * DM * DM * 2, NT / 256, DM / 256, G, bx, (size_t)256 * DM * 2, (size_t)256 * DM * 2};
        pg8::EpiResid E{P.out, xin, DM};
        pg8::gemm_phase<pg8::EpiResid, pg8::DenseSched, false, true>(lds, DM, DM, DM, DM / 64, S, E); } break;
    case ST_MIXERS: { if (args.pad0 & 1) attn::attn_phase(lds, (const bf16*)(ws + WS_PROJ), (bf16*)(ws + WS_OB), (float*)(ws + WS_LSE), G, bx);
        if (args.pad0 & 2) ssm::ssm_phase(lds, ws, l, G, bx); } break;
    case ST_MOEUP: { LAS int* tpre = (LAS int*)(lds + 131072); const unsigned* cnt = (const unsigned*)(ws + WS_CTL) + CW_CNT + l * 32; pg8::moe_build_prefix(tpre, cnt);
        pg8::MoeSched S{tpre, cnt, (const int*)(ws + WS_LTOK), (const char*)(ws + WS_AB), (const char*)(ws + WS_WGU), G, bx, l, 1};
        pg8::EpiMoeUp E{(bf16*)(ws + WS_ACT), (const float*)(ws + WS_LW)};
        pg8::gemm_phase<pg8::EpiMoeUp, pg8::MoeSched, true, true>(lds, DM, DM, DM, DM / 64, S, E); } break;
    case ST_MOEDN: { LAS int* tpre = (LAS int*)(lds + 131072); const unsigned* cnt = (const unsigned*)(ws + WS_CTL) + CW_CNT + l * 32; pg8::moe_build_prefix(tpre, cnt);
        pg8::MoeSched S{tpre, cnt, (const int*)(ws + WS_LTOK), (const char*)(ws + WS_ACT), (const char*)(ws + WS_WD), G, bx, l, 0};
        pg8::EpiMoeDown E{P.out, (const int*)(ws + WS_LTOK)};
        pg8::gemm_phase<pg8::EpiMoeDown, pg8::MoeSched, false, true>(lds, 512, EFF, 512, 4, S, E); } break;
    default: break;
    }
}

#ifndef FAST_INPROJ
#define FAST_INPROJ 1
#endif
#ifndef FAST_GLU
#define FAST_GLU 1
#endif
#ifndef FAST_MOE
#define FAST_MOE 1
#endif
#ifndef FAST_ATTN
#define FAST_ATTN 1
#endif
#ifndef FAST_SSM
#define FAST_SSM 1
#endif
#ifndef FAST_OUT
#define FAST_OUT 1
#endif
extern "C" void kernel_launch(void* const* d_in, const int* in_sizes, int n_in, void* d_out, int out_size, void* d_ws, size_t ws_size, hipStream_t stream) {
    if (n_in != 24 || out_size != NT * DM || ws_size < WS_END) { fprintf(stderr, "kernel_launch: unexpected shapes n_in %d out %d ws %zu (need %zu)\n", n_in, out_size, ws_size, (size_t)WS_END); return; }
    Ptrs P{};
    const float** pf = (const float**)&P;
    for (int i = 0; i < 24; ++i) pf[i] = (const float*)d_in[i];
    P.out = (float*)d_out; P.ws = (unsigned char*)d_ws;
    unsigned char* ws = P.ws;
    static bool attr_set = false;
    if (!attr_set) { if (hipFuncSetAttribute((const void*)mk, hipFuncAttributeMaxDynamicSharedMemorySize, MK_LDS) != hipSuccess) fprintf(stderr, "hipFuncSetAttribute failed\n"); attr_set = true; }
    MkArgs a{}; a.P = P;
    (void)hipMemsetAsync(ws + WS_CTL, 0, CTL_BYTES, stream);
    hipLaunchKernelGGL(k_p0, dim3(256), dim3(256), 0, stream, P);
    for (int l = 0; l < NL; ++l) {
        const float* xin = l == 0 ? P.x : P.out;
        hipLaunchKernelGGL(k_norm, dim3(NT / 4), dim3(256), 0, stream, xin, (bf16*)(ws + WS_AB), (float*)nullptr, (const float*)nullptr, 0);
        if (FAST_INPROJ) { a.step = ST_INPROJ; a.layer = l; hipLaunchKernelGGL(mk, dim3(256), dim3(MK_THREADS), MK_LDS, stream, a); }
        else hipLaunchKernelGGL(nv_gemm<0>, dim3(INW / 64, NT / 64), dim3(256), 0, stream, (const bf16*)(ws + WS_AB), DM, (const bf16*)(ws + WS_WIN) + (size_t)l * INW * DM, DM, DM, (bf16*)(ws + WS_PROJ), (float*)nullptr, INW, (const bf16*)nullptr, (const float*)nullptr);
        if (!FAST_ATTN) hipLaunchKernelGGL(nv_attn, dim3(NT * NH / 64), dim3(64), 0, stream, (const bf16*)(ws + WS_PROJ), (bf16*)(ws + WS_OB), (float*)(ws + WS_LSE));
        if (!FAST_SSM) hipLaunchKernelGGL(nv_ssm, dim3(NB * NG), dim3(64), 0, stream, P, l);
        if (FAST_ATTN || FAST_SSM) { a.step = ST_MIXERS; a.layer = l; a.pad0 = (FAST_ATTN ? 1 : 0) | (FAST_SSM ? 2 : 0); hipLaunchKernelGGL(mk, dim3(256), dim3(MK_THREADS), MK_LDS, stream, a); a.pad0 = 0; }
        if (FAST_GLU) { a.step = ST_GLU; a.layer = l; hipLaunchKernelGGL(mk, dim3(256), dim3(MK_THREADS), MK_LDS, stream, a); }
        else hipLaunchKernelGGL(nv_gemm<1>, dim3(SW / 64, NT / 64), dim3(256), 0, stream, (const bf16*)(ws + WS_YG), SW, (const bf16*)(ws + WS_WGLU) + (size_t)l * SW * SW, SW, SW, (bf16*)(ws + WS_SSMO), (float*)nullptr, SW, (const bf16*)(ws + WS_YG), (const float*)nullptr);
        hipLaunchKernelGGL(k_mix, dim3(NT / 4), dim3(256), 0, stream, P);
        if (FAST_OUT) { a.step = ST_OUT; a.layer = l; hipLaunchKernelGGL(mk, dim3(256), dim3(MK_THREADS), MK_LDS, stream, a); }
        else hipLaunchKernelGGL(nv_gemm<2>, dim3(DM / 64, NT / 64), dim3(256), 0, stream, (const bf16*)(ws + WS_AB), DM, (const bf16*)(ws + WS_WOUT) + (size_t)l * DM * DM, DM, DM, (bf16*)nullptr, P.out, DM, (const bf16*)nullptr, xin);
        hipLaunchKernelGGL(k_route, dim3(NT / 4), dim3(256), 0, stream, P, l);
        if (FAST_MOE) { a.step = ST_MOEUP; a.layer = l; hipLaunchKernelGGL(mk, dim3(256), dim3(MK_THREADS), MK_LDS, stream, a); a.step = ST_MOEDN; hipLaunchKernelGGL(mk, dim3(256), dim3(MK_THREADS), MK_LDS, stream, a); }
        else hipLaunchKernelGGL(nv_moe, dim3(NT), dim3(256), 0, stream, P, l);
    }
    hipLaunchKernelGGL(k_norm, dim3(NT / 4), dim3(256), 0, stream, (const float*)P.out, (bf16*)nullptr, P.out, P.final_g, 2);
}
```

```cpp
#include <hip/hip_runtime.h>
#include <cstdio>
#include <cstdint>

typedef unsigned short bf16;
typedef float f32x4 __attribute__((ext_vector_type(4)));
typedef unsigned u32x4 __attribute__((ext_vector_type(4)));
typedef unsigned u32x2 __attribute__((ext_vector_type(2)));
#define LAS __attribute__((address_space(3)))

constexpr int NB = 8, SEQ = 2048, DM = 1024, NL = 4, NT = NB * SEQ;
constexpr int AW = 512, HD = 64, NH = 8, SW = 512, GC = 16, NG = 32, NP = 64, INW = 2048;
constexpr int NE = 16, EFF = 256, NCLS = 24;
constexpr float RMS_EPS = 1e-6f;
constexpr int CL = 32;
constexpr int NCH = SEQ / CL;

constexpr size_t al256(size_t x) { return (x + 255) & ~(size_t)255; }
constexpr size_t WS_CTL = 0, CTL_BYTES = 1u << 20;
constexpr size_t WS_WIN  = WS_CTL + CTL_BYTES;
constexpr size_t WS_WGLU = WS_WIN  + (size_t)NL * INW * DM * 2;
constexpr size_t WS_WOUT = WS_WGLU + (size_t)NL * SW * SW * 2;
constexpr size_t WS_WGU  = WS_WOUT + (size_t)NL * DM * DM * 2;
constexpr size_t WS_WD   = WS_WGU  + (size_t)NL * NE * 512 * DM * 2;
constexpr size_t WS_KTAB = WS_WD   + (size_t)NL * NE * DM * EFF * 2;
constexpr size_t WS_BMAT = WS_KTAB + al256((size_t)NL * NG * 33 * 256 * 2);
constexpr size_t WS_CMAT = WS_BMAT + (size_t)NL * NG * 128 * 512 * 2;
constexpr size_t WS_LAML = WS_CMAT + (size_t)NL * NG * 512 * 128 * 2;
constexpr size_t WS_AB   = WS_LAML + (size_t)NL * NG * 64 * 2 * 4;
constexpr size_t WS_YG   = WS_AB;
constexpr size_t WS_PROJ = WS_AB + (size_t)NT * DM * 2;
constexpr size_t WS_SSMO = WS_PROJ;
constexpr size_t WS_ACT  = WS_PROJ;
constexpr size_t WS_OB   = WS_PROJ + (size_t)NT * INW * 2;
constexpr size_t WS_TROUTE = WS_OB + (size_t)3 * NT * AW * 2;
constexpr size_t WS_TW   = WS_TROUTE + (size_t)NT * 4;
constexpr size_t WS_LTOK = WS_TW + (size_t)NT * 8;
constexpr size_t WS_LW   = WS_LTOK + (size_t)NCLS * NT * 4;
constexpr size_t WS_LSE  = WS_LW + (size_t)NCLS * NT * 8;
constexpr size_t WS_END  = WS_LSE + (size_t)3 * NT * NH * 4;
static_assert(WS_END <= 325000000, "workspace map exceeds the guaranteed size");
constexpr int CW_CNT = 1024;

__device__ __forceinline__ unsigned f2bf(float f) { unsigned u = __builtin_bit_cast(unsigned, f); return (u + 0x7fffu + ((u >> 16) & 1u)) >> 16; }
__device__ __forceinline__ float bf2f(unsigned h) { return __builtin_bit_cast(float, h << 16); }
__device__ __forceinline__ unsigned pk2(float lo, float hi) { return f2bf(lo) | (f2bf(hi) << 16); }
__device__ __forceinline__ float lane_xor(float v, int lane, int o) { return __builtin_bit_cast(float, __builtin_amdgcn_ds_bpermute((lane ^ o) << 2, __builtin_bit_cast(int, v))); }
__device__ __forceinline__ float wave_sum(float v, int lane) {
#pragma unroll
    for (int o = 1; o < 64; o <<= 1) v += lane_xor(v, lane, o);
    return v;
}
__device__ __forceinline__ float gelu_tanh(float y) {
    const float u = 0.7978845608028654f * (y + 0.044715f * y * y * y);
    const float e = __expf(2.f * u);
    const float th = 1.f - 2.f / (e + 1.f);
    return 0.5f * y * (1.f + th);
}
__device__ __forceinline__ float sigmoidf_(float z) { return 1.f / (1.f + __expf(-z)); }

struct Ptrs {
    const float *x, *ln1_g, *w_in, *lam_re, *lam_im, *log_dt, *b_re, *b_im, *c_re, *c_im, *d_skip, *w_glu, *gn_attn, *gn_ssm, *w_out, *ln2_g,
        *w_rg, *b_rg, *w_re, *b_re_, *w_gate, *w_up, *w_down, *final_g;
    float* out; unsigned char* ws;
};

__device__ __forceinline__ void p0_transpose_item(const float* W, int N, const float* gain, bf16* WT, int K, LAS float* scr, int kb, int nb, int dst_row0, int lane) {
    const int k0 = 64 * kb, n0 = 32 * nb;
#pragma unroll 8
    for (int i = 0; i < 32; ++i) { const int kk = 2 * i + (lane >> 5); float v = W[(size_t)(k0 + kk) * N + n0 + (lane & 31)]; if (gain) v *= gain[k0 + kk]; scr[kk * 33 + (lane & 31)] = v; }
    asm volatile("s_waitcnt lgkmcnt(0)" ::: "memory");
    const int c = lane & 7;
#pragma unroll
    for (int j = 0; j < 4; ++j) { const int n = (lane >> 3) + 8 * j; const LAS float* s = scr + (8 * c) * 33 + n;
        u32x4 o; o.x = pk2(s[0 * 33], s[1 * 33]); o.y = pk2(s[2 * 33], s[3 * 33]); o.z = pk2(s[4 * 33], s[5 * 33]); o.w = pk2(s[6 * 33], s[7 * 33]);
        *(u32x4*)(WT + (size_t)(dst_row0 + n) * K + k0 + 8 * c) = o; }
    asm volatile("s_waitcnt lgkmcnt(0)" ::: "memory");
}
constexpr int IT_WIN = (DM / 64) * (INW / 32);
constexpr int IT_WGLU = (SW / 64) * (SW / 32);
constexpr int IT_WOUT = (DM / 64) * (DM / 32);
constexpr int IT_WG = (DM / 64) * (EFF / 32);
constexpr int IT_WDN = (EFF / 64) * (DM / 32);
constexpr int IT_PER_LAYER = IT_WIN + IT_WGLU + IT_WOUT + NE * (2 * IT_WG + IT_WDN);
constexpr int IT_TOTAL = NL * IT_PER_LAYER;
__device__ __forceinline__ void p0_transposes(const Ptrs& P, LAS float* scr, int gw, int ngw, int lane) {
    unsigned char* ws = P.ws;
#pragma unroll 1
    for (int it = gw; it < IT_TOTAL; it += ngw) {
        const int l = it / IT_PER_LAYER; int r = it % IT_PER_LAYER;
        if (r < IT_WIN) { const int nblk = INW / 32; p0_transpose_item(P.w_in + (size_t)l * DM * INW, INW, P.ln1_g + l * DM, (bf16*)(ws + WS_WIN) + (size_t)l * INW * DM, DM, scr, r / nblk, r % nblk, 32 * (r % nblk), lane); continue; }
        r -= IT_WIN;
        if (r < IT_WGLU) { const int nblk = SW / 32; p0_transpose_item(P.w_glu + (size_t)l * SW * SW, SW, nullptr, (bf16*)(ws + WS_WGLU) + (size_t)l * SW * SW, SW, scr, r / nblk, r % nblk, 32 * (r % nblk), lane); continue; }
        r -= IT_WGLU;
        if (r < IT_WOUT) { const int nblk = DM / 32; const int kb = r / nblk; const float* g = (kb < 8) ? (P.gn_attn + l * AW) : (P.gn_ssm + l * SW - AW);
            p0_transpose_item(P.w_out + (size_t)l * DM * DM, DM, g, (bf16*)(ws + WS_WOUT) + (size_t)l * DM * DM, DM, scr, kb, r % nblk, 32 * (r % nblk), lane); continue; }
        r -= IT_WOUT;
        const int e = r / (2 * IT_WG + IT_WDN); r %= (2 * IT_WG + IT_WDN);
        if (r < 2 * IT_WG) { const int up = r / IT_WG; r %= IT_WG; const int nblk = EFF / 32; const int kb = r / nblk, nb = r % nblk; const int f0 = 32 * nb;
            const float* src = (up ? P.w_up : P.w_gate) + ((size_t)l * NE + e) * DM * EFF;
            bf16* dst = (bf16*)(ws + WS_WGU) + ((size_t)l * NE + e) * 512 * DM;
            p0_transpose_item(src, EFF, P.ln2_g + l * DM, dst, DM, scr, kb, nb, (f0 / 128) * 256 + up * 128 + (f0 % 128), lane); continue; }
        r -= 2 * IT_WG;
        { const int nblk = DM / 32; p0_transpose_item(P.w_down + ((size_t)l * NE + e) * EFF * DM, DM, nullptr, (bf16*)(ws + WS_WD) + ((size_t)l * NE + e) * DM * EFF, EFF, scr, r / nblk, r % nblk, 32 * (r % nblk), lane); }
    }
}

__device__ __forceinline__ void p0_tables_item(const Ptrs& P, int lg, LAS float* scr, int tid, int nthr) {
    typedef float f32x2 __attribute__((ext_vector_type(2)));
    LAS f32x2* pw = (LAS f32x2*)scr; LAS f32x2* Bb = pw + 33 * 64; LAS f32x2* Cc = Bb + 64 * 16;
    const int l = lg / NG, g = lg % NG;
    const float dt = expf(P.log_dt[lg]);
    const float* lre = P.lam_re + (size_t)lg * NP; const float* lim = P.lam_im + (size_t)lg * NP;
#pragma unroll 1
    for (int i = tid; i < 33 * 64; i += nthr) { const int tau = i / 64, p = i % 64;
        const float a = lre[p] * dt * (float)tau; const float turns = lim[p] * dt * 0.15915494309189535f;
        const float xh = (float)tau * turns, xl = fmaf((float)tau, turns, -xh); const float fr = (xh - rintf(xh)) + xl;
        float sn, cs; sincosf(6.283185307179586f * fr, &sn, &cs); const float mg = expf(a);
        pw[i] = (f32x2){mg * cs, mg * sn}; }
#pragma unroll 1
    for (int i = tid; i < 64 * 16; i += nthr) { const int p = i / 16, h = i % 16;
        const float a = lre[p] * dt, th = lim[p] * dt; float sn, cs; sincosf(th, &sn, &cs); float sh, ch; sincosf(0.5f * th, &sh, &ch); (void)ch;
        const float em1 = expm1f(a), ea = em1 + 1.f;
        const float nr = em1 * cs - 2.f * sh * sh, ni = ea * sn;
        const float c = lre[p], d = lim[p], den = 1.f / (c * c + d * d);
        const float qr = (nr * c + ni * d) * den, qi = (ni * c - nr * d) * den;
        const float br = P.b_re[((size_t)lg * NP + p) * GC + h], bi = P.b_im[((size_t)lg * NP + p) * GC + h];
        Bb[i] = (f32x2){qr * br - qi * bi, qr * bi + qi * br}; }
#pragma unroll 1
    for (int i = tid; i < 16 * 64; i += nthr) { const int h = i / 64, p = i % 64;
        Cc[i] = (f32x2){P.c_re[((size_t)lg * GC + h) * NP + p], P.c_im[((size_t)lg * GC + h) * NP + p]}; }
    __syncthreads();
    unsigned char* ws = P.ws;
    bf16* Bmat = (bf16*)(ws + WS_BMAT) + (size_t)lg * 128 * 512;
    bf16* Cmat = (bf16*)(ws + WS_CMAT) + (size_t)lg * 512 * 128;
    bf16* Kt = (bf16*)(ws + WS_KTAB) + (size_t)lg * 33 * 256;
    float* LamL = (float*)(ws + WS_LAML) + (size_t)lg * 128;
#pragma unroll 1
    for (int i = tid; i < 128 * 64; i += nthr) { const int row = i / 64, c8 = i % 64; const int p = row & 63, cc = row >> 6; const int j = c8 >> 1, h0 = (c8 & 1) * 8;
        const f32x2 w = pw[(31 - j) * 64 + p]; unsigned o[4];
#pragma unroll
        for (int q = 0; q < 4; ++q) { const f32x2 b0 = Bb[p * 16 + h0 + 2 * q], b1 = Bb[p * 16 + h0 + 2 * q + 1];
            const float v0 = cc ? (w.x * b0.y + w.y * b0.x) : (w.x * b0.x - w.y * b0.y); const float v1 = cc ? (w.x * b1.y + w.y * b1.x) : (w.x * b1.x - w.y * b1.y); o[q] = pk2(v0, v1); }
        *(u32x4*)(Bmat + (size_t)row * 512 + c8 * 8) = (u32x4){o[0], o[1], o[2], o[3]}; }
#pragma unroll 1
    for (int i = tid; i < 512 * 16; i += nthr) { const int row = i / 16, s8 = i % 16; const int ii = row >> 4, h = row & 15; const int cc = s8 >> 3, p0 = (s8 & 7) * 8; unsigned o[4];
#pragma unroll
        for (int q = 0; q < 4; ++q) { float v[2];
#pragma unroll
            for (int e = 0; e < 2; ++e) { const int p = p0 + 2 * q + e; const f32x2 w = pw[(ii + 1) * 64 + p], c = Cc[h * 64 + p]; v[e] = cc ? -(c.x * w.y + c.y * w.x) : (c.x * w.x - c.y * w.y); }
            o[q] = pk2(v[0], v[1]); }
        *(u32x4*)(Cmat + (size_t)row * 128 + s8 * 8) = (u32x4){o[0], o[1], o[2], o[3]}; }
#pragma unroll 1
    for (int i = tid; i < 33 * 256; i += nthr) { const int t1 = i / 256, h = (i >> 4) & 15, hp = i & 15; float s = 0.f;
        if (t1 > 0) { const int tau = t1 - 1;
            for (int p = 0; p < 64; ++p) { const f32x2 c = Cc[h * 64 + p], w = pw[tau * 64 + p], b = Bb[p * 16 + hp]; const float cr = c.x * w.x - c.y * w.y, ci = c.x * w.y + c.y * w.x; s += cr * b.x - ci * b.y; }
            if (tau == 0 && h == hp) s += P.d_skip[(size_t)lg * GC + h]; }
        Kt[i] = (bf16)f2bf(s); }
#pragma unroll 1
    for (int i = tid; i < 64; i += nthr) { const f32x2 w = pw[32 * 64 + i]; LamL[2 * i] = w.x; LamL[2 * i + 1] = w.y; }
    __syncthreads();
    (void)l; (void)g;
}

__device__ __forceinline__ void route_row(const Ptrs& P, int l, int row, int lane, const float* X, bf16* XN, unsigned* troute, float* tw, int* ltok, float* lw, unsigned* cnt) {
    const f32x4* xr = (const f32x4*)(X + (size_t)row * DM) + lane; f32x4 v[4]; float s = 0.f;
#pragma unroll
    for (int j = 0; j < 4; ++j) { v[j] = xr[64 * j]; s += v[j].x * v[j].x + v[j].y * v[j].y + v[j].z * v[j].z + v[j].w * v[j].w; }
    const float rstd = 1.f / sqrtf(wave_sum(s, lane) * (1.f / DM) + RMS_EPS);
    u32x2* o = (u32x2*)(XN + (size_t)row * DM) + lane;
#pragma unroll
    for (int j = 0; j < 4; ++j) o[64 * j] = (u32x2){pk2(v[j].x * rstd, v[j].y * rstd), pk2(v[j].z * rstd, v[j].w * rstd)};
    const f32x4* gg = (const f32x4*)(P.ln2_g + l * DM) + lane;
#pragma unroll
    for (int j = 0; j < 4; ++j) { const f32x4 gv = gg[64 * j]; v[j] = (f32x4){v[j].x * rstd * gv.x, v[j].y * rstd * gv.y, v[j].z * rstd * gv.z, v[j].w * rstd * gv.w}; }
    const f32x4* wg = (const f32x4*)(P.w_rg + (size_t)l * DM * 4);
    f32x4 acc = (f32x4){0.f, 0.f, 0.f, 0.f};
#pragma unroll
    for (int j = 0; j < 4; ++j) { const int k = 4 * lane + 256 * j; acc += v[j].x * wg[k] + v[j].y * wg[k + 1] + v[j].z * wg[k + 2] + v[j].w * wg[k + 3]; }
    float gl[4];
#pragma unroll
    for (int e = 0; e < 4; ++e) gl[e] = wave_sum(acc[e], lane) + P.b_rg[l * 4 + e];
    int grp = 0; float gm = gl[0];
#pragma unroll
    for (int e = 1; e < 4; ++e) if (gl[e] > gm) { gm = gl[e]; grp = e; }
    float gs = 0.f;
#pragma unroll
    for (int e = 0; e < 4; ++e) gs += expf(gl[e] - gm);
    const float g1 = 1.f / gs;
    const f32x4* we = (const f32x4*)(P.w_re + ((size_t)l * 4 + grp) * DM * 4);
    acc = (f32x4){0.f, 0.f, 0.f, 0.f};
#pragma unroll
    for (int j = 0; j < 4; ++j) { const int k = 4 * lane + 256 * j; acc += v[j].x * we[k] + v[j].y * we[k + 1] + v[j].z * we[k + 2] + v[j].w * we[k + 3]; }
    float el[4];
#pragma unroll
    for (int e = 0; e < 4; ++e) el[e] = wave_sum(acc[e], lane) + P.b_re_[(l * 4 + grp) * 4 + e];
    int i1 = 0; float v1 = el[0];
#pragma unroll
    for (int e = 1; e < 4; ++e) if (el[e] > v1) { v1 = el[e]; i1 = e; }
    int i2 = -1; float v2 = -INFINITY;
#pragma unroll
    for (int e = 0; e < 4; ++e) if (e != i1 && el[e] > v2) { v2 = el[e]; i2 = e; }
    const float e2 = expf(v2 - v1); const float w1 = g1 / (1.f + e2), w2 = g1 * e2 / (1.f + e2);
    const int a = i1 < i2 ? i1 : i2, b = i1 < i2 ? i2 : i1; const float wa = i1 < i2 ? w1 : w2, wb = i1 < i2 ? w2 : w1;
    const int pair = (a == 0) ? (b - 1) : (a == 1 ? (b + 1) : 5);
    const int cls = grp * 6 + pair;
    if (lane == 0) {
        troute[row] = (unsigned)(grp * 4 + a) | ((unsigned)(grp * 4 + b) << 8) | ((unsigned)cls << 16);
        tw[2 * row] = wa; tw[2 * row + 1] = wb;
        const unsigned slot = atomicAdd(cnt + cls, 1u);
        ltok[(size_t)cls * NT + slot] = row; lw[((size_t)cls * NT + slot) * 2] = wa; lw[((size_t)cls * NT + slot) * 2 + 1] = wb;
    }
}
__device__ __forceinline__ void mix_row(int row, int lane, const bf16* OB, const float* LSE, const bf16* SSMO, bf16* AB) {
    const int h = lane >> 3;
    float ls[3], m = -INFINITY;
#pragma unroll
    for (int b = 0; b < 3; ++b) { ls[b] = LSE[((size_t)b * NT + row) * NH + h]; m = fmaxf(m, ls[b]); }
    float w[3], ws_ = 0.f;
#pragma unroll
    for (int b = 0; b < 3; ++b) { w[b] = expf(ls[b] - m); ws_ += w[b]; }
    float o[8];
#pragma unroll
    for (int i = 0; i < 8; ++i) o[i] = 0.f;
#pragma unroll
    for (int b = 0; b < 3; ++b) { const u32x4 q = *((const u32x4*)(OB + ((size_t)b * NT + row) * AW) + lane); const float wb = w[b] / ws_;
        o[0] += wb * bf2f(q.x & 0xffffu); o[1] += wb * bf2f(q.x >> 16); o[2] += wb * bf2f(q.y & 0xffffu); o[3] += wb * bf2f(q.y >> 16);
        o[4] += wb * bf2f(q.z & 0xffffu); o[5] += wb * bf2f(q.z >> 16); o[6] += wb * bf2f(q.w & 0xffffu); o[7] += wb * bf2f(q.w >> 16); }
    float s = 0.f;
#pragma unroll
    for (int i = 0; i < 8; ++i) s += o[i] * o[i];
    float rstd = 1.f / sqrtf(wave_sum(s, lane) * (1.f / AW) + RMS_EPS);
    *((u32x4*)(AB + (size_t)row * DM) + lane) = (u32x4){pk2(o[0] * rstd, o[1] * rstd), pk2(o[2] * rstd, o[3] * rstd), pk2(o[4] * rstd, o[5] * rstd), pk2(o[6] * rstd, o[7] * rstd)};
    const u32x4 q = *((const u32x4*)(SSMO + (size_t)row * SW) + lane);
    o[0] = bf2f(q.x & 0xffffu); o[1] = bf2f(q.x >> 16); o[2] = bf2f(q.y & 0xffffu); o[3] = bf2f(q.y >> 16); o[4] = bf2f(q.z & 0xffffu); o[5] = bf2f(q.z >> 16); o[6] = bf2f(q.w & 0xffffu); o[7] = bf2f(q.w >> 16);
    s = 0.f;
#pragma unroll
    for (int i = 0; i < 8; ++i) s += o[i] * o[i];
    rstd = 1.f / sqrtf(wave_sum(s, lane) * (1.f / SW) + RMS_EPS);
    *((u32x4*)(AB + (size_t)row * DM + AW) + lane) = (u32x4){pk2(o[0] * rstd, o[1] * rstd), pk2(o[2] * rstd, o[3] * rstd), pk2(o[4] * rstd, o[5] * rstd), pk2(o[6] * rstd, o[7] * rstd)};
}
namespace pg8 {
typedef short bf16x8 __attribute__((ext_vector_type(8)));
constexpr int BM = 256, BK = 64, HALF = 128, HTB = HALF * BK * 2, STAGE_BYTES = 8 * HTB, NXCD = 8, WGM = 8;
__host__ __device__ __forceinline__ int lds_byte(int r, int c) { const int st = (r >> 4) * 2 + (c >> 5), rr = r & 15, cc = c & 31, ob = rr * 64 + cc * 2; return st * 1024 + (ob ^ (((ob >> 9) & 1) << 5)); }
__host__ __device__ __forceinline__ void stage_rc(int b, int& R, int& C) { const int st = b / 1024, sb = b % 1024, swz = sb ^ (((sb >> 9) & 1) << 5); R = (st >> 1) * 16 + swz / 64; C = (st & 1) * 32 + (swz % 64) / 2; }
__host__ __device__ __forceinline__ int perm32(int rho) { const int n = rho >> 4, i = rho & 15; return 8 * (i >> 2) + 4 * n + (i & 3); }
struct Unit { int pm, pn; const char* a; const char* b; int x0, x1, x2, fl; };
__device__ __forceinline__ bool static_order(int nM, int nN, int G, int c, int i, int& pm, int& pn) {
    const int nwg = nM * nN; const long L = (long)i * G + c; if (L >= nwg) return false;
    int wgid = (int)L; { const int q = nwg / NXCD, r = nwg % NXCD, xcd = wgid % NXCD, off = wgid / NXCD; wgid = (xcd < r ? xcd * (q + 1) : r * (q + 1) + (xcd - r) * q) + off; }
    const int nig = WGM * nN, gid = wgid / nig, fm = gid * WGM, gsz = (nM - fm) < WGM ? (nM - fm) : WGM;
    pm = fm + ((wgid % nig) % gsz); pn = (wgid % nig) / gsz; return true;
}
__device__ __forceinline__ unsigned cvt_pk_bf16(float lo, float hi) { unsigned r; asm volatile("v_cvt_pk_bf16_f32 %0, %1, %2" : "=v"(r) : "v"(lo), "v"(hi)); return r; }
template <class Epi, class Sched, bool GATHER, bool ALIGN_EPI>
__device__ __forceinline__ void gemm_phase(const int tid, LAS unsigned char* lds, const int lda, const int ldb, const int K, const Sched& S, const Epi& E) {
    const int wid = __builtin_amdgcn_readfirstlane(tid >> 6), lane = tid & 63, wr = wid >> 2, wc = wid & 3, fr = lane & 15, fq = lane >> 4;
    const int nt = K / BK;
    int Rr[2], Cc[2]; unsigned voffB[2], cvA0[2], cvA1[2], nvA0[2], nvA1[2];
#pragma unroll
    for (int i = 0; i < 2; ++i) { stage_rc(tid * 16 + i * 8192, Rr[i], Cc[i]); const int Rb = Epi::PERM ? ((Rr[i] & ~31) + perm32(Rr[i] & 31)) : Rr[i]; voffB[i] = (unsigned)(Rb * ldb + Cc[i]) * 2u; }
    const size_t kstep = (size_t)(BK * 2);
    const size_t hstepB = (size_t)HALF * ldb * 2;
    const unsigned ldsw = (unsigned)wid * 1024u;
    const int aoff = lds_byte(wr * 64 + fr, fq * 8), boff = lds_byte(wc * 32 + fr, fq * 8);
#define PG8_SA(b, h) (((b) * 2 + (h)) * HTB)
#define PG8_SB(b, h) ((4 + (b) * 2 + (h)) * HTB)
#define PG8_STAGE(bufoff, gbase, voff) do { _Pragma("unroll") for (int _i = 0; _i < 2; ++_i) \
        __builtin_amdgcn_global_load_lds((const unsigned*)((const char*)(gbase) + (voff)[_i]), (LAS unsigned*)(lds + (bufoff) + ldsw + _i * 8192), 16, 0, 0); } while (0)
#define PG8_LDA(dst, b, h) do { _Pragma("unroll") for (int m = 0; m < 4; ++m) _Pragma("unroll") for (int k = 0; k < 2; ++k) dst[m][k] = *(const LAS bf16x8*)(lds + PG8_SA(b, h) + aoff + m * 2048 + k * 1024); } while (0)
#define PG8_LDB(dst, b, h) do { _Pragma("unroll") for (int n = 0; n < 2; ++n) _Pragma("unroll") for (int k = 0; k < 2; ++k) dst[n][k] = *(const LAS bf16x8*)(lds + PG8_SB(b, h) + boff + n * 2048 + k * 1024); } while (0)
#define PG8_MMA(ai, bj, At, Bt) do { __builtin_amdgcn_s_setprio(1); _Pragma("unroll") for (int m = 0; m < 4; ++m) _Pragma("unroll") for (int n = 0; n < 2; ++n) _Pragma("unroll") for (int k = 0; k < 2; ++k) \
        acc[ai][bj][m][n] = __builtin_amdgcn_mfma_f32_16x16x32_bf16(Bt[n][k], At[m][k], acc[ai][bj][m][n], 0, 0, 0); __builtin_amdgcn_s_setprio(0); } while (0)
#define PG8_WAIT_V(n) asm volatile("s_waitcnt vmcnt(" #n ")" ::: "memory")
#define PG8_WAIT_L(n) asm volatile("s_waitcnt lgkmcnt(" #n ")" ::: "memory")
#define PG8_BAR __builtin_amdgcn_s_barrier()
#define PG8_SCHED __builtin_amdgcn_sched_barrier(0)
#define PG8_BP(u, tile) ((u).b + (size_t)(tile) * kstep)
#define PG8_SETA(u, v0, v1) do { _Pragma("unroll") for (int _i = 0; _i < 2; ++_i) { \
        if (GATHER) { v0[_i] = S.rowoff(u, Rr[_i]) + (unsigned)Cc[_i] * 2u; v1[_i] = S.rowoff(u, HALF + Rr[_i]) + (unsigned)Cc[_i] * 2u; } \
        else { v0[_i] = (unsigned)(Rr[_i] * lda + Cc[_i]) * 2u; v1[_i] = v0[_i] + (unsigned)(HALF * lda * 2); } } } while (0)
    Unit cur, nxt; int ui = 0;
    if (!S.next(0, cur)) return;
    PG8_SETA(cur, cvA0, cvA1);
    f32x4 acc[2][2][4][2];
#pragma unroll
    for (int a = 0; a < 2; ++a)
#pragma unroll
        for (int b = 0; b < 2; ++b)
#pragma unroll
            for (int m = 0; m < 4; ++m)
#pragma unroll
                for (int n = 0; n < 2; ++n) acc[a][b][m][n] = (f32x4){0.f, 0.f, 0.f, 0.f};
    bf16x8 At[4][2], B0[2][2], B1[2][2];
    {   const char* cB = PG8_BP(cur, 0); const char* cB1 = PG8_BP(cur, 1);
        PG8_STAGE(PG8_SB(0, 0), cB, voffB); PG8_STAGE(PG8_SB(0, 1), cB + hstepB, voffB); PG8_STAGE(PG8_SA(0, 0), cur.a, cvA0); PG8_STAGE(PG8_SA(0, 1), cur.a, cvA1);
        if (wr == 1) PG8_BAR;
        PG8_WAIT_V(2); PG8_BAR;
        PG8_STAGE(PG8_SB(1, 0), cB1, voffB); PG8_STAGE(PG8_SA(1, 0), cur.a + kstep, cvA0); PG8_STAGE(PG8_SB(1, 1), cB1 + hstepB, voffB);
        PG8_WAIT_V(6); PG8_BAR; }
    for (;;) {
        const bool has_next = S.next(ui + 1, nxt);
        if (has_next) { PG8_SETA(nxt, nvA0, nvA1); } else {
#pragma unroll
            for (int i = 0; i < 2; ++i) { nvA0[i] = cvA0[i]; nvA1[i] = cvA1[i]; } }
        const char* nA = has_next ? nxt.a : cur.a; const char* nB = has_next ? PG8_BP(nxt, 0) : PG8_BP(cur, 0);
        for (int t = 0; t < nt; t += 2) {
            const bool last = (t == nt - 2);
            const char* a1 = cur.a + (size_t)(t + 1) * kstep;
            const char* a2 = last ? nA : cur.a + (size_t)(t + 2) * kstep; const char* b2 = last ? nB : PG8_BP(cur, t + 2);
            const char* a3 = a2 + kstep; const char* b3 = b2 + kstep;
            unsigned vo0[2], vo1[2];
#pragma unroll
            for (int i = 0; i < 2; ++i) { vo0[i] = last ? nvA0[i] : cvA0[i]; vo1[i] = last ? nvA1[i] : cvA1[i]; }
            PG8_LDB(B0, 0, 0); PG8_LDB(B1, 0, 1); PG8_SCHED; PG8_LDA(At, 0, 0); PG8_STAGE(PG8_SA(1, 1), a1, cvA1);
            PG8_WAIT_V(8); PG8_WAIT_L(0); PG8_BAR; PG8_MMA(0, 0, At, B0); PG8_MMA(0, 1, At, B1); PG8_BAR; PG8_SCHED;
            PG8_LDA(At, 0, 1); PG8_STAGE(PG8_SB(0, 0), b2, voffB); PG8_STAGE(PG8_SB(0, 1), b2 + hstepB, voffB); PG8_STAGE(PG8_SA(0, 0), a2, vo0);
            PG8_WAIT_V(8); PG8_WAIT_L(0); PG8_BAR; PG8_MMA(1, 0, At, B0); PG8_MMA(1, 1, At, B1); PG8_BAR; PG8_SCHED;
            PG8_LDB(B0, 1, 0); PG8_LDB(B1, 1, 1); PG8_SCHED; PG8_LDA(At, 1, 0); PG8_STAGE(PG8_SA(0, 1), a2, vo1);
            PG8_WAIT_V(8); PG8_WAIT_L(0); PG8_BAR; PG8_MMA(0, 0, At, B0); PG8_MMA(0, 1, At, B1); PG8_BAR; PG8_SCHED;
            PG8_LDA(At, 1, 1); PG8_STAGE(PG8_SB(1, 0), b3, voffB); PG8_STAGE(PG8_SB(1, 1), b3 + hstepB, voffB); PG8_STAGE(PG8_SA(1, 0), a3, vo0);
            PG8_WAIT_V(8); PG8_WAIT_L(0); PG8_BAR; PG8_MMA(1, 0, At, B0); PG8_MMA(1, 1, At, B1); PG8_BAR; PG8_SCHED;
        }
        const bool epi = (cur.fl & 2) != 0;
        if (epi) {
            if constexpr (ALIGN_EPI) { if (wr == 0) PG8_BAR; }
            { int t2 = tid; asm volatile("" : "+v"(t2));
              const int w2 = __builtin_amdgcn_readfirstlane(t2 >> 6), l2 = t2 & 63; E(acc, cur, w2 >> 2, w2 & 3, l2 & 15, l2 >> 4); }
        }
        if (!has_next) break;
        if (nxt.fl & 1) {
#pragma unroll
            for (int a = 0; a < 2; ++a)
#pragma unroll
                for (int b = 0; b < 2; ++b)
#pragma unroll
                    for (int m = 0; m < 4; ++m)
#pragma unroll
                        for (int n = 0; n < 2; ++n) acc[a][b][m][n] = (f32x4){0.f, 0.f, 0.f, 0.f};
        }
        cur = nxt; ++ui;
#pragma unroll
        for (int i = 0; i < 2; ++i) { cvA0[i] = nvA0[i]; cvA1[i] = nvA1[i]; }
        if (epi) { if constexpr (ALIGN_EPI) { if (wr == 1) PG8_BAR; } }
    }
    PG8_WAIT_V(0);
    if constexpr (!ALIGN_EPI) { if (wr == 0) PG8_BAR; }
    PG8_BAR;
#undef PG8_SA
#undef PG8_SB
#undef PG8_STAGE
#undef PG8_LDA
#undef PG8_LDB
#undef PG8_MMA
#undef PG8_WAIT_V
#undef PG8_WAIT_L
#undef PG8_BAR
#undef PG8_SCHED
#undef PG8_BP
#undef PG8_SETA
}

struct DenseSched {
    const char* A; const char* Bt; int nM, nN, G, c; size_t atile, btile;
    __device__ __forceinline__ bool next(int i, Unit& u) const { int pm, pn; if (!static_order(nM, nN, G, c, i, pm, pn)) return false;
        u.pm = pm; u.pn = pn; u.a = A + (size_t)pm * atile; u.b = Bt + (size_t)pn * btile; u.x0 = u.x1 = u.x2 = 0; u.fl = 3; return true; }
    __device__ __forceinline__ unsigned rowoff(const Unit&, int) const { return 0u; }
};
struct EpiStoreBf16 {
    static constexpr bool PERM = true; bf16* C; int ldc;
    __device__ __forceinline__ void operator()(const f32x4 (&acc)[2][2][4][2], const Unit& u, int wr, int wc, int fr, int fq) const {
        const int row0 = u.pm * BM + wr * 64 + fr, col0 = u.pn * BM + wc * 32 + 8 * fq;
#pragma unroll
        for (int ai = 0; ai < 2; ++ai)
#pragma unroll
            for (int m = 0; m < 4; ++m) { bf16* rowp = C + (size_t)(row0 + ai * HALF + m * 16) * ldc + col0;
#pragma unroll
                for (int bj = 0; bj < 2; ++bj) { const f32x4 v0 = acc[ai][bj][m][0], v1 = acc[ai][bj][m][1];
                    *(u32x4*)(rowp + bj * HALF) = (u32x4){cvt_pk_bf16(v0[0], v0[1]), cvt_pk_bf16(v0[2], v0[3]), cvt_pk_bf16(v1[0], v1[1]), cvt_pk_bf16(v1[2], v1[3])}; } }
    }
};
struct EpiGlu {
    static constexpr bool PERM = true; bf16* C; const bf16* aux; int ldc;
    __device__ __forceinline__ void operator()(const f32x4 (&acc)[2][2][4][2], const Unit& u, int wr, int wc, int fr, int fq) const {
        const int row0 = u.pm * BM + wr * 64 + fr, col0 = u.pn * BM + wc * 32 + 8 * fq;
#pragma unroll
        for (int ai = 0; ai < 2; ++ai)
#pragma unroll
            for (int m = 0; m < 4; ++m) { const size_t ro = (size_t)(row0 + ai * HALF + m * 16) * ldc + col0;
#pragma unroll
                for (int bj = 0; bj < 2; ++bj) { const f32x4 v0 = acc[ai][bj][m][0], v1 = acc[ai][bj][m][1]; const u32x4 y = *(const u32x4*)(aux + ro + bj * HALF);
                    float r[8]; r[0] = bf2f(y.x & 0xffffu) * sigmoidf_(v0[0]); r[1] = bf2f(y.x >> 16) * sigmoidf_(v0[1]); r[2] = bf2f(y.y & 0xffffu) * sigmoidf_(v0[2]); r[3] = bf2f(y.y >> 16) * sigmoidf_(v0[3]);
                    r[4] = bf2f(y.z & 0xffffu) * sigmoidf_(v1[0]); r[5] = bf2f(y.z >> 16) * sigmoidf_(v1[1]); r[6] = bf2f(y.w & 0xffffu) * sigmoidf_(v1[2]); r[7] = bf2f(y.w >> 16) * sigmoidf_(v1[3]);
                    *(u32x4*)(C + ro + bj * HALF) = (u32x4){cvt_pk_bf16(r[0], r[1]), cvt_pk_bf16(r[2], r[3]), cvt_pk_bf16(r[4], r[5]), cvt_pk_bf16(r[6], r[7])}; } }
    }
};
struct EpiResid {
    static constexpr bool PERM = false; float* C; const float* base; int ldc;
    __device__ __forceinline__ void operator()(const f32x4 (&acc)[2][2][4][2], const Unit& u, int wr, int wc, int fr, int fq) const {
        const int row0 = u.pm * BM + wr * 64 + fr, col0 = u.pn * BM + wc * 32 + 4 * fq;
#pragma unroll
        for (int ai = 0; ai < 2; ++ai)
#pragma unroll
            for (int m = 0; m < 4; ++m) { const size_t ro = (size_t)(row0 + ai * HALF + m * 16) * ldc + col0;
#pragma unroll
                for (int bj = 0; bj < 2; ++bj)
#pragma unroll
                    for (int n = 0; n < 2; ++n) { const f32x4 bs = *(const f32x4*)(base + ro + bj * HALF + n * 16); *(f32x4*)(C + ro + bj * HALF + n * 16) = bs + acc[ai][bj][m][n]; } }
    }
};

__device__ __forceinline__ void moe_build_prefix(const int tid, LAS int* tpre, unsigned* cnt) {
    __syncthreads();
    if (tid == 0) { int s = 0;
#pragma unroll 1
        for (int c = 0; c < NCLS; ++c) { const int n = (int)__hip_atomic_load(cnt + c, __ATOMIC_RELAXED, __HIP_MEMORY_SCOPE_AGENT); tpre[c] = s; tpre[32 + c] = n; s += (n + 255) >> 8; } tpre[NCLS] = s; }
    __syncthreads();
}
__device__ __forceinline__ void pair_decode(int pair, int& a, int& b) { a = pair < 3 ? 0 : (pair < 5 ? 1 : 2); b = pair < 3 ? pair + 1 : (pair < 5 ? pair - 1 : 3); }
struct MoeSched {
    const LAS int* tpre; const int* ltok; const char* A; const char* W; int G, c, l, up;
    __device__ __forceinline__ bool next(int i, Unit& u) const {
        const int MT = __builtin_amdgcn_readfirstlane(tpre[NCLS]); int pm, pn; const int seg = up ? 0 : (i & 1);
        if (!static_order(MT, 4, G, c, up ? i : (i >> 1), pm, pn)) return false;
        int cls = 0;
#pragma unroll 1
        for (int q = 1; q < NCLS; ++q) if (pm >= __builtin_amdgcn_readfirstlane(tpre[q])) cls = q;
        const int grp = cls / 6; int ea, eb; pair_decode(cls % 6, ea, eb); ea += grp * 4; eb += grp * 4;
        u.pm = pm; u.pn = pn; u.x0 = cls; u.x1 = (pm - __builtin_amdgcn_readfirstlane(tpre[cls])) * 256; u.x2 = __builtin_amdgcn_readfirstlane(tpre[32 + cls]);
        if (up) { const int e = pn < 2 ? ea : eb; u.a = A; u.b = W + ((size_t)((l * NE + e) * 2 + (pn & 1))) * 256 * DM * 2; u.fl = 3; }
        else { const int e = seg ? eb : ea; u.a = A + (size_t)pm * 256 * 512 * 2 + seg * (EFF * 2); u.b = W + ((size_t)(l * NE + e) * DM + pn * 256) * EFF * 2; u.fl = seg ? 2 : 1; }
        return true;
    }
    __device__ __forceinline__ unsigned rowoff(const Unit& u, int r) const { int i = u.x1 + r; i = i < u.x2 ? i : u.x2 - 1; return (unsigned)ltok[(size_t)u.x0 * NT + i] * (unsigned)(DM * 2); }
};
struct EpiMoeUp {
    static constexpr bool PERM = true; bf16* ACT; const float* lw;
    __device__ __forceinline__ void operator()(const f32x4 (&acc)[2][2][4][2], const Unit& u, int wr, int wc, int fr, int fq) const {
        const int col0 = (u.pn >> 1) * 256 + (u.pn & 1) * 128 + wc * 32 + 8 * fq;
#pragma unroll
        for (int ai = 0; ai < 2; ++ai)
#pragma unroll
            for (int m = 0; m < 4; ++m) { const int r = ai * HALF + wr * 64 + m * 16 + fr; int i = u.x1 + r; i = i < u.x2 ? i : u.x2 - 1;
                const float w = lw[((size_t)u.x0 * NT + i) * 2 + (u.pn >> 1)];
                const f32x4 g0 = acc[ai][0][m][0], g1 = acc[ai][0][m][1], u0 = acc[ai][1][m][0], u1 = acc[ai][1][m][1]; float v[8];
#pragma unroll
                for (int j = 0; j < 4; ++j) { v[j] = g0[j] * sigmoidf_(g0[j]) * u0[j] * w; v[4 + j] = g1[j] * sigmoidf_(g1[j]) * u1[j] * w; }
                *(u32x4*)(ACT + (size_t)(u.pm * BM + r) * 512 + col0) = (u32x4){cvt_pk_bf16(v[0], v[1]), cvt_pk_bf16(v[2], v[3]), cvt_pk_bf16(v[4], v[5]), cvt_pk_bf16(v[6], v[7])}; }
    }
};
struct EpiMoeDown {
    static constexpr bool PERM = false; float* X; const int* ltok;
    __device__ __forceinline__ void operator()(const f32x4 (&acc)[2][2][4][2], const Unit& u, int wr, int wc, int fr, int fq) const {
        const int col0 = u.pn * BM + wc * 32 + 4 * fq;
#pragma unroll
        for (int ai = 0; ai < 2; ++ai)
#pragma unroll
            for (int m = 0; m < 4; ++m) { const int r = ai * HALF + wr * 64 + m * 16 + fr; const int i = u.x1 + r;
                if (i < u.x2) { const int tok = ltok[(size_t)u.x0 * NT + i]; float* rowp = X + (size_t)tok * DM + col0;
#pragma unroll
                    for (int bj = 0; bj < 2; ++bj)
#pragma unroll
                        for (int n = 0; n < 2; ++n) { f32x4* p = (f32x4*)(rowp + bj * HALF + n * 16); *p = *p + acc[ai][bj][m][n]; } }
                asm volatile("" ::: "memory"); }
    }
};
}


namespace attn {
typedef short bf16x8 __attribute__((ext_vector_type(8)));
typedef short s16x4 __attribute__((ext_vector_type(4)));
typedef float f32x16 __attribute__((ext_vector_type(16)));
__device__ __forceinline__ unsigned cvtpk(float lo, float hi) { typedef float f2 __attribute__((ext_vector_type(2))); typedef __bf16 b2 __attribute__((ext_vector_type(2))); f2 v = {lo, hi}; b2 b = __builtin_convertvector(v, b2); return __builtin_bit_cast(unsigned, b); }
__device__ __forceinline__ s16x4 vtr(const LAS unsigned char* p) { return __builtin_bit_cast(s16x4, __builtin_amdgcn_ds_read_tr16_b64_v4i16((LAS s16x4*)p)); }
constexpr int N_ITEMS = NB * NH * 48, N_STEPS = N_ITEMS / 2;
__device__ __forceinline__ void attn_phase(const int tid, LAS unsigned char* lds, const bf16* PROJ, bf16* OB, float* LSE, int G, int bx) {
    const int lane = tid & 63, wid = __builtin_amdgcn_readfirstlane(tid >> 6), half = wid >> 2, w = wid & 3, tid4 = tid & 255;
    const int r32 = lane & 31, hi = lane >> 5;
    LAS unsigned char* Kt = lds + half * 65536;
    LAS unsigned char* Vt = Kt + 32768;
    for (int step = bx; step < N_STEPS; step += G) {
        const int it = step * 2 + half; const int bh = it / 48, rem = it % 48, br = rem >> 4, tile = rem & 15;
        const int b = bh >> 3, h = bh & 7;
        const int dil = br == 0 ? 1 : (br == 1 ? 4 : 16); const int rr = br == 0 ? 0 : (br == 1 ? (tile & 3) : tile); const int blk = br == 0 ? tile : (br == 1 ? (tile >> 2) : 0);
        const bool first = (blk == 0);
        const size_t tokbase = (size_t)b * SEQ;
#pragma unroll
        for (int j = 0; j < 8; ++j) { const int row = j * 32 + (tid4 >> 3), ch = tid4 & 7; const bool valid = !(first && row < 128);
            u32x4 kv = (u32x4){0u, 0u, 0u, 0u}, vv = (u32x4){0u, 0u, 0u, 0u};
            if (valid) { const int pos = dil * (128 * (blk - 1) + row) + rr; const bf16* src = PROJ + (tokbase + pos) * INW + AW + h * HD + ch * 8; kv = *(const u32x4*)src; vv = *(const u32x4*)(src + AW); }
            *(LAS u32x4*)(Kt + ch * 4096 + ((row ^ ch) * 16)) = kv;
            *(LAS u32x4*)(Vt + (ch >> 2) * 16384 + row * 64 + (ch & 3) * 16) = vv; }
        const int qrow = 32 * w + r32; const int qpos = dil * (128 * blk + qrow) + rr;
        const bf16* qp = PROJ + (tokbase + qpos) * INW + h * HD + hi * 8;
        bf16x8 qf[4];
#pragma unroll
        for (int d0 = 0; d0 < 4; ++d0) qf[d0] = *(const bf16x8*)(qp + d0 * 16);
        __syncthreads();
        const int kt_lo = first ? (4 - w) : 0;
        f32x16 p[5];
#pragma unroll
        for (int kt = 0; kt < 5; ++kt) { p[kt] = f32x16{};
            if (kt >= kt_lo) {
#pragma unroll
                for (int d0 = 0; d0 < 4; ++d0) { const int ch = 2 * d0 + hi; const int kpos = 32 * w + 32 * kt + r32;
                    const bf16x8 kf = *(const LAS bf16x8*)(Kt + ch * 4096 + ((kpos ^ ch) * 16));
                    p[kt] = __builtin_amdgcn_mfma_f32_32x32x16_bf16(kf, qf[d0], p[kt], 0, 0, 0); } } }
        const float SC = 0.125f * 1.4426950408889634f;
        float mx = -INFINITY;
#pragma unroll
        for (int kt = 0; kt < 5; ++kt) if (kt >= kt_lo) {
#pragma unroll
            for (int r = 0; r < 16; ++r) { const int c = (r & 3) + 8 * (r >> 2) + 4 * hi; bool ok = true; if (kt == 0) ok = (c >= r32); if (kt == 4) ok = (c <= r32);
                const float sv = ok ? p[kt][r] * SC : -INFINITY; p[kt][r] = sv; mx = fmaxf(mx, sv); } }
        mx = fmaxf(mx, lane_xor(mx, lane, 32));
        float lsum = 0.f;
#pragma unroll
        for (int kt = 0; kt < 5; ++kt) if (kt >= kt_lo) {
#pragma unroll
            for (int r = 0; r < 16; ++r) { const float e = __builtin_amdgcn_exp2f(p[kt][r] - mx); p[kt][r] = e; lsum += e; } }
        lsum += lane_xor(lsum, lane, 32);
        f32x16 o[2]; o[0] = f32x16{}; o[1] = f32x16{};
        const LAS unsigned char* vbase = Vt + (32 * w + 4 * hi + ((lane & 15) >> 2)) * 64 + ((lane >> 4) & 1) * 32 + (lane & 3) * 8;
#pragma unroll
        for (int kt = 0; kt < 5; ++kt) if (kt >= kt_lo) {
#pragma unroll
            for (int ks = 0; ks < 2; ++ks) {
                u32x4 pw; pw.x = cvtpk(p[kt][8 * ks + 0], p[kt][8 * ks + 1]); pw.y = cvtpk(p[kt][8 * ks + 2], p[kt][8 * ks + 3]); pw.z = cvtpk(p[kt][8 * ks + 4], p[kt][8 * ks + 5]); pw.w = cvtpk(p[kt][8 * ks + 6], p[kt][8 * ks + 7]);
                const bf16x8 pf = __builtin_bit_cast(bf16x8, pw);
#pragma unroll
                for (int dh = 0; dh < 2; ++dh) { const LAS unsigned char* va = vbase + dh * 16384 + (32 * kt + 16 * ks) * 64;
                    const s16x4 lo = vtr(va), hi8 = vtr(va + 512);
                    const bf16x8 vf = (bf16x8){lo[0], lo[1], lo[2], lo[3], hi8[0], hi8[1], hi8[2], hi8[3]};
                    o[dh] = __builtin_amdgcn_mfma_f32_32x32x16_bf16(vf, pf, o[dh], 0, 0, 0); } } }
        const float inv = 1.f / lsum; const size_t tok = tokbase + qpos;
        bf16* op = OB + ((size_t)br * NT + tok) * AW + h * HD + 4 * hi;
#pragma unroll
        for (int dh = 0; dh < 2; ++dh)
#pragma unroll
            for (int g4 = 0; g4 < 4; ++g4) *(u32x2*)(op + 32 * dh + 8 * g4) = (u32x2){cvtpk(o[dh][4 * g4] * inv, o[dh][4 * g4 + 1] * inv), cvtpk(o[dh][4 * g4 + 2] * inv, o[dh][4 * g4 + 3] * inv)};
        if (hi == 0) LSE[((size_t)br * NT + tok) * NH + h] = (mx + __builtin_amdgcn_logf(lsum)) * 0.6931471805599453f;
        __syncthreads();
    }
}
}

namespace ssm {
typedef short bf16x8 __attribute__((ext_vector_type(8)));
__device__ __forceinline__ void ssm_phase(const int tid, LAS unsigned char* lds, unsigned char* ws, int l, int G, int bx) {
    typedef float f32x2 __attribute__((ext_vector_type(2)));
    const int lane = tid & 63, wid = __builtin_amdgcn_readfirstlane(tid >> 6), nt4 = wid & 3, ih = wid >> 2;
    const bf16* PROJ = (const bf16*)(ws + WS_PROJ); bf16* YG = (bf16*)(ws + WS_YG);
    LAS float* Ef = (LAS float*)lds;
    LAS bf16* Sin = (LAS bf16*)(lds + 32768);
    LAS f32x2* Tot = (LAS f32x2*)(lds + 49152);
    for (int it = bx; it < NG * NB; it += G) {
        const int g = it % NG, b = it / NG, lg = l * NG + g;
        const bf16* Bmat = (const bf16*)(ws + WS_BMAT) + (size_t)lg * 128 * 512; const bf16* Cmat = (const bf16*)(ws + WS_CMAT) + (size_t)lg * 512 * 128;
        const bf16* Kt = (const bf16*)(ws + WS_KTAB) + (size_t)lg * 33 * 256; const float* LamL = (const float*)(ws + WS_LAML) + (size_t)lg * 128;
        const int c = 16 * nt4 + (lane & 15), jj = lane >> 5, h0 = 8 * ((lane >> 4) & 1);
        bf16x8 Uf[16];
        { const bf16* up = PROJ + ((size_t)b * SEQ + (size_t)c * CL + jj) * INW + 3 * AW + g * GC + h0;
#pragma unroll
          for (int ks = 0; ks < 16; ++ks) Uf[ks] = *(const bf16x8*)(up + (size_t)(2 * ks) * INW); }
#pragma unroll 1
        for (int mi = 0; mi < 4; ++mi) { const int m = ih * 4 + mi; f32x4 acc = (f32x4){0.f, 0.f, 0.f, 0.f};
            const bf16* ap = Bmat + (size_t)(16 * m + (lane & 15)) * 512 + 8 * (lane >> 4);
#pragma unroll
            for (int ks = 0; ks < 16; ++ks) { const bf16x8 af = *(const bf16x8*)(ap + 32 * ks); acc = __builtin_amdgcn_mfma_f32_16x16x32_bf16(af, Uf[ks], acc, 0, 0, 0); }
            *(LAS f32x4*)(Ef + c * 128 + 16 * m + 4 * (lane >> 4)) = acc; }
        __syncthreads();
        { const int p = tid & 63, seg = tid >> 6; const float ar = LamL[2 * p], ai = LamL[2 * p + 1];
          float lr[8], li[8]; float sr = 0.f, si = 0.f;
#pragma unroll
          for (int cc = 0; cc < 8; ++cc) { lr[cc] = sr; li[cc] = si; const int cidx = seg * 8 + cc; const float er = Ef[cidx * 128 + p], ei = Ef[cidx * 128 + 64 + p];
              const float nr = ar * sr - ai * si + er, ni = ar * si + ai * sr + ei; sr = nr; si = ni; }
          Tot[seg * 64 + p] = (f32x2){sr, si};
          float a8r = ar, a8i = ai;
#pragma unroll
          for (int q = 0; q < 3; ++q) { const float tr = a8r * a8r - a8i * a8i, ti = 2.f * a8r * a8i; a8r = tr; a8i = ti; }
          __syncthreads();
          float cr = 0.f, ci = 0.f;
          for (int s2 = 0; s2 < seg; ++s2) { const f32x2 t = Tot[s2 * 64 + p]; const float nr = a8r * cr - a8i * ci + t.x, ni = a8r * ci + a8i * cr + t.y; cr = nr; ci = ni; }
          float pr = 1.f, pi = 0.f;
#pragma unroll
          for (int cc = 0; cc < 8; ++cc) { const int cidx = seg * 8 + cc; const float vr = lr[cc] + pr * cr - pi * ci, vi = li[cc] + pr * ci + pi * cr;
              Sin[cidx * 128 + p] = (bf16)f2bf(vr); Sin[cidx * 128 + 64 + p] = (bf16)f2bf(vi);
              const float tr = pr * ar - pi * ai, ti = pr * ai + pi * ar; pr = tr; pi = ti; } }
        __syncthreads();
        bf16x8 Sf[4];
#pragma unroll
        for (int k2 = 0; k2 < 4; ++k2) Sf[k2] = *(const LAS bf16x8*)(Sin + c * 128 + 32 * k2 + 8 * (lane >> 4));
#pragma unroll 1
        for (int ii = 0; ii < 16; ++ii) { const int i = 2 * ii + ih; f32x4 acc = (f32x4){0.f, 0.f, 0.f, 0.f};
            const bf16* cp = Cmat + (size_t)(16 * i + (lane & 15)) * 128 + 8 * (lane >> 4);
#pragma unroll
            for (int k2 = 0; k2 < 4; ++k2) { const bf16x8 af = *(const bf16x8*)(cp + 32 * k2); acc = __builtin_amdgcn_mfma_f32_16x16x32_bf16(af, Sf[k2], acc, 0, 0, 0); }
            const bf16* kp = Kt + (size_t)(i - jj + 1) * 256 + (lane & 15) * 16 + h0;
#pragma unroll
            for (int ks = 0; ks < 16; ++ks) if (2 * ks <= i) { const bf16x8 af = *(const bf16x8*)(kp - (size_t)(2 * ks) * 256); acc = __builtin_amdgcn_mfma_f32_16x16x32_bf16(af, Uf[ks], acc, 0, 0, 0); }
            const size_t tok = (size_t)b * SEQ + (size_t)c * CL + i;
            *(u32x2*)(YG + tok * SW + g * GC + 4 * (lane >> 4)) = (u32x2){pk2(gelu_tanh(acc[0]), gelu_tanh(acc[1])), pk2(gelu_tanh(acc[2]), gelu_tanh(acc[3]))}; }
        __syncthreads();
    }
}
}


#define XB_TMO      128
#define XB_XCNT(j)  (256  + 64 * (j))
#define XB_XSUB(j)  (1280 + 64 * (j))
#define XB_XGEN(j)  (2304 + 64 * (j))
#define XB_TOP      3328
#define XB_TOPGEN   3392
#define XCD_BAR_WORDS 3456
#define XB_SPIN_CAP (1u << 18)
__device__ __forceinline__ unsigned xb_ld(unsigned* p)              { return __hip_atomic_load(p, __ATOMIC_RELAXED, __HIP_MEMORY_SCOPE_AGENT); }
__device__ __forceinline__ unsigned xb_add(unsigned* p, unsigned v) { return __hip_atomic_fetch_add(p, v, __ATOMIC_RELAXED, __HIP_MEMORY_SCOPE_AGENT); }
__device__ __forceinline__ unsigned xb_xcc_id() { return (unsigned)__builtin_amdgcn_s_getreg((3 << 11) | 20) & 0xFu; }
#define XB_SPIN(cond, bar) do { unsigned _sp = 0; while (cond) { __builtin_amdgcn_s_sleep(1); \
    if ((++_sp & 255u) == 0u) { if (xb_ld(&(bar)[XB_TMO])) break; if (_sp > XB_SPIN_CAP) { atomicAdd(&(bar)[XB_TMO], 1u); break; } } } } while (0)
struct XcdBarrier { unsigned* bar; unsigned x; volatile LAS unsigned* st; };
__device__ __forceinline__ XcdBarrier xcd_barrier_post(unsigned* bar, volatile LAS unsigned* st) {
    XcdBarrier b; b.bar = bar; b.x = xb_xcc_id(); b.st = st;
    if (threadIdx.x == 0) (void)xb_add(&bar[XB_XCNT(b.x)], 1u);
    return b;
}
__device__ __forceinline__ void xcd_barrier_complete(unsigned* bar, unsigned x, unsigned& nloc, unsigned& nx) {
    const unsigned G = gridDim.x * gridDim.y * gridDim.z;
    unsigned sum, cnt, mine, sp = 0u;
    for (;;) {
        sum = 0u; cnt = 0u; mine = 0u;
#pragma unroll
        for (unsigned j = 0; j < 16; ++j) { const unsigned c = xb_ld(&bar[XB_XCNT(j)]); sum += c; cnt += (c > 0u) ? 1u : 0u; mine = (j == x) ? c : mine; }
        if (sum == G) break;
        __builtin_amdgcn_s_sleep(1);
        if ((++sp & 255u) == 0u) { if (xb_ld(&bar[XB_TMO])) break; if (sp > XB_SPIN_CAP) { atomicAdd(&bar[XB_TMO], 1u); break; } }
    }
    nloc = mine > 0u ? mine : 1u; nx = cnt > 0u ? cnt : 1u;
}
__device__ __forceinline__ void xcd_barrier(const XcdBarrier& b) {
    asm volatile("s_waitcnt vmcnt(0)" ::: "memory");
    __syncthreads();
    if (threadIdx.x == 0) {
        unsigned* bar = b.bar; unsigned bx_ = b.x;
        asm volatile("" : "+s"(bar), "+s"(bx_));
        __builtin_amdgcn_s_waitcnt(0);
        unsigned nloc = b.st[0], nx = b.st[1];
        if (nloc == 0u) { xcd_barrier_complete(bar, bx_, nloc, nx); b.st[0] = nloc; b.st[1] = nx; }
        const unsigned old = xb_add(&bar[XB_XSUB(bx_)], 1u);
        const unsigned gen = old / nloc;
        if (old + 1u == (gen + 1u) * nloc) {
            __builtin_amdgcn_fence(__ATOMIC_RELEASE, "agent");
            asm volatile("s_waitcnt vmcnt(0)" ::: "memory");
            const unsigned og = xb_add(&bar[XB_TOP], 1u);
            const unsigned tg = og / nx;
            if (og + 1u == (tg + 1u) * nx) xb_add(&bar[XB_TOPGEN], 1u);
            else XB_SPIN(xb_ld(&bar[XB_TOPGEN]) == tg, bar);
            __builtin_amdgcn_fence(__ATOMIC_ACQUIRE, "agent");
            xb_add(&bar[XB_XGEN(bx_)], 1u);
            asm volatile("s_waitcnt vmcnt(0)" ::: "memory");
        } else {
            XB_SPIN(xb_ld(&bar[XB_XGEN(bx_)]) == gen, bar);
            __builtin_amdgcn_fence(__ATOMIC_ACQUIRE, "agent");
            asm volatile("s_waitcnt vmcnt(0)" ::: "memory");
        }
    }
    __syncthreads();
}

__device__ __forceinline__ void norm_rows(const float* x, bf16* xn, float* outf, const float* g, int mode, int gw, int ngw, int lane) {
    for (int row = gw; row < NT; row += ngw) {
        const f32x4* xr = (const f32x4*)(x + (size_t)row * DM) + lane; f32x4 v[4]; float s = 0.f;
#pragma unroll
        for (int j = 0; j < 4; ++j) { v[j] = xr[64 * j]; s += v[j].x * v[j].x + v[j].y * v[j].y + v[j].z * v[j].z + v[j].w * v[j].w; }
        const float rstd = 1.f / sqrtf(wave_sum(s, lane) * (1.f / DM) + RMS_EPS);
        if (mode == 0) { u32x2* o = (u32x2*)(xn + (size_t)row * DM) + lane;
#pragma unroll
            for (int j = 0; j < 4; ++j) o[64 * j] = (u32x2){pk2(v[j].x * rstd, v[j].y * rstd), pk2(v[j].z * rstd, v[j].w * rstd)};
        } else { f32x4* o = (f32x4*)(outf + (size_t)row * DM) + lane; const f32x4* gg = (const f32x4*)g + lane;
#pragma unroll
            for (int j = 0; j < 4; ++j) { const f32x4 gv = gg[64 * j]; o[64 * j] = (f32x4){v[j].x * rstd * gv.x, v[j].y * rstd * gv.y, v[j].z * rstd * gv.z, v[j].w * rstd * gv.w}; } }
    }
}

constexpr int MK_THREADS = 512, MK_LDS = 147456;
constexpr int CW_BAR = 4096;
constexpr int LDS_CTL_OFF = 131072, LDS_MISC_OFF = LDS_CTL_OFF + 512;
enum { ST_P0 = 0, ST_NORM = 1, ST_INPROJ = 2, ST_MIXERS = 3, ST_GLU = 4, ST_MIX = 5, ST_OUT = 6, ST_ROUTE = 7, ST_MOEUP = 8, ST_MOEDN = 9, ST_FINAL = 10 };
constexpr int PROG_LEN = 2 + 9 * NL;
__host__ __device__ __forceinline__ void prog_decode(int pi, int& step, int& layer) {
    if (pi == 0) { step = ST_P0; layer = 0; return; }
    if (pi == PROG_LEN - 1) { step = ST_FINAL; layer = NL - 1; return; }
    int q = pi - 1;
    if (q < 8) { layer = 0; step = ST_INPROJ + q; return; }
    q -= 8; layer = 1 + q / 9; step = ST_NORM + q % 9;
}
struct MkArgs { Ptrs P; int s_lo, s_hi, flags, pad1; };
#if defined(__HIP_DEVICE_COMPILE__)
#define CAS __attribute__((address_space(4)))
#else
#define CAS
#endif
__global__ void __launch_bounds__(MK_THREADS, 2) mk(MkArgs args) {
    extern __shared__ __attribute__((aligned(16))) unsigned char lds_raw[];
    LAS unsigned char* const lds0 = (LAS unsigned char*)lds_raw;
    const CAS MkArgs* ap = (const CAS MkArgs*)__builtin_amdgcn_kernarg_segment_ptr();
    const int G0 = gridDim.x; const int bx0 = blockIdx.x;
    const int tid0 = threadIdx.x;
    for (int u = tid0; u < (MK_LDS - LDS_CTL_OFF) / 4; u += MK_THREADS) ((LAS unsigned*)(lds0 + LDS_CTL_OFF))[u] = 0u;
    __syncthreads();
    const int lo = args.s_lo, hi = args.s_hi;
    XcdBarrier bar; bar.bar = (unsigned*)(args.P.ws + WS_CTL) + CW_BAR; bar.x = 0; bar.st = nullptr;
    if (hi - lo > 1) bar = xcd_barrier_post(bar.bar, (volatile LAS unsigned*)(lds0 + LDS_MISC_OFF));
#define STEP_BEGIN(k) if (lo <= (k) && (k) < hi) { int G = G0, bx = bx0, tid = tid0; unsigned ldsv = (unsigned)(uintptr_t)lds0; asm volatile("" : "+s"(ap), "+s"(G), "+s"(bx), "+v"(tid), "+s"(ldsv)); \
    LAS unsigned char* const lds = (LAS unsigned char*)(uintptr_t)ldsv; const int lane = tid & 63, wave = __builtin_amdgcn_readfirstlane(tid >> 6); (void)lane; const int gw = bx * 8 + wave, ngw = G * 8; (void)gw; (void)ngw; const Ptrs P = ap->P; unsigned char* const ws = P.ws; unsigned* const ctl = (unsigned*)(ws + WS_CTL); (void)ctl;
#define STEP_OFF(k) if (0) { const int G = 1, bx = 0, gw = 0, ngw = 1, tid = 0, lane = 0, wave = 0; LAS unsigned char* const lds = lds0; (void)lane; (void)wave; const Ptrs P{}; unsigned char* const ws = nullptr; unsigned* const ctl = nullptr; (void)ctl;
#define STEP_END(k) if ((k) + 1 < hi) xcd_barrier(bar); }
    STEP_BEGIN(0)
        for (int lg = bx; lg < NL * NG; lg += G) p0_tables_item(P, lg, (LAS float*)lds, tid, MK_THREADS);
        __syncthreads();
        p0_transposes(P, (LAS float*)lds + wave * 64 * 33, gw, ngw, lane);
        norm_rows(P.x, (bf16*)(ws + WS_AB), nullptr, nullptr, 0, gw, ngw, lane);
    STEP_END(0)
#pragma unroll 1
    for (int l = 0; l < NL; ++l) {
        const int kb = 1 + 9 * l;
        if (l > 0) {
        STEP_BEGIN(kb + 0)
            norm_rows(P.out, (bf16*)(ws + WS_AB), nullptr, nullptr, 0, gw, ngw, lane);
        STEP_END(kb + 0)
        }
        STEP_BEGIN(kb + 1)
            pg8::DenseSched S{(const char*)(ws + WS_AB), (const char*)(ws + WS_WIN) + (size_t)l * INW * DM * 2, NT / 256, INW / 256, G, bx, (size_t)256 * DM * 2, (size_t)256 * DM * 2};
            pg8::EpiStoreBf16 E{(bf16*)(ws + WS_PROJ), INW};
            pg8::gemm_phase<pg8::EpiStoreBf16, pg8::DenseSched, false, true>(tid, lds, DM, DM, DM, S, E);
        STEP_END(kb + 1)
        STEP_BEGIN(kb + 2)
            attn::attn_phase(tid, lds, (const bf16*)(ws + WS_PROJ), (bf16*)(ws + WS_OB), (float*)(ws + WS_LSE), G, bx);
            ssm::ssm_phase(tid, lds, ws, l, G, bx);
        STEP_END(kb + 2)
        STEP_BEGIN(kb + 3)
            pg8::DenseSched S{(const char*)(ws + WS_YG), (const char*)(ws + WS_WGLU) + (size_t)l * SW * SW * 2, NT / 256, SW / 256, G, bx, (size_t)256 * SW * 2, (size_t)256 * SW * 2};
            pg8::EpiGlu E{(bf16*)(ws + WS_SSMO), (const bf16*)(ws + WS_YG), SW};
            pg8::gemm_phase<pg8::EpiGlu, pg8::DenseSched, false, true>(tid, lds, SW, SW, SW, S, E);
        STEP_END(kb + 3)
        STEP_BEGIN(kb + 4)
            for (int row = gw; row < NT; row += ngw) mix_row(row, lane, (const bf16*)(ws + WS_OB), (const float*)(ws + WS_LSE), (const bf16*)(ws + WS_SSMO), (bf16*)(ws + WS_AB));
        STEP_END(kb + 4)
        STEP_BEGIN(kb + 5)
            pg8::DenseSched S{(const char*)(ws + WS_AB), (const char*)(ws + WS_WOUT) + (size_t)l * DM * DM * 2, NT / 256, DM / 256, G, bx, (size_t)256 * DM * 2, (size_t)256 * DM * 2};
            pg8::EpiResid E{P.out, l == 0 ? P.x : P.out, DM};
            pg8::gemm_phase<pg8::EpiResid, pg8::DenseSched, false, true>(tid, lds, DM, DM, DM, S, E);
        STEP_END(kb + 5)
        STEP_BEGIN(kb + 6)
            for (int row = gw; row < NT; row += ngw) route_row(P, l, row, lane, P.out, (bf16*)(ws + WS_AB), (unsigned*)(ws + WS_TROUTE), (float*)(ws + WS_TW), (int*)(ws + WS_LTOK), (float*)(ws + WS_LW), ctl + CW_CNT + l * 32);
        STEP_END(kb + 6)
        STEP_BEGIN(kb + 7)
            LAS int* tpre = (LAS int*)(lds + LDS_CTL_OFF); pg8::moe_build_prefix(tid, tpre, ctl + CW_CNT + l * 32);
            pg8::MoeSched S{tpre, (const int*)(ws + WS_LTOK), (const char*)(ws + WS_AB), (const char*)(ws + WS_WGU), G, bx, l, 1};
            pg8::EpiMoeUp E{(bf16*)(ws + WS_ACT), (const float*)(ws + WS_LW)};
            pg8::gemm_phase<pg8::EpiMoeUp, pg8::MoeSched, true, true>(tid, lds, DM, DM, DM, S, E);
        STEP_END(kb + 7)
        STEP_BEGIN(kb + 8)
            LAS int* tpre = (LAS int*)(lds + LDS_CTL_OFF); pg8::moe_build_prefix(tid, tpre, ctl + CW_CNT + l * 32);
            pg8::MoeSched S{tpre, (const int*)(ws + WS_LTOK), (const char*)(ws + WS_ACT), (const char*)(ws + WS_WD), G, bx, l, 0};
            pg8::EpiMoeDown E{P.out, (const int*)(ws + WS_LTOK)};
            pg8::gemm_phase<pg8::EpiMoeDown, pg8::MoeSched, false, true>(tid, lds, 512, EFF, EFF, S, E);
        STEP_END(kb + 8)
    }
    STEP_BEGIN(1 + 9 * NL)
        norm_rows(P.out, nullptr, P.out, P.final_g, 2, gw, ngw, lane);
    STEP_END(1 + 9 * NL)
#undef STEP_BEGIN
#undef STEP_OFF
#undef STEP_END
}

#ifndef MK_SPLIT
#define MK_SPLIT 0
#endif
extern "C" void kernel_launch(void* const* d_in, const int* in_sizes, int n_in, void* d_out, int out_size, void* d_ws, size_t ws_size, hipStream_t stream) {
    if (n_in != 24 || out_size != NT * DM || ws_size < WS_END) { fprintf(stderr, "kernel_launch: unexpected shapes n_in %d out %d ws %zu (need %zu)\n", n_in, out_size, ws_size, (size_t)WS_END); return; }
    static int grid = 0;
    if (grid == 0) {
        int dev = 0, cus = 0, per_cu = 0;
        if (hipFuncSetAttribute((const void*)mk, hipFuncAttributeMaxDynamicSharedMemorySize, MK_LDS) != hipSuccess) { fprintf(stderr, "kernel_launch: hipFuncSetAttribute failed\n"); grid = -1; return; }
        if (hipGetDevice(&dev) != hipSuccess || hipDeviceGetAttribute(&cus, hipDeviceAttributeMultiprocessorCount, dev) != hipSuccess) { fprintf(stderr, "kernel_launch: device query failed\n"); grid = -1; return; }
        if (hipOccupancyMaxActiveBlocksPerMultiprocessor(&per_cu, (const void*)mk, MK_THREADS, MK_LDS) != hipSuccess || per_cu < 1) { fprintf(stderr, "kernel_launch: occupancy query failed (%d)\n", per_cu); grid = -1; return; }
        grid = cus * per_cu;
        fprintf(stderr, "kernel_launch: %d CUs x %d blocks/CU -> grid %d\n", cus, per_cu, grid);
    }
    if (grid < 0) return;
    Ptrs P{};
    const float** pf = (const float**)&P;
    for (int i = 0; i < 24; ++i) pf[i] = (const float*)d_in[i];
    P.out = (float*)d_out; P.ws = (unsigned char*)d_ws;
    (void)hipMemsetAsync(P.ws + WS_CTL, 0, 65536, stream);
    MkArgs a{}; a.P = P;
#if MK_SPLIT
    for (int pi = 0; pi < PROG_LEN; ++pi) { a.s_lo = pi; a.s_hi = pi + 1; hipLaunchKernelGGL(mk, dim3(grid), dim3(MK_THREADS), MK_LDS, stream, a); }
#else
    a.s_lo = 0; a.s_hi = PROG_LEN;
    void* kargs[] = {&a};
    const hipError_t e = hipLaunchCooperativeKernel((const void*)mk, dim3(grid), dim3(MK_THREADS), kargs, MK_LDS, stream);
    if (e != hipSuccess) fprintf(stderr, "kernel_launch: cooperative launch failed: %s (grid %d)\n", hipGetErrorString(e), grid);
#endif
}
```

```cpp
#include <hip/hip_runtime.h>
#include <cstdio>
#include <cstdint>

typedef unsigned short bf16;
typedef float f32x4 __attribute__((ext_vector_type(4)));
typedef unsigned u32x4 __attribute__((ext_vector_type(4)));
typedef unsigned u32x2 __attribute__((ext_vector_type(2)));
#define LAS __attribute__((address_space(3)))

constexpr int NB = 8, SEQ = 2048, DM = 1024, NL = 4, NT = NB * SEQ;
constexpr int AW = 512, HD = 64, NH = 8, SW = 512, GC = 16, NG = 32, NP = 64, INW = 2048;
constexpr int NE = 16, EFF = 256, NCLS = 24;
constexpr float RMS_EPS = 1e-6f;
constexpr int CL = 32;
constexpr int NCH = SEQ / CL;
constexpr int MKT = 512;

constexpr size_t al256(size_t x) { return (x + 255) & ~(size_t)255; }
constexpr size_t WS_CTL = 0, CTL_BYTES = 1u << 20;
constexpr size_t WS_WIN  = WS_CTL + CTL_BYTES;
constexpr size_t WS_WGLU = WS_WIN  + (size_t)NL * INW * DM * 2;
constexpr size_t WS_WOUT = WS_WGLU + (size_t)NL * SW * SW * 2;
constexpr size_t WS_WGU  = WS_WOUT + (size_t)NL * DM * DM * 2;
constexpr size_t WS_WD   = WS_WGU  + (size_t)NL * NE * 512 * DM * 2;
constexpr size_t WS_KTAB = WS_WD   + (size_t)NL * NE * DM * EFF * 2;
constexpr size_t WS_BB2  = WS_KTAB + al256((size_t)NL * NG * 33 * 256 * 2);
constexpr size_t WS_CC   = WS_BB2  + (size_t)NL * NG * 128 * 32 * 2;
constexpr size_t WS_LAMS = WS_CC   + (size_t)NL * NG * 16 * 128 * 2;
constexpr size_t WS_AB   = WS_LAMS + (size_t)NL * NG * 64 * 6 * 4;
constexpr size_t WS_YG   = WS_AB;
constexpr size_t WS_OB   = WS_AB + (size_t)NT * DM * 2;
constexpr size_t WS_TROUTE = WS_OB + (size_t)3 * NT * AW * 2;
constexpr size_t WS_TW   = WS_TROUTE + (size_t)NT * 4;
constexpr size_t WS_LTOK = WS_TW + (size_t)NT * 16;
constexpr size_t WS_LW   = WS_LTOK + (size_t)NCLS * NT * 4;
constexpr size_t WS_LSE  = WS_LW + (size_t)NCLS * NT * 16;
constexpr size_t WS_SS1  = WS_LSE + (size_t)3 * NT * NH * 4;
constexpr size_t WS_CNT2 = WS_SS1 + (size_t)NT * 16 * 4;
constexpr size_t WS_XB   = WS_CNT2 + (size_t)NL * 1024 * 32 * 4;
constexpr size_t WS_RS2  = WS_XB + (size_t)NT * DM * 2;
constexpr size_t WS_END  = WS_RS2 + (size_t)NT * 4;
static_assert(WS_END <= 325000000, "workspace map exceeds the guaranteed size");
constexpr int CW_CNT = 1024;

__device__ __forceinline__ unsigned f2bf(float f) { unsigned u = __builtin_bit_cast(unsigned, f); return (u + 0x7fffu + ((u >> 16) & 1u)) >> 16; }
__device__ __forceinline__ float bf2f(unsigned h) { return __builtin_bit_cast(float, h << 16); }
__device__ __forceinline__ unsigned pk2(float lo, float hi) { return f2bf(lo) | (f2bf(hi) << 16); }
__device__ __forceinline__ float lane_xor(float v, int lane, int o) { return __builtin_bit_cast(float, __builtin_amdgcn_ds_bpermute((lane ^ o) << 2, __builtin_bit_cast(int, v))); }
#define DPP_ADD(x, ctrl, rmask) ((x) + __builtin_bit_cast(float, __builtin_amdgcn_update_dpp(0, __builtin_bit_cast(int, (x)), (ctrl), (rmask), 0xf, true)))
__device__ __forceinline__ float wave_sum(float v, int) {
    v = DPP_ADD(v, 0x111, 0xf); v = DPP_ADD(v, 0x112, 0xf); v = DPP_ADD(v, 0x114, 0xf); v = DPP_ADD(v, 0x118, 0xf);
    v = DPP_ADD(v, 0x142, 0xa); v = DPP_ADD(v, 0x143, 0xc);
    return __builtin_bit_cast(float, __builtin_amdgcn_readlane(__builtin_bit_cast(int, v), 63));
}
__device__ __forceinline__ void store16_wt(void* p, u32x4 v) { asm volatile("global_store_dwordx4 %0, %1, off sc1\n\ts_nop 1" :: "v"(p), "v"(v) : "memory"); }
__device__ __forceinline__ void store16f_wt(void* p, f32x4 v) { asm volatile("global_store_dwordx4 %0, %1, off sc1\n\ts_nop 1" :: "v"(p), "v"(v) : "memory"); }
__device__ __forceinline__ float gelu_tanh(float y) {
    const float u = 0.7978845608028654f * (y + 0.044715f * y * y * y);
    const float e = __expf(2.f * u);
    const float th = 1.f - 2.f / (e + 1.f);
    return 0.5f * y * (1.f + th);
}
__device__ __forceinline__ float sigmoidf_(float z) { return 1.f / (1.f + __expf(-z)); }

struct Ptrs {
    const float *x, *ln1_g, *w_in, *lam_re, *lam_im, *log_dt, *b_re, *b_im, *c_re, *c_im, *d_skip, *w_glu, *gn_attn, *gn_ssm, *w_out, *ln2_g,
        *w_rg, *b_rg, *w_re, *b_re_, *w_gate, *w_up, *w_down, *final_g;
    float* out; unsigned char* ws;
};

__device__ __forceinline__ void unpack8(const u32x4 q, float (&o)[8]) { o[0] = bf2f(q.x & 0xffffu); o[1] = bf2f(q.x >> 16); o[2] = bf2f(q.y & 0xffffu); o[3] = bf2f(q.y >> 16); o[4] = bf2f(q.z & 0xffffu); o[5] = bf2f(q.z >> 16); o[6] = bf2f(q.w & 0xffffu); o[7] = bf2f(q.w >> 16); }
__device__ __forceinline__ void p0_transpose_item(const float* W, int N, const float* gain, bf16* WT, int K, LAS float* scr, int kb, int nb, int dst_row0, int lane) {
    const int k0 = 64 * kb, n0 = 32 * nb;
    const float* wp = W + (size_t)(k0 + (lane >> 5)) * N + n0 + (lane & 31);
    float v[32];
#pragma unroll
    for (int i = 0; i < 32; ++i) v[i] = wp[(size_t)(2 * i) * N];
    const int c = lane & 7;
    f32x4 g0 = (f32x4){1.f, 1.f, 1.f, 1.f}, g1 = g0;
    if (gain) { g0 = *(const f32x4*)(gain + k0 + 8 * c); g1 = *(const f32x4*)(gain + k0 + 8 * c + 4); }
#pragma unroll
    for (int i = 0; i < 32; ++i) scr[(2 * i + (lane >> 5)) * 33 + (lane & 31)] = v[i];
    asm volatile("s_waitcnt lgkmcnt(0)" ::: "memory");
#pragma unroll
    for (int j = 0; j < 4; ++j) { const int n = (lane >> 3) + 8 * j; const LAS float* s = scr + (8 * c) * 33 + n;
        u32x4 o; o.x = pk2(s[0 * 33] * g0[0], s[1 * 33] * g0[1]); o.y = pk2(s[2 * 33] * g0[2], s[3 * 33] * g0[3]); o.z = pk2(s[4 * 33] * g1[0], s[5 * 33] * g1[1]); o.w = pk2(s[6 * 33] * g1[2], s[7 * 33] * g1[3]);
        *(u32x4*)(WT + (size_t)(dst_row0 + n) * K + k0 + 8 * c) = o; }
    asm volatile("s_waitcnt lgkmcnt(0)" ::: "memory");
}
constexpr int IT_WIN = (DM / 64) * (INW / 32);
constexpr int IT_WGLU = (SW / 64) * (SW / 32);
constexpr int IT_WOUT = (DM / 64) * (DM / 32);
constexpr int IT_WG = (DM / 64) * (EFF / 32);
constexpr int IT_WDN = (EFF / 64) * (DM / 32);
constexpr int IT_PER_LAYER = IT_WIN + IT_WGLU + IT_WOUT + NE * (2 * IT_WG + IT_WDN);
constexpr int IT_TOTAL = NL * IT_PER_LAYER;
__device__ __forceinline__ void p0_transposes(const Ptrs& P, LAS float* scr, int gw, int ngw, int lane) {
    unsigned char* ws = P.ws;
#pragma unroll 1
    for (int it = gw; it < IT_TOTAL; it += ngw) {
        const int l = it / IT_PER_LAYER; int r = it % IT_PER_LAYER;
        if (r < IT_WIN) { const int nblk = INW / 32; p0_transpose_item(P.w_in + (size_t)l * DM * INW, INW, P.ln1_g + l * DM, (bf16*)(ws + WS_WIN) + (size_t)l * INW * DM, DM, scr, r / nblk, r % nblk, 32 * (r % nblk), lane); continue; }
        r -= IT_WIN;
        if (r < IT_WGLU) { const int nblk = SW / 32; p0_transpose_item(P.w_glu + (size_t)l * SW * SW, SW, nullptr, (bf16*)(ws + WS_WGLU) + (size_t)l * SW * SW, SW, scr, r / nblk, r % nblk, 32 * (r % nblk), lane); continue; }
        r -= IT_WGLU;
        if (r < IT_WOUT) { const int nblk = DM / 32; const int kb = r / nblk; const float* g = (kb < 8) ? (P.gn_attn + l * AW) : (P.gn_ssm + l * SW - AW);
            p0_transpose_item(P.w_out + (size_t)l * DM * DM, DM, g, (bf16*)(ws + WS_WOUT) + (size_t)l * DM * DM, DM, scr, kb, r % nblk, 32 * (r % nblk), lane); continue; }
        r -= IT_WOUT;
        const int e = r / (2 * IT_WG + IT_WDN); r %= (2 * IT_WG + IT_WDN);
        if (r < 2 * IT_WG) { const int up = r / IT_WG; r %= IT_WG; const int nblk = EFF / 32; const int kb = r / nblk, nb = r % nblk; const int f0 = 32 * nb;
            const float* src = (up ? P.w_up : P.w_gate) + ((size_t)l * NE + e) * DM * EFF;
            bf16* dst = (bf16*)(ws + WS_WGU) + ((size_t)l * NE + e) * 512 * DM;
            p0_transpose_item(src, EFF, P.ln2_g + l * DM, dst, DM, scr, kb, nb, (f0 / 128) * 256 + up * 128 + (f0 % 128), lane); continue; }
        r -= 2 * IT_WG;
        { const int nblk = DM / 32; p0_transpose_item(P.w_down + ((size_t)l * NE + e) * EFF * DM, DM, nullptr, (bf16*)(ws + WS_WD) + ((size_t)l * NE + e) * DM * EFF, EFF, scr, r / nblk, r % nblk, 32 * (r % nblk), lane); }
    }
}

__device__ __forceinline__ void p0_tables_item(const Ptrs& P, int lg, int half, LAS float* scr, int tid, int nthr) {
    typedef float f32x2 __attribute__((ext_vector_type(2)));
    LAS f32x2* pw = (LAS f32x2*)scr; LAS f32x2* Bb = pw + 33 * 64; LAS f32x2* Cc = Bb + 64 * 16;
    const int l = lg / NG, g = lg % NG;
    const float dt = expf(P.log_dt[lg]);
    const float* lre = P.lam_re + (size_t)lg * NP; const float* lim = P.lam_im + (size_t)lg * NP;
#pragma unroll 1
    for (int i = tid; i < 33 * 64; i += nthr) { const int tau = i / 64, p = i % 64;
        const float a = lre[p] * dt * (float)tau; const float turns = lim[p] * dt * 0.15915494309189535f;
        const float xh = (float)tau * turns, xl = fmaf((float)tau, turns, -xh); const float fr = (xh - rintf(xh)) + xl;
        float sn, cs; sincosf(6.283185307179586f * fr, &sn, &cs); const float mg = expf(a);
        pw[i] = (f32x2){mg * cs, mg * sn}; }
#pragma unroll 1
    for (int i = tid; i < 64 * 16; i += nthr) { const int p = i / 16, h = i % 16;
        const float a = lre[p] * dt, th = lim[p] * dt; float sn, cs; sincosf(th, &sn, &cs); float sh, ch; sincosf(0.5f * th, &sh, &ch); (void)ch;
        const float em1 = expm1f(a), ea = em1 + 1.f;
        const float nr = em1 * cs - 2.f * sh * sh, ni = ea * sn;
        const float c = lre[p], d = lim[p], den = 1.f / (c * c + d * d);
        const float qr = (nr * c + ni * d) * den, qi = (ni * c - nr * d) * den;
        const float br = P.b_re[((size_t)lg * NP + p) * GC + h], bi = P.b_im[((size_t)lg * NP + p) * GC + h];
        Bb[i] = (f32x2){qr * br - qi * bi, qr * bi + qi * br}; }
#pragma unroll 1
    for (int i = tid; i < 16 * 64; i += nthr) { const int h = i / 64, p = i % 64;
        Cc[i] = (f32x2){P.c_re[((size_t)lg * GC + h) * NP + p], P.c_im[((size_t)lg * GC + h) * NP + p]}; }
    __syncthreads();
    unsigned char* ws = P.ws;
    bf16* Bb2 = (bf16*)(ws + WS_BB2) + (size_t)lg * 128 * 32;
    bf16* Ccm = (bf16*)(ws + WS_CC) + (size_t)lg * 16 * 128;
    bf16* Kt = (bf16*)(ws + WS_KTAB) + (size_t)lg * 33 * 256;
    float* Lams = (float*)(ws + WS_LAMS) + (size_t)lg * 64 * 6;
    if (half == 0)
#pragma unroll 1
    for (int i = tid; i < 128 * 32; i += nthr) { const int row = i >> 5, col = i & 31; const int p = row >> 1, cc = row & 1, h = col & 15; f32x2 b = Bb[p * 16 + h];
        if (col < 16) { const f32x2 w = pw[64 + p]; b = (f32x2){w.x * b.x - w.y * b.y, w.x * b.y + w.y * b.x}; }
        Bb2[i] = (bf16)f2bf(cc ? b.y : b.x); }
    if (half == 1)
#pragma unroll 1
    for (int i = tid; i < 16 * 128; i += nthr) { const int h = i >> 7, st = i & 127; const f32x2 c = Cc[h * 64 + (st >> 1)]; Ccm[i] = (bf16)f2bf((st & 1) ? -c.y : c.x); }
#pragma unroll 1
    for (int i = (half ? 17 * 256 : 0) + tid; i < (half ? 33 * 256 : 17 * 256); i += nthr) { const int t1 = i / 256, h = (i >> 4) & 15, hp = i & 15; float sacc = 0.f;
        if (t1 > 0) { const int tau = t1 - 1;
            for (int p = 0; p < 64; ++p) { const f32x2 c = Cc[h * 64 + p], w = pw[tau * 64 + p], b = Bb[p * 16 + hp]; const float cr = c.x * w.x - c.y * w.y, ci = c.x * w.y + c.y * w.x; sacc += cr * b.x - ci * b.y; }
            if (tau == 0 && h == hp) sacc += P.d_skip[(size_t)lg * GC + h]; }
        Kt[i] = (bf16)f2bf(sacc); }
    if (half == 1)
#pragma unroll 1
    for (int i = tid; i < 64; i += nthr) { const f32x2 w1 = pw[64 + i], w2 = pw[128 + i], w32 = pw[32 * 64 + i]; float* o = Lams + i * 6; o[0] = w1.x; o[1] = w1.y; o[2] = w2.x; o[3] = w2.y; o[4] = w32.x; o[5] = w32.y; }
    __syncthreads();
    (void)l; (void)g;
}

__device__ __forceinline__ void route_build_lds(const Ptrs& P, int l, LAS f32x4* GW, int tid) {
    for (int idx = tid; idx < 5 * DM; idx += MKT) { const int ep = idx >> 10, k = idx & 1023; const int j = k >> 9, c = k & 7, ln = (k & 511) >> 3;
        const float g = P.ln2_g[l * DM + k];
        const f32x4 w = ep == 0 ? *(const f32x4*)(P.w_rg + ((size_t)l * DM + k) * 4) : *(const f32x4*)(P.w_re + (((size_t)l * 4 + (ep - 1)) * DM + k) * 4);
        GW[((ep * 2 + j) * 8 + c) * 64 + ln] = w * g; }
    __syncthreads();
}
template <int NR> __device__ __forceinline__ void route_rows(const Ptrs& P, int l, const int r0, const int rstride, int lane, const LAS f32x4* GW, const bf16* XB, unsigned* troute, f32x4* tw, LAS int* lcnt) {
    float v[NR][2][8]; float rstd[NR];
#pragma unroll
    for (int q = 0; q < NR; ++q) { const u32x4* xr = (const u32x4*)(XB + (size_t)(r0 + q * rstride) * DM) + lane;
#pragma unroll
        for (int j = 0; j < 2; ++j) unpack8(xr[64 * j], v[q][j]); }
#pragma unroll
    for (int q = 0; q < NR; ++q) { float s = 0.f;
#pragma unroll
        for (int j = 0; j < 2; ++j)
#pragma unroll
            for (int c = 0; c < 8; ++c) s += v[q][j][c] * v[q][j][c];
        rstd[q] = 1.f / sqrtf(wave_sum(s, lane) * (1.f / DM) + RMS_EPS); }
    f32x4 acc[NR];
#pragma unroll
    for (int q = 0; q < NR; ++q) acc[q] = (f32x4){0.f, 0.f, 0.f, 0.f};
#pragma unroll
    for (int j = 0; j < 2; ++j)
#pragma unroll
        for (int c = 0; c < 8; ++c) { const f32x4 w = GW[(j * 8 + c) * 64 + lane];
#pragma unroll
            for (int q = 0; q < NR; ++q) acc[q] += v[q][j][c] * w; }
    int grp[NR]; float g1[NR];
#pragma unroll
    for (int q = 0; q < NR; ++q) { float gl[4];
#pragma unroll
        for (int e = 0; e < 4; ++e) gl[e] = wave_sum(acc[q][e], lane) * rstd[q] + P.b_rg[l * 4 + e];
        int gi = 0; float gm = gl[0];
#pragma unroll
        for (int e = 1; e < 4; ++e) if (gl[e] > gm) { gm = gl[e]; gi = e; }
        float gs = 0.f;
#pragma unroll
        for (int e = 0; e < 4; ++e) gs += expf(gl[e] - gm);
        grp[q] = gi; g1[q] = 1.f / gs; acc[q] = (f32x4){0.f, 0.f, 0.f, 0.f}; }
#pragma unroll
    for (int j = 0; j < 2; ++j)
#pragma unroll
        for (int c = 0; c < 8; ++c)
#pragma unroll
            for (int q = 0; q < NR; ++q) acc[q] += v[q][j][c] * GW[(((1 + grp[q]) * 2 + j) * 8 + c) * 64 + lane];
#pragma unroll
    for (int q = 0; q < NR; ++q) { float el[4];
#pragma unroll
        for (int e = 0; e < 4; ++e) el[e] = wave_sum(acc[q][e], lane) * rstd[q] + P.b_re_[(l * 4 + grp[q]) * 4 + e];
        int i1 = 0; float v1 = el[0];
#pragma unroll
        for (int e = 1; e < 4; ++e) if (el[e] > v1) { v1 = el[e]; i1 = e; }
        int i2 = -1; float v2 = -INFINITY;
#pragma unroll
        for (int e = 0; e < 4; ++e) if (e != i1 && el[e] > v2) { v2 = el[e]; i2 = e; }
        const float e2 = expf(v2 - v1); const float w1 = g1[q] / (1.f + e2), w2 = g1[q] * e2 / (1.f + e2);
        const int a = i1 < i2 ? i1 : i2, b = i1 < i2 ? i2 : i1; const float wa = i1 < i2 ? w1 : w2, wb = i1 < i2 ? w2 : w1;
        const int pair = (a == 0) ? (b - 1) : (a == 1 ? (b + 1) : 5);
        const int cls = grp[q] * 6 + pair; const int row = r0 + q * rstride;
        if (lane == 0) {
            const int lslot = __hip_atomic_fetch_add(lcnt + cls, 1, __ATOMIC_RELAXED, __HIP_MEMORY_SCOPE_WORKGROUP);
            troute[row] = (unsigned)(grp[q] * 4 + a) | ((unsigned)(grp[q] * 4 + b) << 8) | ((unsigned)cls << 16) | ((unsigned)lslot << 24);
            tw[row] = (f32x4){wa, wb, rstd[q], 0.f};
        } }
}

__device__ __forceinline__ void mix_row(int row, int lane, const bf16* OB, const float* LSE, const bf16* SSMO, bf16* AB) {
    const int h = lane >> 3;
    float ls[3], m = -INFINITY;
#pragma unroll
    for (int b = 0; b < 3; ++b) { ls[b] = LSE[((size_t)b * NT + row) * NH + h]; m = fmaxf(m, ls[b]); }
    float w[3], ws_ = 0.f;
#pragma unroll
    for (int b = 0; b < 3; ++b) { w[b] = expf(ls[b] - m); ws_ += w[b]; }
    float o[8];
#pragma unroll
    for (int i = 0; i < 8; ++i) o[i] = 0.f;
#pragma unroll
    for (int b = 0; b < 3; ++b) { const u32x4 q = *((const u32x4*)(OB + ((size_t)b * NT + row) * AW) + lane); const float wb = w[b] / ws_;
        o[0] += wb * bf2f(q.x & 0xffffu); o[1] += wb * bf2f(q.x >> 16); o[2] += wb * bf2f(q.y & 0xffffu); o[3] += wb * bf2f(q.y >> 16);
        o[4] += wb * bf2f(q.z & 0xffffu); o[5] += wb * bf2f(q.z >> 16); o[6] += wb * bf2f(q.w & 0xffffu); o[7] += wb * bf2f(q.w >> 16); }
    float s = 0.f;
#pragma unroll
    for (int i = 0; i < 8; ++i) s += o[i] * o[i];
    float rstd = 1.f / sqrtf(wave_sum(s, lane) * (1.f / AW) + RMS_EPS);
    *((u32x4*)(AB + (size_t)row * DM) + lane) = (u32x4){pk2(o[0] * rstd, o[1] * rstd), pk2(o[2] * rstd, o[3] * rstd), pk2(o[4] * rstd, o[5] * rstd), pk2(o[6] * rstd, o[7] * rstd)};
    const u32x4 q = *((const u32x4*)(SSMO + (size_t)row * SW) + lane);
    o[0] = bf2f(q.x & 0xffffu); o[1] = bf2f(q.x >> 16); o[2] = bf2f(q.y & 0xffffu); o[3] = bf2f(q.y >> 16); o[4] = bf2f(q.z & 0xffffu); o[5] = bf2f(q.z >> 16); o[6] = bf2f(q.w & 0xffffu); o[7] = bf2f(q.w >> 16);
    s = 0.f;
#pragma unroll
    for (int i = 0; i < 8; ++i) s += o[i] * o[i];
    rstd = 1.f / sqrtf(wave_sum(s, lane) * (1.f / SW) + RMS_EPS);
    *((u32x4*)(AB + (size_t)row * DM + AW) + lane) = (u32x4){pk2(o[0] * rstd, o[1] * rstd), pk2(o[2] * rstd, o[3] * rstd), pk2(o[4] * rstd, o[5] * rstd), pk2(o[6] * rstd, o[7] * rstd)};
}
namespace pg8 {
typedef short bf16x8 __attribute__((ext_vector_type(8)));
constexpr int BM = 256, BK = 64, HALF = 128, HTB = HALF * BK * 2, STAGE_BYTES = 8 * HTB, NXCD = 8, WGM = 8;
__host__ __device__ __forceinline__ int lds_byte(int r, int c) { const int st = (r >> 4) * 2 + (c >> 5), rr = r & 15, cc = c & 31, ob = rr * 64 + cc * 2; return st * 1024 + (ob ^ (((ob >> 9) & 1) << 5)); }
__host__ __device__ __forceinline__ void stage_rc(int b, int& R, int& C) { const int st = b / 1024, sb = b % 1024, swz = sb ^ (((sb >> 9) & 1) << 5); R = (st >> 1) * 16 + swz / 64; C = (st & 1) * 32 + (swz % 64) / 2; }
__host__ __device__ __forceinline__ int perm32(int rho) { const int n = rho >> 4, i = rho & 15; return 8 * (i >> 2) + 4 * n + (i & 3); }
struct Unit { int pm, pn; const char* a; const char* b; int x0, x1, x2, fl; };
__device__ __forceinline__ bool static_order(int nM, int nN, int G, int c, int i, int& pm, int& pn) {
    const int nwg = nM * nN; const long L = (long)i * G + c; if (L >= nwg) return false;
    int wgid = (int)L; { const int q = nwg / NXCD, r = nwg % NXCD, xcd = wgid % NXCD, off = wgid / NXCD; wgid = (xcd < r ? xcd * (q + 1) : r * (q + 1) + (xcd - r) * q) + off; }
    const int nig = WGM * nN, gid = wgid / nig, fm = gid * WGM, gsz = (nM - fm) < WGM ? (nM - fm) : WGM;
    pm = fm + ((wgid % nig) % gsz); pn = (wgid % nig) / gsz; return true;
}
__device__ __forceinline__ unsigned cvt_pk_bf16(float lo, float hi) { unsigned r; asm volatile("v_cvt_pk_bf16_f32 %0, %1, %2" : "=v"(r) : "v"(lo), "v"(hi)); return r; }
template <class Epi, class Sched, bool GATHER, bool ALIGN_EPI>
__device__ __forceinline__ void gemm_phase(const int tid, LAS unsigned char* lds, const int lda, const int ldb, const int K, const Sched& S, const Epi& E) {
    const int wid = __builtin_amdgcn_readfirstlane(tid >> 6), lane = tid & 63, wr = wid >> 2, wc = wid & 3, fr = lane & 15, fq = lane >> 4;
    const int nt = K / BK;
    int Rr[2], Cc[2]; unsigned voffB[2], cvA0[2], cvA1[2], nvA0[2], nvA1[2];
#pragma unroll
    for (int i = 0; i < 2; ++i) { stage_rc(tid * 16 + i * 8192, Rr[i], Cc[i]); const int Rb = Epi::PERM ? ((Rr[i] & ~31) + perm32(Rr[i] & 31)) : Rr[i]; voffB[i] = (unsigned)(Rb * ldb + Cc[i]) * 2u; }
    const size_t kstep = (size_t)(BK * 2);
    const size_t hstepB = (size_t)HALF * ldb * 2;
    const unsigned ldsw = (unsigned)wid * 1024u;
    const int aoff = lds_byte(wr * 64 + fr, fq * 8), boff = lds_byte(wc * 32 + fr, fq * 8);
#define PG8_SA(b, h) (((b) * 2 + (h)) * HTB)
#define PG8_SB(b, h) ((4 + (b) * 2 + (h)) * HTB)
#define PG8_STAGE(bufoff, gbase, voff) do { _Pragma("unroll") for (int _i = 0; _i < 2; ++_i) \
        __builtin_amdgcn_global_load_lds((const unsigned*)((const char*)(gbase) + (voff)[_i]), (LAS unsigned*)(lds + (bufoff) + ldsw + _i * 8192), 16, 0, 0); } while (0)
#define PG8_LDA(dst, b, h) do { _Pragma("unroll") for (int m = 0; m < 4; ++m) _Pragma("unroll") for (int k = 0; k < 2; ++k) dst[m][k] = *(const LAS bf16x8*)(lds + PG8_SA(b, h) + aoff + m * 2048 + k * 1024); } while (0)
#define PG8_LDB(dst, b, h) do { _Pragma("unroll") for (int n = 0; n < 2; ++n) _Pragma("unroll") for (int k = 0; k < 2; ++k) dst[n][k] = *(const LAS bf16x8*)(lds + PG8_SB(b, h) + boff + n * 2048 + k * 1024); } while (0)
#define PG8_MMA(ai, bj, At, Bt) do { __builtin_amdgcn_s_setprio(1); _Pragma("unroll") for (int m = 0; m < 4; ++m) _Pragma("unroll") for (int n = 0; n < 2; ++n) _Pragma("unroll") for (int k = 0; k < 2; ++k) \
        acc[ai][bj][m][n] = __builtin_amdgcn_mfma_f32_16x16x32_bf16(Bt[n][k], At[m][k], acc[ai][bj][m][n], 0, 0, 0); __builtin_amdgcn_s_setprio(0); } while (0)
#define PG8_WAIT_V(n) asm volatile("s_waitcnt vmcnt(" #n ")" ::: "memory")
#define PG8_WAIT_L(n) asm volatile("s_waitcnt lgkmcnt(" #n ")" ::: "memory")
#define PG8_BAR __builtin_amdgcn_s_barrier()
#define PG8_SCHED __builtin_amdgcn_sched_barrier(0)
#define PG8_BP(u, tile) ((u).b + (size_t)(tile) * kstep)
#define PG8_SETA(u, v0, v1) do { _Pragma("unroll") for (int _i = 0; _i < 2; ++_i) { \
        if (GATHER) { v0[_i] = S.rowoff(u, Rr[_i]) + (unsigned)Cc[_i] * 2u; v1[_i] = S.rowoff(u, HALF + Rr[_i]) + (unsigned)Cc[_i] * 2u; } \
        else { v0[_i] = (unsigned)(Rr[_i] * lda + Cc[_i]) * 2u; v1[_i] = v0[_i] + (unsigned)(HALF * lda * 2); } } } while (0)
    Unit cur, nxt; int ui = 0;
    if (!S.next(0, cur)) return;
    PG8_SETA(cur, cvA0, cvA1);
    f32x4 acc[2][2][4][2];
#pragma unroll
    for (int a = 0; a < 2; ++a)
#pragma unroll
        for (int b = 0; b < 2; ++b)
#pragma unroll
            for (int m = 0; m < 4; ++m)
#pragma unroll
                for (int n = 0; n < 2; ++n) acc[a][b][m][n] = (f32x4){0.f, 0.f, 0.f, 0.f};
    bf16x8 At[4][2], B0[2][2], B1[2][2];
    {   const char* cB = PG8_BP(cur, 0); const char* cB1 = PG8_BP(cur, 1);
        PG8_STAGE(PG8_SB(0, 0), cB, voffB); PG8_STAGE(PG8_SB(0, 1), cB + hstepB, voffB); PG8_STAGE(PG8_SA(0, 0), cur.a, cvA0); PG8_STAGE(PG8_SA(0, 1), cur.a, cvA1);
        if (wr == 1) PG8_BAR;
        PG8_WAIT_V(2); PG8_BAR;
        PG8_STAGE(PG8_SB(1, 0), cB1, voffB); PG8_STAGE(PG8_SA(1, 0), cur.a + kstep, cvA0); PG8_STAGE(PG8_SB(1, 1), cB1 + hstepB, voffB);
        PG8_WAIT_V(6); PG8_BAR; }
    for (;;) {
        const bool has_next = S.next(ui + 1, nxt);
        if (has_next) { PG8_SETA(nxt, nvA0, nvA1); } else {
#pragma unroll
            for (int i = 0; i < 2; ++i) { nvA0[i] = cvA0[i]; nvA1[i] = cvA1[i]; } }
        const char* nA = has_next ? nxt.a : cur.a; const char* nB = has_next ? PG8_BP(nxt, 0) : PG8_BP(cur, 0);
        for (int t = 0; t < nt; t += 2) {
            const bool last = (t == nt - 2);
            const char* a1 = cur.a + (size_t)(t + 1) * kstep;
            const char* a2 = last ? nA : cur.a + (size_t)(t + 2) * kstep; const char* b2 = last ? nB : PG8_BP(cur, t + 2);
            const char* a3 = a2 + kstep; const char* b3 = b2 + kstep;
            unsigned vo0[2], vo1[2];
#pragma unroll
            for (int i = 0; i < 2; ++i) { vo0[i] = last ? nvA0[i] : cvA0[i]; vo1[i] = last ? nvA1[i] : cvA1[i]; }
            PG8_LDB(B0, 0, 0); PG8_LDB(B1, 0, 1); PG8_SCHED; PG8_LDA(At, 0, 0); PG8_STAGE(PG8_SA(1, 1), a1, cvA1);
            PG8_WAIT_V(8); PG8_WAIT_L(0); PG8_BAR; PG8_MMA(0, 0, At, B0); PG8_MMA(0, 1, At, B1); PG8_BAR; PG8_SCHED;
            PG8_LDA(At, 0, 1); PG8_STAGE(PG8_SB(0, 0), b2, voffB); PG8_STAGE(PG8_SB(0, 1), b2 + hstepB, voffB); PG8_STAGE(PG8_SA(0, 0), a2, vo0);
            PG8_WAIT_V(8); PG8_WAIT_L(0); PG8_BAR; PG8_MMA(1, 0, At, B0); PG8_MMA(1, 1, At, B1); PG8_BAR; PG8_SCHED;
            PG8_LDB(B0, 1, 0); PG8_LDB(B1, 1, 1); PG8_SCHED; PG8_LDA(At, 1, 0); PG8_STAGE(PG8_SA(0, 1), a2, vo1);
            PG8_WAIT_V(8); PG8_WAIT_L(0); PG8_BAR; PG8_MMA(0, 0, At, B0); PG8_MMA(0, 1, At, B1); PG8_BAR; PG8_SCHED;
            PG8_LDA(At, 1, 1); PG8_STAGE(PG8_SB(1, 0), b3, voffB); PG8_STAGE(PG8_SB(1, 1), b3 + hstepB, voffB); PG8_STAGE(PG8_SA(1, 0), a3, vo0);
            PG8_WAIT_V(8); PG8_WAIT_L(0); PG8_BAR; PG8_MMA(1, 0, At, B0); PG8_MMA(1, 1, At, B1); PG8_BAR; PG8_SCHED;
        }
        const bool epi = (cur.fl & 2) != 0;
        if (epi) {
            if constexpr (ALIGN_EPI) { if (wr == 0) PG8_BAR; }
            { int t2 = tid; asm volatile("" : "+v"(t2));
              const int w2 = __builtin_amdgcn_readfirstlane(t2 >> 6), l2 = t2 & 63; E(acc, cur, w2 >> 2, w2 & 3, l2 & 15, l2 >> 4); }
        }
        if (!has_next) break;
        if (nxt.fl & 1) {
#pragma unroll
            for (int a = 0; a < 2; ++a)
#pragma unroll
                for (int b = 0; b < 2; ++b)
#pragma unroll
                    for (int m = 0; m < 4; ++m)
#pragma unroll
                        for (int n = 0; n < 2; ++n) acc[a][b][m][n] = (f32x4){0.f, 0.f, 0.f, 0.f};
        }
        cur = nxt; ++ui;
#pragma unroll
        for (int i = 0; i < 2; ++i) { cvA0[i] = nvA0[i]; cvA1[i] = nvA1[i]; }
        if (epi) { if constexpr (ALIGN_EPI) { if (wr == 1) PG8_BAR; } }
    }
    PG8_WAIT_V(0);
    if constexpr (!ALIGN_EPI) { if (wr == 0) PG8_BAR; }
    PG8_BAR;
#undef PG8_SA
#undef PG8_SB
#undef PG8_STAGE
#undef PG8_LDA
#undef PG8_LDB
#undef PG8_MMA
#undef PG8_WAIT_V
#undef PG8_WAIT_L
#undef PG8_BAR
#undef PG8_SCHED
#undef PG8_BP
#undef PG8_SETA
}

struct DenseSched {
    const char* A; const char* Bt; int nM, nN, G, c; size_t atile, btile;
    __device__ __forceinline__ bool next(int i, Unit& u) const { int pm, pn; if (!static_order(nM, nN, G, c, i, pm, pn)) return false;
        u.pm = pm; u.pn = pn; u.a = A + (size_t)pm * atile; u.b = Bt + (size_t)pn * btile; u.x0 = u.x1 = u.x2 = 0; u.fl = 3; return true; }
    __device__ __forceinline__ unsigned rowoff(const Unit&, int) const { return 0u; }
};
struct EpiStoreBf16 {
    static constexpr bool PERM = true; bf16* C; int ldc; const float* ss;
    __device__ __forceinline__ void operator()(const f32x4 (&acc)[2][2][4][2], const Unit& u, int wr, int wc, int fr, int fq) const {
        const int row0 = u.pm * BM + wr * 64 + fr, col0 = u.pn * BM + wc * 32 + 8 * fq;
#pragma unroll
        for (int ai = 0; ai < 2; ++ai)
#pragma unroll
            for (int m = 0; m < 4; ++m) { const int row = row0 + ai * HALF + m * 16; bf16* rowp = C + (size_t)row * ldc + col0; const f32x4* sp = (const f32x4*)(ss + (size_t)row * 16); const f32x4 s4 = (sp[0] + sp[1]) + (sp[2] + sp[3]); const float r = 1.f / sqrtf(((s4[0] + s4[1]) + (s4[2] + s4[3])) * (1.f / DM) + RMS_EPS);
#pragma unroll
                for (int bj = 0; bj < 2; ++bj) { const f32x4 v0 = acc[ai][bj][m][0] * r, v1 = acc[ai][bj][m][1] * r;
                    store16_wt(rowp + bj * HALF, (u32x4){cvt_pk_bf16(v0[0], v0[1]), cvt_pk_bf16(v0[2], v0[3]), cvt_pk_bf16(v1[0], v1[1]), cvt_pk_bf16(v1[2], v1[3])}); } }
    }
};
struct EpiGlu {
    static constexpr bool PERM = true; bf16* C; const bf16* aux; int ldc;
    __device__ __forceinline__ void operator()(const f32x4 (&acc)[2][2][4][2], const Unit& u, int wr, int wc, int fr, int fq) const {
        const int row0 = u.pm * BM + wr * 64 + fr, col0 = u.pn * BM + wc * 32 + 8 * fq;
#pragma unroll
        for (int ai = 0; ai < 2; ++ai)
#pragma unroll
            for (int m = 0; m < 4; ++m) { const size_t ro = (size_t)(row0 + ai * HALF + m * 16) * ldc + col0;
#pragma unroll
                for (int bj = 0; bj < 2; ++bj) { const f32x4 v0 = acc[ai][bj][m][0], v1 = acc[ai][bj][m][1]; const u32x4 y = *(const u32x4*)(aux + ro + bj * HALF);
                    float r[8]; r[0] = bf2f(y.x & 0xffffu) * sigmoidf_(v0[0]); r[1] = bf2f(y.x >> 16) * sigmoidf_(v0[1]); r[2] = bf2f(y.y & 0xffffu) * sigmoidf_(v0[2]); r[3] = bf2f(y.y >> 16) * sigmoidf_(v0[3]);
                    r[4] = bf2f(y.z & 0xffffu) * sigmoidf_(v1[0]); r[5] = bf2f(y.z >> 16) * sigmoidf_(v1[1]); r[6] = bf2f(y.w & 0xffffu) * sigmoidf_(v1[2]); r[7] = bf2f(y.w >> 16) * sigmoidf_(v1[3]);
                    *(u32x4*)(C + ro + bj * HALF) = (u32x4){cvt_pk_bf16(r[0], r[1]), cvt_pk_bf16(r[2], r[3]), cvt_pk_bf16(r[4], r[5]), cvt_pk_bf16(r[6], r[7])}; } }
    }
};
struct EpiResid {
    static constexpr bool PERM = true; bf16* XB; int ldc;
    __device__ __forceinline__ void operator()(const f32x4 (&acc)[2][2][4][2], const Unit& u, int wr, int wc, int fr, int fq) const {
        const int row0 = u.pm * BM + wr * 64 + fr, col0 = u.pn * BM + wc * 32 + 8 * fq;
#pragma unroll
        for (int ai = 0; ai < 2; ++ai)
#pragma unroll
            for (int m = 0; m < 4; ++m) { const size_t ro = (size_t)(row0 + ai * HALF + m * 16) * ldc + col0;
#pragma unroll
                for (int bj = 0; bj < 2; ++bj) { float b[8]; unpack8(*(const u32x4*)(XB + ro + bj * HALF), b); const f32x4 a0 = acc[ai][bj][m][0], a1 = acc[ai][bj][m][1];
                    *(u32x4*)(XB + ro + bj * HALF) = (u32x4){cvt_pk_bf16(b[0] + a0[0], b[1] + a0[1]), cvt_pk_bf16(b[2] + a0[2], b[3] + a0[3]), cvt_pk_bf16(b[4] + a1[0], b[5] + a1[1]), cvt_pk_bf16(b[6] + a1[2], b[7] + a1[3])}; } }
    }
};
__device__ __forceinline__ void moe_build_prefix(const int tid, LAS int* tpre, unsigned* cnt) {
    __syncthreads();
    if (tid == 0) { int s = 0;
#pragma unroll 1
        for (int c = 0; c < NCLS; ++c) { const int n = (int)__hip_atomic_load(cnt + c, __ATOMIC_RELAXED, __HIP_MEMORY_SCOPE_AGENT); tpre[c] = s; tpre[32 + c] = n; s += (n + 255) >> 8; } tpre[NCLS] = s; }
    __syncthreads();
}
__device__ __forceinline__ void pair_decode(int pair, int& a, int& b) { a = pair < 3 ? 0 : (pair < 5 ? 1 : 2); b = pair < 3 ? pair + 1 : (pair < 5 ? pair - 1 : 3); }
struct MoeSched {
    const LAS int* tpre; const int* ltok; const char* A; const char* W; int G, c, l, up;
    __device__ __forceinline__ bool next(int i, Unit& u) const {
        const int MT = __builtin_amdgcn_readfirstlane(tpre[NCLS]); int pm, pn; const int seg = up ? 0 : (i & 1);
        if (!static_order(MT, 4, G, c, up ? i : (i >> 1), pm, pn)) return false;
        int cls = 0;
#pragma unroll 1
        for (int q = 1; q < NCLS; ++q) if (pm >= __builtin_amdgcn_readfirstlane(tpre[q])) cls = q;
        const int grp = cls / 6; int ea, eb; pair_decode(cls % 6, ea, eb); ea += grp * 4; eb += grp * 4;
        u.pm = pm; u.pn = pn; u.x0 = cls; u.x1 = (pm - __builtin_amdgcn_readfirstlane(tpre[cls])) * 256; u.x2 = __builtin_amdgcn_readfirstlane(tpre[32 + cls]);
        if (up) { const int e = pn < 2 ? ea : eb; u.a = A; u.b = W + ((size_t)((l * NE + e) * 2 + (pn & 1))) * 256 * DM * 2; u.fl = 3; }
        else { const int e = seg ? eb : ea; u.a = A + (size_t)pm * 256 * 512 * 2 + seg * (EFF * 2); u.b = W + ((size_t)(l * NE + e) * DM + pn * 256) * EFF * 2; u.fl = seg ? 2 : 1; }
        return true;
    }
    __device__ __forceinline__ unsigned rowoff(const Unit& u, int r) const { int i = u.x1 + r; i = i < u.x2 ? i : u.x2 - 1; return (unsigned)ltok[(size_t)u.x0 * NT + i] * (unsigned)(DM * 2); }
};
struct EpiMoeUp {
    static constexpr bool PERM = true; bf16* ACT; const f32x4* lw;
    __device__ __forceinline__ void operator()(const f32x4 (&acc)[2][2][4][2], const Unit& u, int wr, int wc, int fr, int fq) const {
        const int col0 = (u.pn >> 1) * 256 + (u.pn & 1) * 128 + wc * 32 + 8 * fq;
#pragma unroll
        for (int ai = 0; ai < 2; ++ai)
#pragma unroll
            for (int m = 0; m < 4; ++m) { const int r = ai * HALF + wr * 64 + m * 16 + fr; int i = u.x1 + r; i = i < u.x2 ? i : u.x2 - 1;
                const f32x4 lwv = lw[(size_t)u.x0 * NT + i]; const float w = (u.pn >> 1) ? lwv[1] : lwv[0], rs = lwv[2];
                const f32x4 g0 = acc[ai][0][m][0], g1 = acc[ai][0][m][1], u0 = acc[ai][1][m][0], u1 = acc[ai][1][m][1]; float v[8];
#pragma unroll
                for (int j = 0; j < 4; ++j) { const float ga = g0[j] * rs, gb = g1[j] * rs; v[j] = ga * sigmoidf_(ga) * (u0[j] * rs) * w; v[4 + j] = gb * sigmoidf_(gb) * (u1[j] * rs) * w; }
                *(u32x4*)(ACT + (size_t)(u.pm * BM + r) * 512 + col0) = (u32x4){cvt_pk_bf16(v[0], v[1]), cvt_pk_bf16(v[2], v[3]), cvt_pk_bf16(v[4], v[5]), cvt_pk_bf16(v[6], v[7])}; }
    }
};
template <bool DRY> struct EpiMoeDown {
    static constexpr bool PERM = true; bf16* XB; const int* ltok; float* SS;
    __device__ __forceinline__ void operator()(const f32x4 (&acc)[2][2][4][2], const Unit& u, int wr, int wc, int fr, int fq) const {
        const int col0 = u.pn * BM + wc * 32 + 8 * fq; const int lane = fr + 16 * fq;
#pragma unroll
        for (int ai = 0; ai < 2; ++ai)
#pragma unroll
            for (int m = 0; m < 4; ++m) { const int r = ai * HALF + wr * 64 + m * 16 + fr; const int i = u.x1 + r; const bool ok = i < u.x2;
                const int tok = ltok[(size_t)u.x0 * NT + (ok ? i : u.x2 - 1)]; const size_t ro = (size_t)tok * DM + col0; u32x4 xv[2];
#pragma unroll
                for (int bj = 0; bj < 2; ++bj) xv[bj] = *(const u32x4*)(XB + ro + bj * HALF);
                float ssq = 0.f;
#pragma unroll
                for (int bj = 0; bj < 2; ++bj) { float b[8]; unpack8(xv[bj], b); const f32x4 a0 = acc[ai][bj][m][0], a1 = acc[ai][bj][m][1];
                    if (!DRY) { b[0] += a0[0]; b[1] += a0[1]; b[2] += a0[2]; b[3] += a0[3]; b[4] += a1[0]; b[5] += a1[1]; b[6] += a1[2]; b[7] += a1[3]; }
                    const u32x4 o = (u32x4){cvt_pk_bf16(b[0], b[1]), cvt_pk_bf16(b[2], b[3]), cvt_pk_bf16(b[4], b[5]), cvt_pk_bf16(b[6], b[7])};
                    float rb[8]; unpack8(o, rb);
#pragma unroll
                    for (int e = 0; e < 8; ++e) ssq += rb[e] * rb[e];
                    if (ok) *(u32x4*)(XB + ro + bj * HALF) = o; }
                ssq += lane_xor(ssq, lane, 16); ssq += lane_xor(ssq, lane, 32);
                if (ok && fq == 0 && !DRY) SS[(size_t)tok * 16 + u.pn * 4 + wc] = ssq;
                asm volatile("" ::: "memory"); }
    }
};
}


namespace attn {
typedef short bf16x8 __attribute__((ext_vector_type(8)));
typedef short s16x4 __attribute__((ext_vector_type(4)));
typedef float f32x16 __attribute__((ext_vector_type(16)));
__device__ __forceinline__ unsigned cvtpk(float lo, float hi) { typedef float f2 __attribute__((ext_vector_type(2))); typedef __bf16 b2 __attribute__((ext_vector_type(2))); f2 v = {lo, hi}; b2 b = __builtin_convertvector(v, b2); return __builtin_bit_cast(unsigned, b); }
__device__ __forceinline__ s16x4 vtr(const LAS unsigned char* p) { return __builtin_bit_cast(s16x4, __builtin_amdgcn_ds_read_tr16_b64_v4i16((LAS s16x4*)p)); }
constexpr int N_ITEMS = NB * NH * 48, N_STEPS = N_ITEMS / 2;
__device__ __forceinline__ void attn_phase(const int tid, LAS unsigned char* lds, const bf16* PROJ, bf16* OB, float* LSE, int G, int bx) {
    const int lane = tid & 63, wid = __builtin_amdgcn_readfirstlane(tid >> 6), half = wid >> 2, w = wid & 3, tid4 = tid & 255;
    const int r32 = lane & 31, hi = lane >> 5;
    LAS unsigned char* Kt = lds + half * 65536;
    LAS unsigned char* Vt = Kt + 32768;
    for (int step = bx; step < N_STEPS; step += G) {
        const int it = step * 2 + half; const int bh = it / 48, rem = it % 48, br = rem >> 4, tile = rem & 15;
        const int b = bh >> 3, h = bh & 7;
        const int dil = br == 0 ? 1 : (br == 1 ? 4 : 16); const int rr = br == 0 ? 0 : (br == 1 ? (tile & 3) : tile); const int blk = br == 0 ? tile : (br == 1 ? (tile >> 2) : 0);
        const bool first = (blk == 0);
        const size_t tokbase = (size_t)b * SEQ;
#pragma unroll
        for (int j = 0; j < 8; ++j) { const int row = j * 32 + (tid4 >> 3), ch = tid4 & 7; const bool valid = !(first && row < 128);
            u32x4 kv = (u32x4){0u, 0u, 0u, 0u}, vv = (u32x4){0u, 0u, 0u, 0u};
            if (valid) { const int pos = dil * (128 * (blk - 1) + row) + rr; const bf16* src = PROJ + (tokbase + pos) * INW + AW + h * HD + ch * 8; kv = *(const u32x4*)src; vv = *(const u32x4*)(src + AW); }
            *(LAS u32x4*)(Kt + ch * 4096 + ((row ^ ch) * 16)) = kv;
            *(LAS u32x4*)(Vt + (ch >> 2) * 16384 + row * 64 + (ch & 3) * 16) = vv; }
        const int qrow = 32 * w + r32; const int qpos = dil * (128 * blk + qrow) + rr;
        const bf16* qp = PROJ + (tokbase + qpos) * INW + h * HD + hi * 8;
        bf16x8 qf[4];
#pragma unroll
        for (int d0 = 0; d0 < 4; ++d0) qf[d0] = *(const bf16x8*)(qp + d0 * 16);
        __syncthreads();
        const int kt_lo = first ? (4 - w) : 0;
        f32x16 p[5];
#pragma unroll
        for (int kt = 0; kt < 5; ++kt) { p[kt] = f32x16{};
            if (kt >= kt_lo) {
#pragma unroll
                for (int d0 = 0; d0 < 4; ++d0) { const int ch = 2 * d0 + hi; const int kpos = 32 * w + 32 * kt + r32;
                    const bf16x8 kf = *(const LAS bf16x8*)(Kt + ch * 4096 + ((kpos ^ ch) * 16));
                    p[kt] = __builtin_amdgcn_mfma_f32_32x32x16_bf16(kf, qf[d0], p[kt], 0, 0, 0); } } }
        const float SC = 0.125f * 1.4426950408889634f;
        float mx = -INFINITY;
#pragma unroll
        for (int kt = 0; kt < 5; ++kt) if (kt >= kt_lo) {
#pragma unroll
            for (int r = 0; r < 16; ++r) { const int c = (r & 3) + 8 * (r >> 2) + 4 * hi; bool ok = true; if (kt == 0) ok = (c >= r32); if (kt == 4) ok = (c <= r32);
                const float sv = ok ? p[kt][r] * SC : -INFINITY; p[kt][r] = sv; mx = fmaxf(mx, sv); } }
        mx = fmaxf(mx, lane_xor(mx, lane, 32));
        float lsum = 0.f;
#pragma unroll
        for (int kt = 0; kt < 5; ++kt) if (kt >= kt_lo) {
#pragma unroll
            for (int r = 0; r < 16; ++r) { const float e = __builtin_amdgcn_exp2f(p[kt][r] - mx); p[kt][r] = e; lsum += e; } }
        lsum += lane_xor(lsum, lane, 32);
        f32x16 o[2]; o[0] = f32x16{}; o[1] = f32x16{};
        const LAS unsigned char* vbase = Vt + (32 * w + 4 * hi + ((lane & 15) >> 2)) * 64 + ((lane >> 4) & 1) * 32 + (lane & 3) * 8;
#pragma unroll
        for (int kt = 0; kt < 5; ++kt) if (kt >= kt_lo) {
#pragma unroll
            for (int ks = 0; ks < 2; ++ks) {
                u32x4 pw; pw.x = cvtpk(p[kt][8 * ks + 0], p[kt][8 * ks + 1]); pw.y = cvtpk(p[kt][8 * ks + 2], p[kt][8 * ks + 3]); pw.z = cvtpk(p[kt][8 * ks + 4], p[kt][8 * ks + 5]); pw.w = cvtpk(p[kt][8 * ks + 6], p[kt][8 * ks + 7]);
                const bf16x8 pf = __builtin_bit_cast(bf16x8, pw);
#pragma unroll
                for (int dh = 0; dh < 2; ++dh) { const LAS unsigned char* va = vbase + dh * 16384 + (32 * kt + 16 * ks) * 64;
                    const s16x4 lo = vtr(va), hi8 = vtr(va + 512);
                    const bf16x8 vf = (bf16x8){lo[0], lo[1], lo[2], lo[3], hi8[0], hi8[1], hi8[2], hi8[3]};
                    o[dh] = __builtin_amdgcn_mfma_f32_32x32x16_bf16(vf, pf, o[dh], 0, 0, 0); } } }
        const float inv = 1.f / lsum; const size_t tok = tokbase + qpos;
        bf16* op = OB + ((size_t)br * NT + tok) * AW + h * HD + 4 * hi;
#pragma unroll
        for (int dh = 0; dh < 2; ++dh)
#pragma unroll
            for (int g4 = 0; g4 < 4; ++g4) *(u32x2*)(op + 32 * dh + 8 * g4) = (u32x2){cvtpk(o[dh][4 * g4] * inv, o[dh][4 * g4 + 1] * inv), cvtpk(o[dh][4 * g4 + 2] * inv, o[dh][4 * g4 + 3] * inv)};
        if (hi == 0) LSE[((size_t)br * NT + tok) * NH + h] = (mx + __builtin_amdgcn_logf(lsum)) * 0.6931471805599453f;
        __syncthreads();
    }
}
}

namespace ssm {
typedef short bf16x8 __attribute__((ext_vector_type(8)));
__device__ __forceinline__ void ssm_phase(const int tid, LAS unsigned char* lds, unsigned char* ws, unsigned char* pj, int l, int G, int bx) {
    typedef float f32x2 __attribute__((ext_vector_type(2)));
    const int lane = tid & 63, wid = __builtin_amdgcn_readfirstlane(tid >> 6), nt4 = wid & 3, ih = wid >> 2;
    const bf16* PROJ = (const bf16*)(pj); bf16* YG = (bf16*)(ws + WS_YG);
    LAS float* Ef = (LAS float*)lds;
    LAS f32x2* Tot = (LAS f32x2*)(lds + 32768);
    LAS unsigned char* Kl = lds + 36864;
    for (int it = bx; it < NG * NB; it += G) {
        const int g = it % NG, b = it / NG, lg = l * NG + g;
        const bf16* Bb2 = (const bf16*)(ws + WS_BB2) + (size_t)lg * 128 * 32; const bf16* Ccm = (const bf16*)(ws + WS_CC) + (size_t)lg * 16 * 128;
        const unsigned char* Ktg = ws + WS_KTAB + (size_t)lg * 33 * 512; const float* Lams = (const float*)(ws + WS_LAMS) + (size_t)lg * 64 * 6;
        const int c = 16 * nt4 + (lane & 15), jj = lane >> 5, h0 = 8 * ((lane >> 4) & 1), q4 = lane >> 4;
        for (int i = tid; i < 33 * 512 / 16; i += MKT) *(LAS u32x4*)(Kl + i * 16) = *(const u32x4*)(Ktg + i * 16);
        bf16x8 Uf[16];
        { const bf16* up = PROJ + ((size_t)b * SEQ + (size_t)c * CL + jj) * INW + 3 * AW + g * GC + h0;
#pragma unroll
          for (int ks = 0; ks < 16; ++ks) Uf[ks] = *(const bf16x8*)(up + (size_t)(2 * ks) * INW); }
        { bf16x8 Af[4]; f32x4 acc[4]; float l2r[4][2], l2i[4][2];
#pragma unroll
          for (int mi = 0; mi < 4; ++mi) { const int m = ih * 4 + mi; Af[mi] = *(const bf16x8*)(Bb2 + (size_t)(16 * m + (lane & 15)) * 32 + 8 * q4); acc[mi] = (f32x4){0.f, 0.f, 0.f, 0.f};
#pragma unroll
              for (int e = 0; e < 2; ++e) { const int p = 8 * m + 2 * q4 + e; l2r[mi][e] = Lams[p * 6 + 2]; l2i[mi][e] = Lams[p * 6 + 3]; } }
#pragma unroll
          for (int ks = 0; ks < 16; ++ks) {
#pragma unroll
              for (int mi = 0; mi < 4; ++mi) { f32x4 a = acc[mi];
                  if (ks > 0) a = (f32x4){l2r[mi][0] * a[0] - l2i[mi][0] * a[1], l2r[mi][0] * a[1] + l2i[mi][0] * a[0], l2r[mi][1] * a[2] - l2i[mi][1] * a[3], l2r[mi][1] * a[3] + l2i[mi][1] * a[2]};
                  acc[mi] = __builtin_amdgcn_mfma_f32_16x16x32_bf16(Af[mi], Uf[ks], a, 0, 0, 0); } }
#pragma unroll
          for (int mi = 0; mi < 4; ++mi) *(LAS f32x4*)(Ef + c * 128 + 16 * (ih * 4 + mi) + 4 * q4) = acc[mi]; }
        __syncthreads();
        { const int p = tid & 63, seg = tid >> 6; const float ar = Lams[p * 6 + 4], ai = Lams[p * 6 + 5];
          float lr[8], li[8]; float sr = 0.f, si = 0.f;
#pragma unroll
          for (int cc = 0; cc < 8; ++cc) { lr[cc] = sr; li[cc] = si; const f32x2 e = *(const LAS f32x2*)(Ef + (seg * 8 + cc) * 128 + 2 * p);
              const float nr = ar * sr - ai * si + e.x, ni = ar * si + ai * sr + e.y; sr = nr; si = ni; }
          Tot[seg * 64 + p] = (f32x2){sr, si};
          float a8r = ar, a8i = ai;
#pragma unroll
          for (int q = 0; q < 3; ++q) { const float tr = a8r * a8r - a8i * a8i, ti = 2.f * a8r * a8i; a8r = tr; a8i = ti; }
          __syncthreads();
          float cr = 0.f, ci = 0.f;
          for (int s2 = 0; s2 < seg; ++s2) { const f32x2 t = Tot[s2 * 64 + p]; const float nr = a8r * cr - a8i * ci + t.x, ni = a8r * ci + a8i * cr + t.y; cr = nr; ci = ni; }
          float pr = 1.f, pi = 0.f;
#pragma unroll
          for (int cc = 0; cc < 8; ++cc) { *(LAS f32x2*)(Ef + (seg * 8 + cc) * 128 + 2 * p) = (f32x2){lr[cc] + pr * cr - pi * ci, li[cc] + pr * ci + pi * cr};
              const float tr = pr * ar - pi * ai, ti = pr * ai + pi * ar; pr = tr; pi = ti; } }
        __syncthreads();
        { bf16x8 Cf[4]; float zr[4][4], zi[4][4], l2r[4][4], l2i[4][4];
#pragma unroll
          for (int k2 = 0; k2 < 4; ++k2) { Cf[k2] = *(const bf16x8*)(Ccm + (size_t)(lane & 15) * 128 + 32 * k2 + 8 * q4);
              const f32x4 s0 = *(const LAS f32x4*)(Ef + c * 128 + 32 * k2 + 8 * q4), s1 = *(const LAS f32x4*)(Ef + c * 128 + 32 * k2 + 8 * q4 + 4);
              const float sre[4] = {s0[0], s0[2], s1[0], s1[2]}, sim[4] = {s0[1], s0[3], s1[1], s1[3]};
#pragma unroll
              for (int e = 0; e < 4; ++e) { const int p = 16 * k2 + 4 * q4 + e; const float* lp = Lams + p * 6; l2r[k2][e] = lp[2]; l2i[k2][e] = lp[3];
                  const float fr_ = ih ? lp[2] : lp[0], fi_ = ih ? lp[3] : lp[1];
                  zr[k2][e] = fr_ * sre[e] - fi_ * sim[e]; zi[k2][e] = fr_ * sim[e] + fi_ * sre[e]; } }
          const LAS unsigned char* kbase = Kl + (lane & 15) * 32 + h0 * 2;
#pragma unroll 1
          for (int ii = 0; ii < 16; ++ii) { const int i = 2 * ii + ih; f32x4 acc = (f32x4){0.f, 0.f, 0.f, 0.f};
#pragma unroll
              for (int k2 = 0; k2 < 4; ++k2) { u32x4 zw; zw.x = attn::cvtpk(zr[k2][0], zi[k2][0]); zw.y = attn::cvtpk(zr[k2][1], zi[k2][1]); zw.z = attn::cvtpk(zr[k2][2], zi[k2][2]); zw.w = attn::cvtpk(zr[k2][3], zi[k2][3]);
                  acc = __builtin_amdgcn_mfma_f32_16x16x32_bf16(Cf[k2], __builtin_bit_cast(bf16x8, zw), acc, 0, 0, 0);
#pragma unroll
                  for (int e = 0; e < 4; ++e) { const float nr = l2r[k2][e] * zr[k2][e] - l2i[k2][e] * zi[k2][e], ni = l2r[k2][e] * zi[k2][e] + l2i[k2][e] * zr[k2][e]; zr[k2][e] = nr; zi[k2][e] = ni; } }
              const LAS unsigned char* kp = kbase + (i - jj + 1) * 512;
#pragma unroll
              for (int ks = 0; ks < 16; ++ks) if (2 * ks <= i) { const bf16x8 af = *(const LAS bf16x8*)(kp - ks * 1024); acc = __builtin_amdgcn_mfma_f32_16x16x32_bf16(af, Uf[ks], acc, 0, 0, 0); }
              const size_t tok = (size_t)b * SEQ + (size_t)c * CL + i;
              *(u32x2*)(YG + tok * SW + g * GC + 4 * q4) = (u32x2){pk2(gelu_tanh(acc[0]), gelu_tanh(acc[1])), pk2(gelu_tanh(acc[2]), gelu_tanh(acc[3]))}; } }
        __syncthreads();
    }
}
}

#define XB_TMO      128
#define XB_XCNT(j)  (256  + 64 * (j))
#define XB_XSUB(j)  (1280 + 64 * (j))
#define XB_XGEN(j)  (2304 + 64 * (j))
#define XB_TOP      3328
#define XB_TOPGEN   3392
#define XCD_BAR_WORDS 3456
#define XB_SPIN_CAP (1u << 18)
__device__ __forceinline__ unsigned xb_ld(unsigned* p)              { return __hip_atomic_load(p, __ATOMIC_RELAXED, __HIP_MEMORY_SCOPE_AGENT); }
__device__ __forceinline__ unsigned xb_add(unsigned* p, unsigned v) { return __hip_atomic_fetch_add(p, v, __ATOMIC_RELAXED, __HIP_MEMORY_SCOPE_AGENT); }
__device__ __forceinline__ unsigned xb_xcc_id() { return (unsigned)__builtin_amdgcn_s_getreg((3 << 11) | 20) & 0xFu; }
#define XB_SPIN(cond, bar) do { unsigned _sp = 0; while (cond) { __builtin_amdgcn_s_sleep(1); \
    if ((++_sp & 255u) == 0u) { if (xb_ld(&(bar)[XB_TMO])) break; if (_sp > XB_SPIN_CAP) { atomicAdd(&(bar)[XB_TMO], 1u); break; } } } } while (0)
struct XcdBarrier { unsigned* bar; unsigned x; volatile LAS unsigned* st; };
__device__ __forceinline__ XcdBarrier xcd_barrier_post(unsigned* bar, volatile LAS unsigned* st) {
    XcdBarrier b; b.bar = bar; b.x = xb_xcc_id(); b.st = st;
    if (threadIdx.x == 0) (void)xb_add(&bar[XB_XCNT(b.x)], 1u);
    return b;
}
__device__ __forceinline__ void xcd_barrier_complete(unsigned* bar, unsigned x, unsigned& nloc, unsigned& nx) {
    const unsigned G = gridDim.x * gridDim.y * gridDim.z;
    unsigned sum, cnt, mine, sp = 0u;
    for (;;) {
        sum = 0u; cnt = 0u; mine = 0u;
#pragma unroll
        for (unsigned j = 0; j < 16; ++j) { const unsigned c = xb_ld(&bar[XB_XCNT(j)]); sum += c; cnt += (c > 0u) ? 1u : 0u; mine = (j == x) ? c : mine; }
        if (sum == G) break;
        __builtin_amdgcn_s_sleep(1);
        if ((++sp & 255u) == 0u) { if (xb_ld(&bar[XB_TMO])) break; if (sp > XB_SPIN_CAP) { atomicAdd(&bar[XB_TMO], 1u); break; } }
    }
    nloc = mine > 0u ? mine : 1u; nx = cnt > 0u ? cnt : 1u;
}
__device__ __forceinline__ void xcd_barrier(const XcdBarrier& b) {
    asm volatile("s_waitcnt vmcnt(0)" ::: "memory");
    __syncthreads();
    if (threadIdx.x == 0) {
        unsigned* bar = b.bar; unsigned bx_ = b.x;
        asm volatile("" : "+s"(bar), "+s"(bx_));
        __builtin_amdgcn_s_waitcnt(0);
        unsigned nloc = b.st[0], nx = b.st[1];
        if (nloc == 0u) { xcd_barrier_complete(bar, bx_, nloc, nx); b.st[0] = nloc; b.st[1] = nx; }
        const unsigned old = xb_add(&bar[XB_XSUB(bx_)], 1u);
        const unsigned gen = old / nloc;
        if (old + 1u == (gen + 1u) * nloc) {
            __builtin_amdgcn_fence(__ATOMIC_RELEASE, "agent");
            asm volatile("s_waitcnt vmcnt(0)" ::: "memory");
            const unsigned og = xb_add(&bar[XB_TOP], 1u);
            const unsigned tg = og / nx;
            if (og + 1u == (tg + 1u) * nx) xb_add(&bar[XB_TOPGEN], 1u);
            else XB_SPIN(xb_ld(&bar[XB_TOPGEN]) == tg, bar);
            __builtin_amdgcn_fence(__ATOMIC_ACQUIRE, "agent");
            xb_add(&bar[XB_XGEN(bx_)], 1u);
            asm volatile("s_waitcnt vmcnt(0)" ::: "memory");
        } else {
            XB_SPIN(xb_ld(&bar[XB_XGEN(bx_)]) == gen, bar);
            __builtin_amdgcn_fence(__ATOMIC_ACQUIRE, "agent");
            asm volatile("s_waitcnt vmcnt(0)" ::: "memory");
        }
    }
    __syncthreads();
}

__device__ __forceinline__ void norm_rows(const float* x, bf16* xn, float* outf, const float* g, int mode, int gw, int ngw, int lane) {
    for (int row = gw; row < NT; row += ngw) {
        const f32x4* xr = (const f32x4*)(x + (size_t)row * DM) + lane; f32x4 v[4]; float s = 0.f;
#pragma unroll
        for (int j = 0; j < 4; ++j) { v[j] = xr[64 * j]; s += v[j].x * v[j].x + v[j].y * v[j].y + v[j].z * v[j].z + v[j].w * v[j].w; }
        const float ssq = wave_sum(s, lane); const float rstd = 1.f / sqrtf(ssq * (1.f / DM) + RMS_EPS);
        if (mode == 0) { u32x2* o = (u32x2*)(xn + (size_t)row * DM) + lane;
#pragma unroll
            for (int j = 0; j < 4; ++j) o[64 * j] = (u32x2){pk2(v[j].x * rstd, v[j].y * rstd), pk2(v[j].z * rstd, v[j].w * rstd)};
        } else if (mode == 1) { u32x2* o = (u32x2*)(xn + (size_t)row * DM) + lane;
#pragma unroll
            for (int j = 0; j < 4; ++j) o[64 * j] = (u32x2){pk2(v[j].x, v[j].y), pk2(v[j].z, v[j].w)};
            if (lane < 16) outf[(size_t)row * 16 + lane] = lane == 0 ? ssq : 0.f;
        } else { f32x4* o = (f32x4*)(outf + (size_t)row * DM) + lane; const f32x4* gg = (const f32x4*)g + lane;
#pragma unroll
            for (int j = 0; j < 4; ++j) { const f32x4 gv = gg[64 * j]; o[64 * j] = (f32x4){v[j].x * rstd * gv.x, v[j].y * rstd * gv.y, v[j].z * rstd * gv.z, v[j].w * rstd * gv.w}; } }
    }
}

__device__ __forceinline__ void final_rows(const bf16* XB, float* out, const float* g, int gw, int ngw, int lane) {
    for (int row = gw; row < NT; row += ngw) { const u32x4* xr = (const u32x4*)(XB + (size_t)row * DM) + lane; float v[2][8]; float s = 0.f;
#pragma unroll
        for (int j = 0; j < 2; ++j) { unpack8(xr[64 * j], v[j]);
#pragma unroll
            for (int c = 0; c < 8; ++c) s += v[j][c] * v[j][c]; }
        const float rstd = 1.f / sqrtf(wave_sum(s, lane) * (1.f / DM) + RMS_EPS);
#pragma unroll
        for (int j = 0; j < 2; ++j) { const f32x4* gp = (const f32x4*)(g + 512 * j + 8 * lane); const f32x4 g0 = gp[0], g1 = gp[1]; f32x4* op = (f32x4*)(out + (size_t)row * DM + 512 * j + 8 * lane);
            op[0] = (f32x4){v[j][0] * rstd * g0[0], v[j][1] * rstd * g0[1], v[j][2] * rstd * g0[2], v[j][3] * rstd * g0[3]};
            op[1] = (f32x4){v[j][4] * rstd * g1[0], v[j][5] * rstd * g1[1], v[j][6] * rstd * g1[2], v[j][7] * rstd * g1[3]}; } }
}

#ifndef TL_MASK
#define TL_MASK 0ull
#endif
#define TL_K 4ull
#ifndef REP_ATTN
#define REP_ATTN 1
#endif
#ifndef REP_P0
#define REP_P0 1
#endif
#ifndef REP_NORM
#define REP_NORM 1
#endif
#ifndef REP_INPROJ
#define REP_INPROJ 1
#endif
#ifndef REP_GLU
#define REP_GLU 1
#endif
#ifndef REP_MIX
#define REP_MIX 1
#endif
#ifndef REP_OUT
#define REP_OUT 1
#endif
#ifndef REP_ROUTE
#define REP_ROUTE 1
#endif
#ifndef REP_MOEUP
#define REP_MOEUP 1
#endif
#ifndef REP_MOEDN
#define REP_MOEDN 1
#endif

#ifndef REP_SSM
#define REP_SSM 1
#endif
constexpr int MK_THREADS = 512, MK_LDS = 147456;
constexpr int CW_BAR = 4096;
constexpr int LDS_CTL_OFF = 131072, LDS_MISC_OFF = LDS_CTL_OFF + 512;
enum { ST_P0 = 0, ST_NORM = 1, ST_INPROJ = 2, ST_MIXERS = 3, ST_GLU = 4, ST_MIX = 5, ST_OUT = 6, ST_ROUTE = 7, ST_MOEUP = 8, ST_MOEDN = 9, ST_FINAL = 10 };
constexpr int PROG_LEN = 2 + 9 * NL;
__host__ __device__ __forceinline__ void prog_decode(int pi, int& step, int& layer) {
    if (pi == 0) { step = ST_P0; layer = 0; return; }
    if (pi == PROG_LEN - 1) { step = ST_FINAL; layer = NL - 1; return; }
    int q = pi - 1;
    if (q < 8) { layer = 0; step = ST_INPROJ + q; return; }
    q -= 8; layer = 1 + q / 9; step = ST_NORM + q % 9;
}
struct MkArgs { Ptrs P; int s_lo, s_hi, flags, pad1; };
#if defined(__HIP_DEVICE_COMPILE__)
#define CAS __attribute__((address_space(4)))
#else
#define CAS
#endif
__global__ void __launch_bounds__(MK_THREADS, 2) mk(MkArgs args) {
    extern __shared__ __attribute__((aligned(16))) unsigned char lds_raw[];
    LAS unsigned char* const lds0 = (LAS unsigned char*)lds_raw;
    const CAS MkArgs* ap = (const CAS MkArgs*)__builtin_amdgcn_kernarg_segment_ptr();
    const int G0 = gridDim.x; const int bx0 = blockIdx.x;
    const int tid0 = threadIdx.x;
    for (int u = tid0; u < (MK_LDS - LDS_CTL_OFF) / 4; u += MK_THREADS) ((LAS unsigned*)(lds0 + LDS_CTL_OFF))[u] = 0u;
    __syncthreads();
    const int lo = args.s_lo, hi = args.s_hi;
#if TL_MASK
    unsigned long long tl_prev = __builtin_amdgcn_s_memrealtime(), tl_sum = 0;
#endif
    XcdBarrier bar; bar.bar = (unsigned*)(args.P.ws + WS_CTL) + CW_BAR; bar.x = 0; bar.st = nullptr;
    if (hi - lo > 1) bar = xcd_barrier_post(bar.bar, (volatile LAS unsigned*)(lds0 + LDS_MISC_OFF));
#define STEP_BEGIN(k) if (lo <= (k) && (k) < hi) { int G = G0, bx = bx0, tid = tid0; unsigned ldsv = (unsigned)(uintptr_t)lds0; asm volatile("" : "+s"(ap), "+s"(G), "+s"(bx), "+v"(tid), "+s"(ldsv)); \
    LAS unsigned char* const lds = (LAS unsigned char*)(uintptr_t)ldsv; const int lane = tid & 63, wave = __builtin_amdgcn_readfirstlane(tid >> 6); (void)lane; const int gw = bx * 8 + wave, ngw = G * 8; (void)gw; (void)ngw; const Ptrs P = ap->P; unsigned char* const ws = P.ws; unsigned char* const pj = (unsigned char*)P.out; (void)pj; unsigned* const ctl = (unsigned*)(ws + WS_CTL); (void)ctl;
#define STEP_OFF(k) if (0) { const int G = 1, bx = 0, gw = 0, ngw = 1, tid = 0, lane = 0, wave = 0; LAS unsigned char* const lds = lds0; (void)lane; (void)wave; const Ptrs P{}; unsigned char* const ws = nullptr; unsigned char* const pj = nullptr; unsigned* const ctl = nullptr; (void)ctl;
#if TL_MASK
#define TL_MARK(k) { const unsigned long long tn_ = __builtin_amdgcn_s_memrealtime(); if ((TL_MASK >> (k)) & 1ull) tl_sum += tn_ - tl_prev; tl_prev = tn_; }
#else
#define TL_MARK(k)
#endif
#define STEP_END(k) if ((k) + 1 < hi) xcd_barrier(bar); TL_MARK(k) }
    STEP_BEGIN(0)
      for (int rep = 0; rep < REP_P0; ++rep) {
        for (int ti = bx; ti < 2 * NL * NG; ti += G) p0_tables_item(P, ti >> 1, ti & 1, (LAS float*)lds, tid, MK_THREADS);
        __syncthreads();
        p0_transposes(P, (LAS float*)lds + wave * 64 * 33, gw, ngw, lane);
        norm_rows(P.x, (bf16*)(ws + WS_XB), (float*)(ws + WS_SS1), nullptr, 1, gw, ngw, lane);
        __syncthreads(); }
    STEP_END(0)
#pragma unroll 1
    for (int l = 0; l < NL; ++l) {
        const int kb = 1 + 9 * l;
        STEP_BEGIN(kb + 1)
            pg8::DenseSched S{(const char*)(ws + WS_XB), (const char*)(ws + WS_WIN) + (size_t)l * INW * DM * 2, NT / 256, INW / 256, G, bx, (size_t)256 * DM * 2, (size_t)256 * DM * 2};
            pg8::EpiStoreBf16 E{(bf16*)(pj), INW, (const float*)(ws + WS_SS1)};
            for (int rep = 0; rep < REP_INPROJ; ++rep) pg8::gemm_phase<pg8::EpiStoreBf16, pg8::DenseSched, false, true>(tid, lds, DM, DM, DM, S, E);
        STEP_END(kb + 1)
        STEP_BEGIN(kb + 2)
            for (int rep = 0; rep < REP_ATTN; ++rep) attn::attn_phase(tid, lds, (const bf16*)(pj), (bf16*)(ws + WS_OB), (float*)(ws + WS_LSE), G, bx);
            for (int rep = 0; rep < REP_SSM; ++rep) ssm::ssm_phase(tid, lds, ws, pj, l, G, bx);
        STEP_END(kb + 2)
        STEP_BEGIN(kb + 3)
            pg8::DenseSched S{(const char*)(ws + WS_YG), (const char*)(ws + WS_WGLU) + (size_t)l * SW * SW * 2, NT / 256, SW / 256, G, bx, (size_t)256 * SW * 2, (size_t)256 * SW * 2};
            pg8::EpiGlu E{(bf16*)(pj), (const bf16*)(ws + WS_YG), SW};
            for (int rep = 0; rep < REP_GLU; ++rep) pg8::gemm_phase<pg8::EpiGlu, pg8::DenseSched, false, true>(tid, lds, SW, SW, SW, S, E);
        STEP_END(kb + 3)
        STEP_BEGIN(kb + 4)
            for (int rep = 0; rep < REP_MIX; ++rep) for (int row = gw; row < NT; row += ngw) mix_row(row, lane, (const bf16*)(ws + WS_OB), (const float*)(ws + WS_LSE), (const bf16*)(pj), (bf16*)(ws + WS_AB));
        STEP_END(kb + 4)
        STEP_BEGIN(kb + 5)
            pg8::DenseSched S{(const char*)(ws + WS_AB), (const char*)(ws + WS_WOUT) + (size_t)l * DM * DM * 2, NT / 256, DM / 256, G, bx, (size_t)256 * DM * 2, (size_t)256 * DM * 2};
            pg8::EpiResid E{(bf16*)(ws + WS_XB), DM};
            pg8::gemm_phase<pg8::EpiResid, pg8::DenseSched, false, true>(tid, lds, DM, DM, DM, S, E);
        STEP_END(kb + 5)
        STEP_BEGIN(kb + 6)
            LAS f32x4* GW = (LAS f32x4*)lds; LAS int* lcnt = (LAS int*)(lds + 98304); LAS int* lbase = lcnt + 32; LAS int* lpart = lcnt + 64;
            if (tid < 32) lcnt[tid] = 0;
            route_build_lds(P, l, GW, tid);
            int* cnt2 = (int*)(ws + WS_CNT2) + (size_t)l * 1024 * 32;
            {
#pragma unroll 1
              for (int r0 = gw; r0 < NT; r0 += 2 * ngw) { route_rows<2>(P, l, r0, ngw, lane, GW, (const bf16*)(ws + WS_XB), (unsigned*)(ws + WS_TROUTE), (f32x4*)(ws + WS_TW), lcnt); }
              __syncthreads();
              if (tid < 32) cnt2[bx * 32 + tid] = lcnt[tid];
              xcd_barrier(bar);
              { const int c = tid >> 4, part = tid & 15; int sum = 0, tot = 0;
                for (int b2 = part; b2 < G; b2 += 16) { const int v = __hip_atomic_load(cnt2 + b2 * 32 + c, __ATOMIC_RELAXED, __HIP_MEMORY_SCOPE_AGENT); tot += v; if (b2 < bx) sum += v; }
                lpart[tid] = sum; lpart[512 + tid] = tot; }
              __syncthreads();
              if (tid < 32) { int sum = 0, tot = 0; for (int q = 0; q < 16; ++q) { sum += lpart[tid * 16 + q]; tot += lpart[512 + tid * 16 + q]; } lbase[tid] = sum; if (bx == 0 && tid < NCLS) ctl[CW_CNT + l * 32 + tid] = (unsigned)tot; }
              __syncthreads();
              if (lane == 0) { int* ltok = (int*)(ws + WS_LTOK); f32x4* lw = (f32x4*)(ws + WS_LW); const unsigned* troute = (const unsigned*)(ws + WS_TROUTE); const f32x4* tw = (const f32x4*)(ws + WS_TW);
#pragma unroll 1
                for (int row = gw; row < NT; row += ngw) { const unsigned rt = troute[row]; const int cls = (int)((rt >> 16) & 255u), slot = lbase[cls] + (int)(rt >> 24);
                    ltok[(size_t)cls * NT + slot] = row; lw[(size_t)cls * NT + slot] = tw[row]; } } }
        STEP_END(kb + 6)
        STEP_BEGIN(kb + 7)
            LAS int* tpre = (LAS int*)(lds + LDS_CTL_OFF); pg8::moe_build_prefix(tid, tpre, ctl + CW_CNT + l * 32);
            pg8::MoeSched S{tpre, (const int*)(ws + WS_LTOK), (const char*)(ws + WS_XB), (const char*)(ws + WS_WGU), G, bx, l, 1};
            pg8::EpiMoeUp E{(bf16*)(pj), (const f32x4*)(ws + WS_LW)};
            for (int rep = 0; rep < REP_MOEUP; ++rep) pg8::gemm_phase<pg8::EpiMoeUp, pg8::MoeSched, true, true>(tid, lds, DM, DM, DM, S, E);
        STEP_END(kb + 7)
        STEP_BEGIN(kb + 8)
            LAS int* tpre = (LAS int*)(lds + LDS_CTL_OFF); pg8::moe_build_prefix(tid, tpre, ctl + CW_CNT + l * 32);
            pg8::MoeSched S{tpre, (const int*)(ws + WS_LTOK), (const char*)(pj), (const char*)(ws + WS_WD), G, bx, l, 0};
            pg8::EpiMoeDown<false> E{(bf16*)(ws + WS_XB), (const int*)(ws + WS_LTOK), (float*)(ws + WS_SS1)};
            pg8::gemm_phase<pg8::EpiMoeDown<false>, pg8::MoeSched, false, true>(tid, lds, 512, EFF, EFF, S, E);
            for (int rep = 1; rep < REP_MOEDN; ++rep) { pg8::EpiMoeDown<true> E2{(bf16*)(ws + WS_XB), (const int*)(ws + WS_LTOK), (float*)(ws + WS_SS1)}; pg8::gemm_phase<pg8::EpiMoeDown<true>, pg8::MoeSched, false, true>(tid, lds, 512, EFF, EFF, S, E2); }
        STEP_END(kb + 8)
    }
    STEP_BEGIN(1 + 9 * NL)
        final_rows((const bf16*)(ws + WS_XB), P.out, P.final_g, gw, ngw, lane);
    STEP_END(1 + 9 * NL)
#if TL_MASK
    if (bx0 == 0) { const unsigned long long t0_ = __builtin_amdgcn_s_memrealtime(); while (__builtin_amdgcn_s_memrealtime() - t0_ < TL_K * tl_sum) __builtin_amdgcn_s_sleep(8); }
#endif
#undef STEP_BEGIN
#undef STEP_OFF
#undef STEP_END
}

#ifndef MK_SPLIT
#define MK_SPLIT 0
#endif
extern "C" void kernel_launch(void* const* d_in, const int* in_sizes, int n_in, void* d_out, int out_size, void* d_ws, size_t ws_size, hipStream_t stream) {
    if (n_in != 24 || out_size != NT * DM || ws_size < WS_END) { fprintf(stderr, "kernel_launch: unexpected shapes n_in %d out %d ws %zu (need %zu)\n", n_in, out_size, ws_size, (size_t)WS_END); return; }
    static int grid = 0;
    if (grid == 0) {
        int dev = 0, cus = 0, per_cu = 0;
        if (hipFuncSetAttribute((const void*)mk, hipFuncAttributeMaxDynamicSharedMemorySize, MK_LDS) != hipSuccess) { fprintf(stderr, "kernel_launch: hipFuncSetAttribute failed\n"); grid = -1; return; }
        if (hipGetDevice(&dev) != hipSuccess || hipDeviceGetAttribute(&cus, hipDeviceAttributeMultiprocessorCount, dev) != hipSuccess) { fprintf(stderr, "kernel_launch: device query failed\n"); grid = -1; return; }
        if (hipOccupancyMaxActiveBlocksPerMultiprocessor(&per_cu, (const void*)mk, MK_THREADS, MK_LDS) != hipSuccess || per_cu < 1) { fprintf(stderr, "kernel_launch: occupancy query failed (%d)\n", per_cu); grid = -1; return; }
        grid = cus * per_cu;
        fprintf(stderr, "kernel_launch: %d CUs x %d blocks/CU -> grid %d\n", cus, per_cu, grid);
    }
    if (grid < 0) return;
    Ptrs P{};
    const float** pf = (const float**)&P;
    for (int i = 0; i < 24; ++i) pf[i] = (const float*)d_in[i];
    P.out = (float*)d_out; P.ws = (unsigned char*)d_ws;
    (void)hipMemsetAsync(P.ws + WS_CTL, 0, 65536, stream);
    MkArgs a{}; a.P = P;
#if MK_SPLIT
    for (int pi = 0; pi < PROG_LEN; ++pi) { a.s_lo = pi; a.s_hi = pi + 1; hipLaunchKernelGGL(mk, dim3(grid), dim3(MK_THREADS), MK_LDS, stream, a); }
#else
    a.s_lo = 0; a.s_hi = PROG_LEN;
    void* kargs[] = {&a};
    const hipError_t e = hipLaunchCooperativeKernel((const void*)mk, dim3(grid), dim3(MK_THREADS), kargs, MK_LDS, stream);
    if (e != hipSuccess) fprintf(stderr, "kernel_launch: cooperative launch failed: %s (grid %d)\n", hipGetErrorString(e), grid);
#endif
}
```

```cpp
#include <hip/hip_runtime.h>
#include <cstdio>
#include <cstdint>

typedef unsigned short bf16;
typedef float f32x4 __attribute__((ext_vector_type(4)));
typedef unsigned u32x4 __attribute__((ext_vector_type(4)));
typedef unsigned u32x2 __attribute__((ext_vector_type(2)));
#define LAS __attribute__((address_space(3)))

constexpr int NB = 8, SEQ = 2048, DM = 1024, NL = 4, NT = NB * SEQ;
constexpr int AW = 512, HD = 64, NH = 8, SW = 512, GC = 16, NG = 32, NP = 64, INW = 2048;
constexpr int NE = 16, EFF = 256, NCLS = 24;
constexpr float RMS_EPS = 1e-6f;
constexpr int CL = 32;
constexpr int NCH = SEQ / CL;
constexpr int MKT = 512;

constexpr size_t al256(size_t x) { return (x + 255) & ~(size_t)255; }
constexpr size_t WS_CTL = 0, CTL_BYTES = 1u << 20;
constexpr size_t WS_WIN  = WS_CTL + CTL_BYTES;
constexpr size_t WS_WGLU = WS_WIN  + (size_t)NL * INW * DM * 2;
constexpr size_t WS_WOUT = WS_WGLU + (size_t)NL * SW * SW * 2;
constexpr size_t WS_WGU  = WS_WOUT + (size_t)NL * DM * DM * 2;
constexpr size_t WS_WD   = WS_WGU  + (size_t)NL * NE * 512 * DM * 2;
constexpr size_t WS_KTAB = WS_WD   + (size_t)NL * NE * DM * EFF * 2;
constexpr size_t WS_BB2  = WS_KTAB + al256((size_t)NL * NG * 33 * 256 * 2);
constexpr size_t WS_CC   = WS_BB2  + (size_t)NL * NG * 128 * 32 * 2;
constexpr size_t WS_LAMS = WS_CC   + (size_t)NL * NG * 16 * 128 * 2;
constexpr size_t WS_AB   = WS_LAMS + (size_t)NL * NG * 64 * 6 * 4;
constexpr size_t WS_UGM  = WS_AB + (size_t)NT * SW * 2;
constexpr size_t WS_OB   = WS_AB + (size_t)NT * DM * 2;
constexpr size_t WS_TROUTE = WS_OB + (size_t)3 * NT * AW * 2;
constexpr size_t WS_TW   = WS_TROUTE + (size_t)NT * 4;
constexpr size_t WS_LTOK = WS_TW + (size_t)NT * 16;
constexpr size_t WS_LW   = WS_LTOK + (size_t)NCLS * NT * 4;
constexpr size_t WS_LSE  = WS_LW + (size_t)NCLS * NT * 16;
constexpr size_t WS_SS1  = WS_LSE + (size_t)3 * NT * NH * 4;
constexpr size_t WS_CNT2 = WS_SS1 + (size_t)NT * 16 * 4;
constexpr size_t WS_XB   = WS_CNT2 + (size_t)NL * 1024 * 32 * 4;
constexpr size_t WS_RS2  = WS_XB + (size_t)NT * DM * 2;
constexpr size_t WS_SSG  = WS_RS2 + (size_t)NT * 4;
constexpr size_t WS_YG   = WS_SSG + (size_t)NT * 8 * 4;
constexpr size_t WS_END  = WS_YG + (size_t)NT * SW * 2;
static_assert(WS_END <= 325000000, "workspace map exceeds the guaranteed size");
constexpr int CW_CNT = 1024;
constexpr int CW_UCNT = 2048;

__device__ __forceinline__ unsigned f2bf(float f) { unsigned u = __builtin_bit_cast(unsigned, f); return (u + 0x7fffu + ((u >> 16) & 1u)) >> 16; }
__device__ __forceinline__ float bf2f(unsigned h) { return __builtin_bit_cast(float, h << 16); }
__device__ __forceinline__ unsigned pk2(float lo, float hi) { return f2bf(lo) | (f2bf(hi) << 16); }
__device__ __forceinline__ float lane_xor(float v, int lane, int o) { return __builtin_bit_cast(float, __builtin_amdgcn_ds_bpermute((lane ^ o) << 2, __builtin_bit_cast(int, v))); }
#define DPP_ADD(x, ctrl, rmask) ((x) + __builtin_bit_cast(float, __builtin_amdgcn_update_dpp(0, __builtin_bit_cast(int, (x)), (ctrl), (rmask), 0xf, true)))
__device__ __forceinline__ float wave_sum(float v, int) {
    v = DPP_ADD(v, 0x111, 0xf); v = DPP_ADD(v, 0x112, 0xf); v = DPP_ADD(v, 0x114, 0xf); v = DPP_ADD(v, 0x118, 0xf);
    v = DPP_ADD(v, 0x142, 0xa); v = DPP_ADD(v, 0x143, 0xc);
    return __builtin_bit_cast(float, __builtin_amdgcn_readlane(__builtin_bit_cast(int, v), 63));
}
__device__ __forceinline__ void store16_wt(void* p, u32x4 v) { asm volatile("global_store_dwordx4 %0, %1, off sc1\n\ts_nop 1" :: "v"(p), "v"(v) : "memory"); }
__device__ __forceinline__ void store16f_wt(void* p, f32x4 v) { asm volatile("global_store_dwordx4 %0, %1, off sc1\n\ts_nop 1" :: "v"(p), "v"(v) : "memory"); }
__device__ __forceinline__ float gelu_tanh(float y) {
    const float u = 0.7978845608028654f * (y + 0.044715f * y * y * y);
    const float e = __expf(2.f * u);
    const float th = 1.f - 2.f / (e + 1.f);
    return 0.5f * y * (1.f + th);
}
__device__ __forceinline__ float sigmoidf_(float z) { return 1.f / (1.f + __expf(-z)); }

struct Ptrs {
    const float *x, *ln1_g, *w_in, *lam_re, *lam_im, *log_dt, *b_re, *b_im, *c_re, *c_im, *d_skip, *w_glu, *gn_attn, *gn_ssm, *w_out, *ln2_g,
        *w_rg, *b_rg, *w_re, *b_re_, *w_gate, *w_up, *w_down, *final_g;
    float* out; unsigned char* ws;
};

__device__ __forceinline__ void unpack8(const u32x4 q, float (&o)[8]) { o[0] = bf2f(q.x & 0xffffu); o[1] = bf2f(q.x >> 16); o[2] = bf2f(q.y & 0xffffu); o[3] = bf2f(q.y >> 16); o[4] = bf2f(q.z & 0xffffu); o[5] = bf2f(q.z >> 16); o[6] = bf2f(q.w & 0xffffu); o[7] = bf2f(q.w >> 16); }
__device__ __forceinline__ void p0_transpose_item(const float* W, int N, const float* gain, bf16* WT, int K, LAS float* scr, int kb, int nb, int dst_row0, int lane) {
    const int k0 = 64 * kb, n0 = 32 * nb;
    const float* wp = W + (size_t)(k0 + (lane >> 5)) * N + n0 + (lane & 31);
    float v[32];
#pragma unroll
    for (int i = 0; i < 32; ++i) v[i] = wp[(size_t)(2 * i) * N];
    const int c = lane & 7;
    f32x4 g0 = (f32x4){1.f, 1.f, 1.f, 1.f}, g1 = g0;
    if (gain) { g0 = *(const f32x4*)(gain + k0 + 8 * c); g1 = *(const f32x4*)(gain + k0 + 8 * c + 4); }
#pragma unroll
    for (int i = 0; i < 32; ++i) scr[(2 * i + (lane >> 5)) * 33 + (lane & 31)] = v[i];
    asm volatile("s_waitcnt lgkmcnt(0)" ::: "memory");
#pragma unroll
    for (int j = 0; j < 4; ++j) { const int n = (lane >> 3) + 8 * j; const LAS float* s = scr + (8 * c) * 33 + n;
        u32x4 o; o.x = pk2(s[0 * 33] * g0[0], s[1 * 33] * g0[1]); o.y = pk2(s[2 * 33] * g0[2], s[3 * 33] * g0[3]); o.z = pk2(s[4 * 33] * g1[0], s[5 * 33] * g1[1]); o.w = pk2(s[6 * 33] * g1[2], s[7 * 33] * g1[3]);
        *(u32x4*)(WT + (size_t)(dst_row0 + n) * K + k0 + 8 * c) = o; }
    asm volatile("s_waitcnt lgkmcnt(0)" ::: "memory");
}
constexpr int IT_WIN = (DM / 64) * (INW / 32);
constexpr int IT_WGLU = (SW / 64) * (SW / 32);
constexpr int IT_WOUT = (DM / 64) * (DM / 32);
constexpr int IT_WG = (DM / 64) * (EFF / 32);
constexpr int IT_WDN = (EFF / 64) * (DM / 32);
constexpr int IT_PER_LAYER = IT_WIN + IT_WGLU + IT_WOUT + NE * (2 * IT_WG + IT_WDN);
constexpr int IT_TOTAL = NL * IT_PER_LAYER;
__device__ __forceinline__ void p0_transposes(const Ptrs& P, LAS float* scr, int gw, int ngw, int lane) {
    unsigned char* ws = P.ws;
#pragma unroll 1
    for (int it = gw; it < IT_TOTAL; it += ngw) {
        const int l = it / IT_PER_LAYER; int r = it % IT_PER_LAYER;
        if (r < IT_WIN) { const int nblk = INW / 32; p0_transpose_item(P.w_in + (size_t)l * DM * INW, INW, P.ln1_g + l * DM, (bf16*)(ws + WS_WIN) + (size_t)l * INW * DM, DM, scr, r / nblk, r % nblk, 32 * (r % nblk), lane); continue; }
        r -= IT_WIN;
        if (r < IT_WGLU) { const int nblk = SW / 32; p0_transpose_item(P.w_glu + (size_t)l * SW * SW, SW, nullptr, (bf16*)(ws + WS_WGLU) + (size_t)l * SW * SW, SW, scr, r / nblk, r % nblk, 32 * (r % nblk), lane); continue; }
        r -= IT_WGLU;
        if (r < IT_WOUT) { const int nblk = DM / 32; const int kb = r / nblk; const float* g = (kb < 8) ? (P.gn_attn + l * AW) : (P.gn_ssm + l * SW - AW);
            p0_transpose_item(P.w_out + (size_t)l * DM * DM, DM, g, (bf16*)(ws + WS_WOUT) + (size_t)l * DM * DM, DM, scr, kb, r % nblk, 32 * (r % nblk), lane); continue; }
        r -= IT_WOUT;
        const int e = r / (2 * IT_WG + IT_WDN); r %= (2 * IT_WG + IT_WDN);
        if (r < 2 * IT_WG) { const int up = r / IT_WG; r %= IT_WG; const int nblk = EFF / 32; const int kb = r / nblk, nb = r % nblk; const int f0 = 32 * nb;
            const float* src = (up ? P.w_up : P.w_gate) + ((size_t)l * NE + e) * DM * EFF;
            bf16* dst = (bf16*)(ws + WS_WGU) + ((size_t)l * NE + e) * 512 * DM;
            p0_transpose_item(src, EFF, P.ln2_g + l * DM, dst, DM, scr, kb, nb, (f0 / 128) * 256 + up * 128 + (f0 % 128), lane); continue; }
        r -= 2 * IT_WG;
        { const int nblk = DM / 32; p0_transpose_item(P.w_down + ((size_t)l * NE + e) * EFF * DM, DM, nullptr, (bf16*)(ws + WS_WD) + ((size_t)l * NE + e) * DM * EFF, EFF, scr, r / nblk, r % nblk, 32 * (r % nblk), lane); }
    }
}

__device__ __forceinline__ void p0_tables_item(const Ptrs& P, int lg, int half, LAS float* scr, int tid, int nthr) {
    typedef float f32x2 __attribute__((ext_vector_type(2)));
    LAS f32x2* pw = (LAS f32x2*)scr; LAS f32x2* Bb = pw + 33 * 64; LAS f32x2* Cc = Bb + 64 * 16;
    const int l = lg / NG, g = lg % NG;
    const float dt = expf(P.log_dt[lg]);
    const float* lre = P.lam_re + (size_t)lg * NP; const float* lim = P.lam_im + (size_t)lg * NP;
#pragma unroll 1
    for (int i = tid; i < 33 * 64; i += nthr) { const int tau = i / 64, p = i % 64;
        const float a = lre[p] * dt * (float)tau; const float turns = lim[p] * dt * 0.15915494309189535f;
        const float xh = (float)tau * turns, xl = fmaf((float)tau, turns, -xh); const float fr = (xh - rintf(xh)) + xl;
        float sn, cs; sincosf(6.283185307179586f * fr, &sn, &cs); const float mg = expf(a);
        pw[i] = (f32x2){mg * cs, mg * sn}; }
#pragma unroll 1
    for (int i = tid; i < 64 * 16; i += nthr) { const int p = i / 16, h = i % 16;
        const float a = lre[p] * dt, th = lim[p] * dt; float sn, cs; sincosf(th, &sn, &cs); float sh, ch; sincosf(0.5f * th, &sh, &ch); (void)ch;
        const float em1 = expm1f(a), ea = em1 + 1.f;
        const float nr = em1 * cs - 2.f * sh * sh, ni = ea * sn;
        const float c = lre[p], d = lim[p], den = 1.f / (c * c + d * d);
        const float qr = (nr * c + ni * d) * den, qi = (ni * c - nr * d) * den;
        const float br = P.b_re[((size_t)lg * NP + p) * GC + h], bi = P.b_im[((size_t)lg * NP + p) * GC + h];
        Bb[i] = (f32x2){qr * br - qi * bi, qr * bi + qi * br}; }
#pragma unroll 1
    for (int i = tid; i < 16 * 64; i += nthr) { const int h = i / 64, p = i % 64;
        Cc[i] = (f32x2){P.c_re[((size_t)lg * GC + h) * NP + p], P.c_im[((size_t)lg * GC + h) * NP + p]}; }
    __syncthreads();
    unsigned char* ws = P.ws;
    bf16* Bb2 = (bf16*)(ws + WS_BB2) + (size_t)lg * 128 * 32;
    bf16* Ccm = (bf16*)(ws + WS_CC) + (size_t)lg * 16 * 128;
    bf16* Kt = (bf16*)(ws + WS_KTAB) + (size_t)lg * 33 * 256;
    float* Lams = (float*)(ws + WS_LAMS) + (size_t)lg * 64 * 6;
    if (half == 0)
#pragma unroll 1
    for (int i = tid; i < 128 * 32; i += nthr) { const int row = i >> 5, col = i & 31; const int p = row >> 1, cc = row & 1, h = col & 15; f32x2 b = Bb[p * 16 + h];
        if (col < 16) { const f32x2 w = pw[64 + p]; b = (f32x2){w.x * b.x - w.y * b.y, w.x * b.y + w.y * b.x}; }
        Bb2[i] = (bf16)f2bf(cc ? b.y : b.x); }
    if (half == 1)
#pragma unroll 1
    for (int i = tid; i < 16 * 128; i += nthr) { const int h = i >> 7, st = i & 127; const f32x2 c = Cc[h * 64 + (st >> 1)]; Ccm[i] = (bf16)f2bf((st & 1) ? -c.y : c.x); }
#pragma unroll 1
    for (int i = (half ? 17 * 256 : 0) + tid; i < (half ? 33 * 256 : 17 * 256); i += nthr) { const int t1 = i / 256, h = (i >> 4) & 15, hp = i & 15; float sacc = 0.f;
        if (t1 > 0) { const int tau = t1 - 1;
            for (int p = 0; p < 64; ++p) { const f32x2 c = Cc[h * 64 + p], w = pw[tau * 64 + p], b = Bb[p * 16 + hp]; const float cr = c.x * w.x - c.y * w.y, ci = c.x * w.y + c.y * w.x; sacc += cr * b.x - ci * b.y; }
            if (tau == 0 && h == hp) sacc += P.d_skip[(size_t)lg * GC + h]; }
        Kt[i] = (bf16)f2bf(sacc); }
    if (half == 1)
#pragma unroll 1
    for (int i = tid; i < 64; i += nthr) { const f32x2 w1 = pw[64 + i], w2 = pw[128 + i], w32 = pw[32 * 64 + i]; float* o = Lams + i * 6; o[0] = w1.x; o[1] = w1.y; o[2] = w2.x; o[3] = w2.y; o[4] = w32.x; o[5] = w32.y; }
    __syncthreads();
    (void)l; (void)g;
}

__device__ __forceinline__ void route_build_lds(const Ptrs& P, int l, LAS f32x4* GW, int tid) {
    for (int idx = tid; idx < 5 * DM; idx += MKT) { const int ep = idx >> 10, k = idx & 1023; const int j = k >> 9, c = k & 7, ln = (k & 511) >> 3;
        const float g = P.ln2_g[l * DM + k];
        const f32x4 w = ep == 0 ? *(const f32x4*)(P.w_rg + ((size_t)l * DM + k) * 4) : *(const f32x4*)(P.w_re + (((size_t)l * 4 + (ep - 1)) * DM + k) * 4);
        GW[((ep * 2 + j) * 8 + c) * 64 + ln] = w * g; }
    __syncthreads();
}
template <int NR> __device__ __forceinline__ void route_rows(const Ptrs& P, int l, const int r0, const int rstride, int lane, const LAS f32x4* GW, const bf16* XB, unsigned* troute, f32x4* tw, LAS int* lcnt) {
    float v[NR][2][8]; float rstd[NR];
#pragma unroll
    for (int q = 0; q < NR; ++q) { const u32x4* xr = (const u32x4*)(XB + (size_t)(r0 + q * rstride) * DM) + lane;
#pragma unroll
        for (int j = 0; j < 2; ++j) unpack8(xr[64 * j], v[q][j]); }
#pragma unroll
    for (int q = 0; q < NR; ++q) { float s = 0.f;
#pragma unroll
        for (int j = 0; j < 2; ++j)
#pragma unroll
            for (int c = 0; c < 8; ++c) s += v[q][j][c] * v[q][j][c];
        rstd[q] = 1.f / sqrtf(wave_sum(s, lane) * (1.f / DM) + RMS_EPS); }
    f32x4 acc[NR];
#pragma unroll
    for (int q = 0; q < NR; ++q) acc[q] = (f32x4){0.f, 0.f, 0.f, 0.f};
#pragma unroll
    for (int j = 0; j < 2; ++j)
#pragma unroll
        for (int c = 0; c < 8; ++c) { const f32x4 w = GW[(j * 8 + c) * 64 + lane];
#pragma unroll
            for (int q = 0; q < NR; ++q) acc[q] += v[q][j][c] * w; }
    int grp[NR]; float g1[NR];
#pragma unroll
    for (int q = 0; q < NR; ++q) { float gl[4];
#pragma unroll
        for (int e = 0; e < 4; ++e) gl[e] = wave_sum(acc[q][e], lane) * rstd[q] + P.b_rg[l * 4 + e];
        int gi = 0; float gm = gl[0];
#pragma unroll
        for (int e = 1; e < 4; ++e) if (gl[e] > gm) { gm = gl[e]; gi = e; }
        float gs = 0.f;
#pragma unroll
        for (int e = 0; e < 4; ++e) gs += expf(gl[e] - gm);
        grp[q] = gi; g1[q] = 1.f / gs; acc[q] = (f32x4){0.f, 0.f, 0.f, 0.f}; }
#pragma unroll
    for (int j = 0; j < 2; ++j)
#pragma unroll
        for (int c = 0; c < 8; ++c)
#pragma unroll
            for (int q = 0; q < NR; ++q) acc[q] += v[q][j][c] * GW[(((1 + grp[q]) * 2 + j) * 8 + c) * 64 + lane];
#pragma unroll
    for (int q = 0; q < NR; ++q) { float el[4];
#pragma unroll
        for (int e = 0; e < 4; ++e) el[e] = wave_sum(acc[q][e], lane) * rstd[q] + P.b_re_[(l * 4 + grp[q]) * 4 + e];
        int i1 = 0; float v1 = el[0];
#pragma unroll
        for (int e = 1; e < 4; ++e) if (el[e] > v1) { v1 = el[e]; i1 = e; }
        int i2 = -1; float v2 = -INFINITY;
#pragma unroll
        for (int e = 0; e < 4; ++e) if (e != i1 && el[e] > v2) { v2 = el[e]; i2 = e; }
        const float e2 = expf(v2 - v1); const float w1 = g1[q] / (1.f + e2), w2 = g1[q] * e2 / (1.f + e2);
        const int a = i1 < i2 ? i1 : i2, b = i1 < i2 ? i2 : i1; const float wa = i1 < i2 ? w1 : w2, wb = i1 < i2 ? w2 : w1;
        const int pair = (a == 0) ? (b - 1) : (a == 1 ? (b + 1) : 5);
        const int cls = grp[q] * 6 + pair; const int row = r0 + q * rstride;
        if (lane == 0) {
            const int lslot = __hip_atomic_fetch_add(lcnt + cls, 1, __ATOMIC_RELAXED, __HIP_MEMORY_SCOPE_WORKGROUP);
            troute[row] = (unsigned)(grp[q] * 4 + a) | ((unsigned)(grp[q] * 4 + b) << 8) | ((unsigned)cls << 16) | ((unsigned)lslot << 24);
            tw[row] = (f32x4){wa, wb, rstd[q], 0.f};
        } }
}

__device__ __forceinline__ void mix_row_attn(int row, int lane, const bf16* OB, const float* LSE, bf16* AB) {
    const int h = lane >> 3;
    float ls[3], m = -INFINITY;
#pragma unroll
    for (int b = 0; b < 3; ++b) { ls[b] = LSE[((size_t)b * NT + row) * NH + h]; m = fmaxf(m, ls[b]); }
    float w[3], ws_ = 0.f;
#pragma unroll
    for (int b = 0; b < 3; ++b) { w[b] = expf(ls[b] - m); ws_ += w[b]; }
    float o[8];
#pragma unroll
    for (int i = 0; i < 8; ++i) o[i] = 0.f;
#pragma unroll
    for (int b = 0; b < 3; ++b) { const u32x4 q = *((const u32x4*)(OB + ((size_t)b * NT + row) * AW) + lane); const float wb = w[b] / ws_;
        o[0] += wb * bf2f(q.x & 0xffffu); o[1] += wb * bf2f(q.x >> 16); o[2] += wb * bf2f(q.y & 0xffffu); o[3] += wb * bf2f(q.y >> 16);
        o[4] += wb * bf2f(q.z & 0xffffu); o[5] += wb * bf2f(q.z >> 16); o[6] += wb * bf2f(q.w & 0xffffu); o[7] += wb * bf2f(q.w >> 16); }
    float s = 0.f;
#pragma unroll
    for (int i = 0; i < 8; ++i) s += o[i] * o[i];
    const float rstd = 1.f / sqrtf(wave_sum(s, lane) * (1.f / AW) + RMS_EPS);
    *((u32x4*)(AB + (size_t)row * DM) + lane) = (u32x4){pk2(o[0] * rstd, o[1] * rstd), pk2(o[2] * rstd, o[3] * rstd), pk2(o[4] * rstd, o[5] * rstd), pk2(o[6] * rstd, o[7] * rstd)};
}
namespace pg8 {
typedef short bf16x8 __attribute__((ext_vector_type(8)));
constexpr int BM = 256, BK = 64, HALF = 128, HTB = HALF * BK * 2, STAGE_BYTES = 8 * HTB, NXCD = 8, WGM = 8;
__host__ __device__ __forceinline__ int lds_byte(int r, int c) { const int st = (r >> 4) * 2 + (c >> 5), rr = r & 15, cc = c & 31, ob = rr * 64 + cc * 2; return st * 1024 + (ob ^ (((ob >> 9) & 1) << 5)); }
__host__ __device__ __forceinline__ void stage_rc(int b, int& R, int& C) { const int st = b / 1024, sb = b % 1024, swz = sb ^ (((sb >> 9) & 1) << 5); R = (st >> 1) * 16 + swz / 64; C = (st & 1) * 32 + (swz % 64) / 2; }
__host__ __device__ __forceinline__ int perm32(int rho) { const int n = rho >> 4, i = rho & 15; return 8 * (i >> 2) + 4 * n + (i & 3); }
struct Unit { int pm, pn; const char* a; const char* b; int x0, x1, x2, fl; };
__device__ __forceinline__ bool static_order(int nM, int nN, int G, int c, int i, int& pm, int& pn) {
    const int nwg = nM * nN; const long L = (long)i * G + c; if (L >= nwg) return false;
    int wgid = (int)L; { const int q = nwg / NXCD, r = nwg % NXCD, xcd = wgid % NXCD, off = wgid / NXCD; wgid = (xcd < r ? xcd * (q + 1) : r * (q + 1) + (xcd - r) * q) + off; }
    const int nig = WGM * nN, gid = wgid / nig, fm = gid * WGM, gsz = (nM - fm) < WGM ? (nM - fm) : WGM;
    pm = fm + ((wgid % nig) % gsz); pn = (wgid % nig) / gsz; return true;
}
__device__ __forceinline__ unsigned cvt_pk_bf16(float lo, float hi) { unsigned r; asm volatile("v_cvt_pk_bf16_f32 %0, %1, %2" : "=v"(r) : "v"(lo), "v"(hi)); return r; }
template <class Epi, class Sched, bool GATHER, bool ALIGN_EPI>
__device__ __forceinline__ void gemm_phase(const int tid, LAS unsigned char* lds, const int lda, const int ldb, const int K, const Sched& S, const Epi& E, const size_t kstepA = (size_t)(BK * 2)) {
    const int wid = __builtin_amdgcn_readfirstlane(tid >> 6), lane = tid & 63, wr = wid >> 2, wc = wid & 3, fr = lane & 15, fq = lane >> 4;
    const int nt = K / BK;
    int Rr[2], Cc[2]; unsigned voffB[2], cvA0[2], cvA1[2], nvA0[2], nvA1[2];
#pragma unroll
    for (int i = 0; i < 2; ++i) { stage_rc(tid * 16 + i * 8192, Rr[i], Cc[i]); const int Rb = Epi::PERM ? ((Rr[i] & ~31) + perm32(Rr[i] & 31)) : Rr[i]; voffB[i] = (unsigned)(Rb * ldb + Cc[i]) * 2u; }
    const size_t kstep = (size_t)(BK * 2);
    const size_t hstepB = (size_t)HALF * ldb * 2;
    const unsigned ldsw = (unsigned)wid * 1024u;
    const int aoff = lds_byte(wr * 64 + fr, fq * 8), boff = lds_byte(wc * 32 + fr, fq * 8);
#define PG8_SA(b, h) (((b) * 2 + (h)) * HTB)
#define PG8_SB(b, h) ((4 + (b) * 2 + (h)) * HTB)
#define PG8_STAGE(bufoff, gbase, voff) do { _Pragma("unroll") for (int _i = 0; _i < 2; ++_i) \
        __builtin_amdgcn_global_load_lds((const unsigned*)((const char*)(gbase) + (voff)[_i]), (LAS unsigned*)(lds + (bufoff) + ldsw + _i * 8192), 16, 0, 0); } while (0)
#define PG8_LDA(dst, b, h) do { _Pragma("unroll") for (int m = 0; m < 4; ++m) _Pragma("unroll") for (int k = 0; k < 2; ++k) dst[m][k] = *(const LAS bf16x8*)(lds + PG8_SA(b, h) + aoff + m * 2048 + k * 1024); } while (0)
#define PG8_LDB(dst, b, h) do { _Pragma("unroll") for (int n = 0; n < 2; ++n) _Pragma("unroll") for (int k = 0; k < 2; ++k) dst[n][k] = *(const LAS bf16x8*)(lds + PG8_SB(b, h) + boff + n * 2048 + k * 1024); } while (0)
#define PG8_MMA(ai, bj, At, Bt) do { __builtin_amdgcn_s_setprio(1); _Pragma("unroll") for (int m = 0; m < 4; ++m) _Pragma("unroll") for (int n = 0; n < 2; ++n) _Pragma("unroll") for (int k = 0; k < 2; ++k) \
        acc[ai][bj][m][n] = __builtin_amdgcn_mfma_f32_16x16x32_bf16(Bt[n][k], At[m][k], acc[ai][bj][m][n], 0, 0, 0); __builtin_amdgcn_s_setprio(0); } while (0)
#define PG8_WAIT_V(n) asm volatile("s_waitcnt vmcnt(" #n ")" ::: "memory")
#define PG8_WAIT_L(n) asm volatile("s_waitcnt lgkmcnt(" #n ")" ::: "memory")
#define PG8_BAR __builtin_amdgcn_s_barrier()
#define PG8_SCHED __builtin_amdgcn_sched_barrier(0)
#define PG8_BP(u, tile) ((u).b + (size_t)(tile) * kstep)
#define PG8_SETA(u, v0, v1) do { _Pragma("unroll") for (int _i = 0; _i < 2; ++_i) { v0[_i] = S.aoff(u, Rr[_i], Cc[_i], lda); v1[_i] = S.aoff(u, HALF + Rr[_i], Cc[_i], lda); } } while (0)
    Unit cur, nxt; int ui = 0;
    if (!S.next(0, cur)) return;
    S.a_ready(cur);
    PG8_SETA(cur, cvA0, cvA1);
    f32x4 acc[2][2][4][2];
#pragma unroll
    for (int a = 0; a < 2; ++a)
#pragma unroll
        for (int b = 0; b < 2; ++b)
#pragma unroll
            for (int m = 0; m < 4; ++m)
#pragma unroll
                for (int n = 0; n < 2; ++n) acc[a][b][m][n] = (f32x4){0.f, 0.f, 0.f, 0.f};
    bf16x8 At[4][2], B0[2][2], B1[2][2];
    {   const char* cB = PG8_BP(cur, 0); const char* cB1 = PG8_BP(cur, 1);
        PG8_STAGE(PG8_SB(0, 0), cB, voffB); PG8_STAGE(PG8_SB(0, 1), cB + hstepB, voffB); PG8_STAGE(PG8_SA(0, 0), cur.a, cvA0); PG8_STAGE(PG8_SA(0, 1), cur.a, cvA1);
        if (wr == 1) PG8_BAR;
        PG8_WAIT_V(2); PG8_BAR;
        PG8_STAGE(PG8_SB(1, 0), cB1, voffB); PG8_STAGE(PG8_SA(1, 0), cur.a + kstepA, cvA0); PG8_STAGE(PG8_SB(1, 1), cB1 + hstepB, voffB);
        PG8_WAIT_V(6); PG8_BAR; }
    for (;;) {
        const bool has_next = S.next(ui + 1, nxt);
        if (has_next) { S.a_ready(nxt); PG8_SETA(nxt, nvA0, nvA1); } else {
#pragma unroll
            for (int i = 0; i < 2; ++i) { nvA0[i] = cvA0[i]; nvA1[i] = cvA1[i]; } }
        const char* nA = has_next ? nxt.a : cur.a; const char* nB = has_next ? PG8_BP(nxt, 0) : PG8_BP(cur, 0);
        for (int t = 0; t < nt; t += 2) {
            const bool last = (t == nt - 2);
            const char* a1 = cur.a + (size_t)(t + 1) * kstepA;
            const char* a2 = last ? nA : cur.a + (size_t)(t + 2) * kstepA; const char* b2 = last ? nB : PG8_BP(cur, t + 2);
            const char* a3 = a2 + kstepA; const char* b3 = b2 + kstep;
            unsigned vo0[2], vo1[2];
#pragma unroll
            for (int i = 0; i < 2; ++i) { vo0[i] = last ? nvA0[i] : cvA0[i]; vo1[i] = last ? nvA1[i] : cvA1[i]; }
            PG8_LDB(B0, 0, 0); PG8_LDB(B1, 0, 1); PG8_SCHED; PG8_LDA(At, 0, 0); PG8_STAGE(PG8_SA(1, 1), a1, cvA1);
            PG8_WAIT_V(8); PG8_WAIT_L(0); PG8_BAR; PG8_MMA(0, 0, At, B0); PG8_MMA(0, 1, At, B1); PG8_BAR; PG8_SCHED;
            PG8_LDA(At, 0, 1); PG8_STAGE(PG8_SB(0, 0), b2, voffB); PG8_STAGE(PG8_SB(0, 1), b2 + hstepB, voffB); PG8_STAGE(PG8_SA(0, 0), a2, vo0);
            PG8_WAIT_V(8); PG8_WAIT_L(0); PG8_BAR; PG8_MMA(1, 0, At, B0); PG8_MMA(1, 1, At, B1); PG8_BAR; PG8_SCHED;
            PG8_LDB(B0, 1, 0); PG8_LDB(B1, 1, 1); PG8_SCHED; PG8_LDA(At, 1, 0); PG8_STAGE(PG8_SA(0, 1), a2, vo1);
            PG8_WAIT_V(8); PG8_WAIT_L(0); PG8_BAR; PG8_MMA(0, 0, At, B0); PG8_MMA(0, 1, At, B1); PG8_BAR; PG8_SCHED;
            PG8_LDA(At, 1, 1); PG8_STAGE(PG8_SB(1, 0), b3, voffB); PG8_STAGE(PG8_SB(1, 1), b3 + hstepB, voffB); PG8_STAGE(PG8_SA(1, 0), a3, vo0);
            PG8_WAIT_V(8); PG8_WAIT_L(0); PG8_BAR; PG8_MMA(1, 0, At, B0); PG8_MMA(1, 1, At, B1); PG8_BAR; PG8_SCHED;
        }
        const bool epi = (cur.fl & 2) != 0;
        if (epi) {
            if constexpr (ALIGN_EPI) { if (wr == 0) PG8_BAR; }
            { int t2 = tid; asm volatile("" : "+v"(t2));
              const int w2 = __builtin_amdgcn_readfirstlane(t2 >> 6), l2 = t2 & 63; E(acc, cur, w2 >> 2, w2 & 3, l2 & 15, l2 >> 4); S.done(cur, l2); }
        }
        if (!epi) { int t2 = tid; asm volatile("" : "+v"(t2)); const int w2 = __builtin_amdgcn_readfirstlane(t2 >> 6), l2 = t2 & 63; E.mid(acc, cur, w2 >> 2, w2 & 3, l2 & 15, l2 >> 4); }
        if (!has_next) break;
        if (nxt.fl & 1) {
#pragma unroll
            for (int a = 0; a < 2; ++a)
#pragma unroll
                for (int b = 0; b < 2; ++b)
#pragma unroll
                    for (int m = 0; m < 4; ++m)
#pragma unroll
                        for (int n = 0; n < 2; ++n) acc[a][b][m][n] = (f32x4){0.f, 0.f, 0.f, 0.f};
        }
        cur = nxt; ++ui;
#pragma unroll
        for (int i = 0; i < 2; ++i) { cvA0[i] = nvA0[i]; cvA1[i] = nvA1[i]; }
        if (epi) { if constexpr (ALIGN_EPI) { if (wr == 1) PG8_BAR; } }
    }
    PG8_WAIT_V(0);
    if constexpr (!ALIGN_EPI) { if (wr == 0) PG8_BAR; }
    PG8_BAR;
#undef PG8_SA
#undef PG8_SB
#undef PG8_STAGE
#undef PG8_LDA
#undef PG8_LDB
#undef PG8_MMA
#undef PG8_WAIT_V
#undef PG8_WAIT_L
#undef PG8_BAR
#undef PG8_SCHED
#undef PG8_BP
#undef PG8_SETA
}

struct DenseSched {
    const char* A; const char* Bt; int nM, nN, G, c; size_t atile, btile;
    __device__ __forceinline__ bool next(int i, Unit& u) const { int pm, pn; if (!static_order(nM, nN, G, c, i, pm, pn)) return false;
        u.pm = pm; u.pn = pn; u.a = A + (size_t)pm * atile; u.b = Bt + (size_t)pn * btile; u.x0 = u.x1 = u.x2 = 0; u.fl = 3; return true; }
    __device__ __forceinline__ unsigned aoff(const Unit&, int r, int c, int lda) const { return (unsigned)(r * lda + c) * 2u; }
    __device__ __forceinline__ void a_ready(const Unit&) const {}
    __device__ __forceinline__ void done(const Unit&, int) const {}
};
struct GluSched {
    const char* A; const char* Bt; int nM, nN, G, c;
    __device__ __forceinline__ bool next(int i, Unit& u) const { int pm, pn; if (!static_order(nM, nN, G, c, i, pm, pn)) return false;
        u.pm = pm; u.pn = pn; u.a = A + (size_t)pm * 256 * 32; u.b = Bt + (size_t)pn * 256 * SW * 2; u.x0 = u.x1 = u.x2 = 0; u.fl = 3; return true; }
    __device__ __forceinline__ unsigned aoff(const Unit&, int r, int c, int) const { return (unsigned)((c >> 4) * NT + r) * 32u + (unsigned)(c & 15) * 2u; }
    __device__ __forceinline__ void a_ready(const Unit&) const {}
    __device__ __forceinline__ void done(const Unit&, int) const {}
};
struct EpiStoreBf16 {
    static constexpr bool PERM = true; bf16* C; int ldc; const float* ss; bf16* UGM;
    __device__ __forceinline__ void mid(f32x4 (&)[2][2][4][2], const Unit&, int, int, int, int) const {}
    __device__ __forceinline__ void operator()(const f32x4 (&acc)[2][2][4][2], const Unit& u, int wr, int wc, int fr, int fq) const {
        const int row0 = u.pm * BM + wr * 64 + fr, col0 = u.pn * BM + wc * 32 + 8 * fq; const bool isu = col0 >= 3 * AW;
#pragma unroll
        for (int ai = 0; ai < 2; ++ai)
#pragma unroll
            for (int m = 0; m < 4; ++m) { const int row = row0 + ai * HALF + m * 16; const f32x4* sp = (const f32x4*)(ss + (size_t)row * 16); const f32x4 s4 = (sp[0] + sp[1]) + (sp[2] + sp[3]); const float r = 1.f / sqrtf(((s4[0] + s4[1]) + (s4[2] + s4[3])) * (1.f / DM) + RMS_EPS);
#pragma unroll
                for (int bj = 0; bj < 2; ++bj) { const f32x4 v0 = acc[ai][bj][m][0] * r, v1 = acc[ai][bj][m][1] * r; const int col = col0 + bj * HALF;
                    bf16* dst = isu ? UGM + ((size_t)((col - 3 * AW) >> 4) * NT + row) * 16 + (col & 15) : C + (size_t)row * ldc + col;
                    store16_wt(dst, (u32x4){cvt_pk_bf16(v0[0], v0[1]), cvt_pk_bf16(v0[2], v0[3]), cvt_pk_bf16(v1[0], v1[1]), cvt_pk_bf16(v1[2], v1[3])}); } }
    }
};
struct EpiGlu {
    static constexpr bool PERM = true; bf16* C; const bf16* aux; int ldc; float* SSG;
    __device__ __forceinline__ void mid(f32x4 (&)[2][2][4][2], const Unit&, int, int, int, int) const {}
    __device__ __forceinline__ void operator()(const f32x4 (&acc)[2][2][4][2], const Unit& u, int wr, int wc, int fr, int fq) const {
        const int row0 = u.pm * BM + wr * 64 + fr, col0 = u.pn * BM + wc * 32 + 8 * fq; const int lane = fr + 16 * fq;
#pragma unroll
        for (int ai = 0; ai < 2; ++ai)
#pragma unroll
            for (int m = 0; m < 4; ++m) { const int row = row0 + ai * HALF + m * 16; const size_t ro = (size_t)row * ldc + col0; float ssq = 0.f;
#pragma unroll
                for (int bj = 0; bj < 2; ++bj) { const f32x4 v0 = acc[ai][bj][m][0], v1 = acc[ai][bj][m][1]; const int col_ = col0 + bj * HALF; const u32x4 y = *(const u32x4*)(aux + ((size_t)(col_ >> 4) * NT + row) * 16 + (col_ & 15));
                    float r[8]; r[0] = bf2f(y.x & 0xffffu) * sigmoidf_(v0[0]); r[1] = bf2f(y.x >> 16) * sigmoidf_(v0[1]); r[2] = bf2f(y.y & 0xffffu) * sigmoidf_(v0[2]); r[3] = bf2f(y.y >> 16) * sigmoidf_(v0[3]);
                    r[4] = bf2f(y.z & 0xffffu) * sigmoidf_(v1[0]); r[5] = bf2f(y.z >> 16) * sigmoidf_(v1[1]); r[6] = bf2f(y.w & 0xffffu) * sigmoidf_(v1[2]); r[7] = bf2f(y.w >> 16) * sigmoidf_(v1[3]);
                    const u32x4 o = (u32x4){cvt_pk_bf16(r[0], r[1]), cvt_pk_bf16(r[2], r[3]), cvt_pk_bf16(r[4], r[5]), cvt_pk_bf16(r[6], r[7])}; float rb[8]; unpack8(o, rb);
#pragma unroll
                    for (int e = 0; e < 8; ++e) ssq += rb[e] * rb[e];
                    *(u32x4*)(C + ro + bj * HALF) = o; }
                ssq += lane_xor(ssq, lane, 16); ssq += lane_xor(ssq, lane, 32);
                if (fq == 0) SSG[(size_t)row * 8 + u.pn * 4 + wc] = ssq; }
    }
};
struct EpiResid {
    static constexpr bool PERM = true; bf16* XB; int ldc; const float* SSG;
    __device__ __forceinline__ float ssum(int row) const { const f32x4* sp = (const f32x4*)(SSG + (size_t)row * 8); const f32x4 s4 = sp[0] + sp[1]; return ((s4[0] + s4[1]) + (s4[2] + s4[3])) * (1.f / SW) + RMS_EPS; }
    __device__ __forceinline__ void mid(f32x4 (&acc)[2][2][4][2], const Unit& u, int wr, int wc, int fr, int fq) const {
        const int row0 = u.pm * BM + wr * 64 + fr; (void)wc; (void)fq;
#pragma unroll
        for (int ai = 0; ai < 2; ++ai)
#pragma unroll
            for (int m = 0; m < 4; ++m) { const float irs = sqrtf(ssum(row0 + ai * HALF + m * 16));
#pragma unroll
                for (int bj = 0; bj < 2; ++bj)
#pragma unroll
                    for (int n = 0; n < 2; ++n) acc[ai][bj][m][n] *= irs;
                asm volatile("" : "+v"(acc[ai][0][m][0]), "+v"(acc[ai][0][m][1]), "+v"(acc[ai][1][m][0]), "+v"(acc[ai][1][m][1]) :: "memory"); }
    }
    __device__ __forceinline__ void operator()(const f32x4 (&acc)[2][2][4][2], const Unit& u, int wr, int wc, int fr, int fq) const {
        const int row0 = u.pm * BM + wr * 64 + fr, col0 = u.pn * BM + wc * 32 + 8 * fq;
#pragma unroll
        for (int ai = 0; ai < 2; ++ai)
#pragma unroll
            for (int m = 0; m < 4; ++m) { const int row = row0 + ai * HALF + m * 16; const size_t ro = (size_t)row * ldc + col0; const float rs = 1.f / sqrtf(ssum(row));
#pragma unroll
                for (int bj = 0; bj < 2; ++bj) { float b[8]; unpack8(*(const u32x4*)(XB + ro + bj * HALF), b); const f32x4 a0 = acc[ai][bj][m][0] * rs, a1 = acc[ai][bj][m][1] * rs;
                    *(u32x4*)(XB + ro + bj * HALF) = (u32x4){cvt_pk_bf16(b[0] + a0[0], b[1] + a0[1]), cvt_pk_bf16(b[2] + a0[2], b[3] + a0[3]), cvt_pk_bf16(b[4] + a1[0], b[5] + a1[1]), cvt_pk_bf16(b[6] + a1[2], b[7] + a1[3])}; }
                asm volatile("" ::: "memory"); }
    }
};
struct OutSched {
    const char* AB; const char* Wt; int G, c;
    __device__ __forceinline__ bool next(int i, Unit& u) const { int pm, pn; if (!static_order(NT / 256, DM / 256, G, c, i >> 1, pm, pn)) return false; const int seg = i & 1;
        u.pm = pm; u.pn = pn; u.x0 = u.x1 = u.x2 = 0; u.fl = seg ? 2 : 1;
        u.a = AB + (size_t)pm * 256 * DM * 2 + (seg ? AW * 2 : 0); u.b = Wt + (size_t)pn * 256 * DM * 2 + (seg ? AW * 2 : 0); return true; }
    __device__ __forceinline__ unsigned aoff(const Unit&, int r, int c, int lda) const { return (unsigned)(r * lda + c) * 2u; }
    __device__ __forceinline__ void a_ready(const Unit&) const {}
    __device__ __forceinline__ void done(const Unit&, int) const {}
};
__device__ __forceinline__ void moe_build_prefix(const int tid, LAS int* tpre, unsigned* cnt) {
    __syncthreads();
    if (tid == 0) { int s = 0;
#pragma unroll 1
        for (int c = 0; c < NCLS; ++c) { const int n = (int)__hip_atomic_load(cnt + c, __ATOMIC_RELAXED, __HIP_MEMORY_SCOPE_AGENT); tpre[c] = s; tpre[32 + c] = n; s += (n + 255) >> 8; } tpre[NCLS] = s; }
    __syncthreads();
}
__device__ __forceinline__ void pair_decode(int pair, int& a, int& b) { a = pair < 3 ? 0 : (pair < 5 ? 1 : 2); b = pair < 3 ? pair + 1 : (pair < 5 ? pair - 1 : 3); }
struct MoeSched {
    const LAS int* tpre; const int* ltok; const char* A; const char* W; int G, c, l, up; unsigned* ucnt; unsigned* tmo;
    __device__ __forceinline__ void fill(int pm, int pn, int seg, Unit& u) const {
        int cls = 0;
#pragma unroll 1
        for (int q = 1; q < NCLS; ++q) if (pm >= __builtin_amdgcn_readfirstlane(tpre[q])) cls = q;
        const int grp = cls / 6; int ea, eb; pair_decode(cls % 6, ea, eb); ea += grp * 4; eb += grp * 4;
        u.pm = pm; u.pn = pn; u.x0 = cls; u.x1 = (pm - __builtin_amdgcn_readfirstlane(tpre[cls])) * 256; u.x2 = __builtin_amdgcn_readfirstlane(tpre[32 + cls]);
        if (up) { const int e = pn < 2 ? ea : eb; u.a = A; u.b = W + ((size_t)((l * NE + e) * 2 + (pn & 1))) * 256 * DM * 2; u.fl = 3; }
        else { const int e = seg ? eb : ea; u.a = A + (size_t)pm * 256 * 512 * 2 + seg * (EFF * 2); u.b = W + ((size_t)(l * NE + e) * DM + pn * 256) * EFF * 2; u.fl = seg ? 2 : 1; }
    }
    __device__ __forceinline__ bool next(int i, Unit& u) const {
        const int MT = __builtin_amdgcn_readfirstlane(tpre[NCLS]);
        if (G == 256) {
            const int x = c & 7, j = c >> 3; const int cb0 = (x * MT) >> 3, cb1 = ((x + 1) * MT) >> 3; const int n4 = (cb1 - cb0 - 8) * 4;
            if (up) { int pm, pn;
                if (i == 0) { pm = cb0 + (j & 7); pn = j >> 3; }
                else if (i == 1 && j < n4) { pm = cb0 + 8 + (j >> 2); pn = j & 3; }
                else return false;
                fill(pm, pn, 0, u); return true; }
            const int jd = i >> 1, seg = i & 1; int pm, pn;
            if (j >= n4) { const int F = 32 - n4, e = (j - n4) + jd * F; if (e >= 32) return false; pm = cb0 + (e & 7); pn = e >> 3; }
            else { if (jd > 0) return false; pm = cb0 + 8 + (j >> 2); pn = j & 3; }
            fill(pm, pn, seg, u); return true;
        }
        const int E0 = G >> 2;
        const int R = (MT - E0) * 4;
        if (up) { int pm, pn;
            if (i == 0) { pm = (c & 7) + 8 * (c >> 5); pn = (c >> 3) & 3; }
            else { const int L2 = (i - 1) * G + c; if (L2 >= R) return false; pm = E0 + (L2 >> 2); pn = L2 & 3; }
            fill(pm, pn, 0, u); return true; }
        const int jd = i >> 1, seg = i & 1; int pm, pn;
        const int Rc = R < G ? R : G;
        if (c >= Rc) { const int F = G - Rc, e = (c - Rc) + jd * F; if (e >= G) return false; pm = (e & 7) + 8 * (e >> 5); pn = (e >> 3) & 3; }
        else { const int q = c + jd * G; if (q >= R) return false; pm = E0 + (q >> 2); pn = q & 3; }
        fill(pm, pn, seg, u); return true;
    }
    __device__ __forceinline__ unsigned aoff(const Unit& u, int r, int c, int lda) const {
        if (!up) return (unsigned)(r * lda + c) * 2u;
        int i = u.x1 + r; i = i < u.x2 ? i : u.x2 - 1; return (unsigned)ltok[(size_t)u.x0 * NT + i] * (unsigned)(DM * 2) + (unsigned)c * 2u; }
    __device__ __forceinline__ void a_ready(const Unit& u) const {
        if (up || !(u.fl & 1)) return;
        if (threadIdx.x < 64) { unsigned sp = 0;
            while ((unsigned)__builtin_amdgcn_readfirstlane((int)__hip_atomic_load(ucnt + u.pm, __ATOMIC_RELAXED, __HIP_MEMORY_SCOPE_AGENT)) < 32u) {
                __builtin_amdgcn_s_sleep(2);
                if ((++sp & 255u) == 0u) { if (__hip_atomic_load(tmo, __ATOMIC_RELAXED, __HIP_MEMORY_SCOPE_AGENT) != 0u) break; if (sp > (1u << 20)) { atomicAdd(tmo, 1u); break; } } }
            __builtin_amdgcn_fence(__ATOMIC_ACQUIRE, "agent");
            asm volatile("s_waitcnt vmcnt(0)" ::: "memory"); }
        asm volatile("" ::: "memory"); __builtin_amdgcn_s_barrier(); asm volatile("" ::: "memory");
    }
    __device__ __forceinline__ void done(const Unit& u, int lane) const {
        if (!up) return;
        asm volatile("s_waitcnt vmcnt(0)" ::: "memory");
        if (lane == 0) __hip_atomic_fetch_add(ucnt + u.pm, 1u, __ATOMIC_RELAXED, __HIP_MEMORY_SCOPE_AGENT);
    }
};
struct EpiMoeUp {
    static constexpr bool PERM = true; bf16* ACT; const f32x4* lw;
    __device__ __forceinline__ void mid(f32x4 (&)[2][2][4][2], const Unit&, int, int, int, int) const {}
    __device__ __forceinline__ void operator()(const f32x4 (&acc)[2][2][4][2], const Unit& u, int wr, int wc, int fr, int fq) const {
        const int col0 = (u.pn >> 1) * 256 + (u.pn & 1) * 128 + wc * 32 + 8 * fq;
#pragma unroll
        for (int ai = 0; ai < 2; ++ai)
#pragma unroll
            for (int m = 0; m < 4; ++m) { const int r = ai * HALF + wr * 64 + m * 16 + fr; int i = u.x1 + r; i = i < u.x2 ? i : u.x2 - 1;
                const f32x4 lwv = lw[(size_t)u.x0 * NT + i]; const float w = (u.pn >> 1) ? lwv[1] : lwv[0], rs = lwv[2];
                const f32x4 g0 = acc[ai][0][m][0], g1 = acc[ai][0][m][1], u0 = acc[ai][1][m][0], u1 = acc[ai][1][m][1]; float v[8];
#pragma unroll
                for (int j = 0; j < 4; ++j) { const float ga = g0[j] * rs, gb = g1[j] * rs; v[j] = ga * sigmoidf_(ga) * (u0[j] * rs) * w; v[4 + j] = gb * sigmoidf_(gb) * (u1[j] * rs) * w; }
                store16_wt(ACT + (size_t)(u.pm * BM + r) * 512 + col0, (u32x4){cvt_pk_bf16(v[0], v[1]), cvt_pk_bf16(v[2], v[3]), cvt_pk_bf16(v[4], v[5]), cvt_pk_bf16(v[6], v[7])}); }
    }
};
template <bool DRY> struct EpiMoeDown {
    static constexpr bool PERM = true; bf16* XB; const int* ltok; float* SS;
    __device__ __forceinline__ void mid(f32x4 (&)[2][2][4][2], const Unit&, int, int, int, int) const {}
    __device__ __forceinline__ void operator()(const f32x4 (&acc)[2][2][4][2], const Unit& u, int wr, int wc, int fr, int fq) const {
        const int col0 = u.pn * BM + wc * 32 + 8 * fq; const int lane = fr + 16 * fq;
#pragma unroll
        for (int ai = 0; ai < 2; ++ai)
#pragma unroll
            for (int m = 0; m < 4; ++m) { const int r = ai * HALF + wr * 64 + m * 16 + fr; const int i = u.x1 + r; const bool ok = i < u.x2;
                const int tok = ltok[(size_t)u.x0 * NT + (ok ? i : u.x2 - 1)]; const size_t ro = (size_t)tok * DM + col0; u32x4 xv[2];
#pragma unroll
                for (int bj = 0; bj < 2; ++bj) xv[bj] = *(const u32x4*)(XB + ro + bj * HALF);
                float ssq = 0.f;
#pragma unroll
                for (int bj = 0; bj < 2; ++bj) { float b[8]; unpack8(xv[bj], b); const f32x4 a0 = acc[ai][bj][m][0], a1 = acc[ai][bj][m][1];
                    if (!DRY) { b[0] += a0[0]; b[1] += a0[1]; b[2] += a0[2]; b[3] += a0[3]; b[4] += a1[0]; b[5] += a1[1]; b[6] += a1[2]; b[7] += a1[3]; }
                    const u32x4 o = (u32x4){cvt_pk_bf16(b[0], b[1]), cvt_pk_bf16(b[2], b[3]), cvt_pk_bf16(b[4], b[5]), cvt_pk_bf16(b[6], b[7])};
                    float rb[8]; unpack8(o, rb);
#pragma unroll
                    for (int e = 0; e < 8; ++e) ssq += rb[e] * rb[e];
                    if (ok) *(u32x4*)(XB + ro + bj * HALF) = o; }
                ssq += lane_xor(ssq, lane, 16); ssq += lane_xor(ssq, lane, 32);
                if (ok && fq == 0 && !DRY) SS[(size_t)tok * 16 + u.pn * 4 + wc] = ssq;
                asm volatile("" ::: "memory"); }
    }
};
}


namespace attn {
typedef short bf16x8 __attribute__((ext_vector_type(8)));
typedef short s16x4 __attribute__((ext_vector_type(4)));
typedef float f32x16 __attribute__((ext_vector_type(16)));
__device__ __forceinline__ unsigned cvtpk(float lo, float hi) { typedef float f2 __attribute__((ext_vector_type(2))); typedef __bf16 b2 __attribute__((ext_vector_type(2))); f2 v = {lo, hi}; b2 b = __builtin_convertvector(v, b2); return __builtin_bit_cast(unsigned, b); }
__device__ __forceinline__ s16x4 vtr(const LAS unsigned char* p) { return __builtin_bit_cast(s16x4, __builtin_amdgcn_ds_read_tr16_b64_v4i16((LAS s16x4*)p)); }
constexpr int N_ITEMS = NB * NH * 48, N_STEPS = N_ITEMS / 2;
__device__ __forceinline__ void attn_phase(const int tid, LAS unsigned char* lds, const bf16* PROJ, bf16* OB, float* LSE, int G, int bx) {
    const int lane = tid & 63, wid = __builtin_amdgcn_readfirstlane(tid >> 6), half = wid >> 2, w = wid & 3, tid4 = tid & 255;
    const int r32 = lane & 31, hi = lane >> 5;
    LAS unsigned char* Kt = lds + half * 65536;
    LAS unsigned char* Vt = Kt + 32768;
    for (int step = bx; step < N_STEPS; step += G) {
        const int it = step * 2 + half; const int bh = it / 48, rem = it % 48, br = rem >> 4, tile = rem & 15;
        const int b = bh >> 3, h = bh & 7;
        const int dil = br == 0 ? 1 : (br == 1 ? 4 : 16); const int rr = br == 0 ? 0 : (br == 1 ? (tile & 3) : tile); const int blk = br == 0 ? tile : (br == 1 ? (tile >> 2) : 0);
        const bool first = (blk == 0);
        const size_t tokbase = (size_t)b * SEQ;
#pragma unroll
        for (int j = 0; j < 8; ++j) { const int row = j * 32 + (tid4 >> 3), ch = tid4 & 7; const bool valid = !(first && row < 128);
            u32x4 kv = (u32x4){0u, 0u, 0u, 0u}, vv = (u32x4){0u, 0u, 0u, 0u};
            if (valid) { const int pos = dil * (128 * (blk - 1) + row) + rr; const bf16* src = PROJ + (tokbase + pos) * INW + AW + h * HD + ch * 8; kv = *(const u32x4*)src; vv = *(const u32x4*)(src + AW); }
            *(LAS u32x4*)(Kt + ch * 4096 + ((row ^ ch) * 16)) = kv;
            *(LAS u32x4*)(Vt + (ch >> 2) * 16384 + row * 64 + (ch & 3) * 16) = vv; }
        const int qrow = 32 * w + r32; const int qpos = dil * (128 * blk + qrow) + rr;
        const bf16* qp = PROJ + (tokbase + qpos) * INW + h * HD + hi * 8;
        bf16x8 qf[4];
#pragma unroll
        for (int d0 = 0; d0 < 4; ++d0) qf[d0] = *(const bf16x8*)(qp + d0 * 16);
        __syncthreads();
        const int kt_lo = first ? (4 - w) : 0;
        f32x16 p[5];
#pragma unroll
        for (int kt = 0; kt < 5; ++kt) { p[kt] = f32x16{};
            if (kt >= kt_lo) {
#pragma unroll
                for (int d0 = 0; d0 < 4; ++d0) { const int ch = 2 * d0 + hi; const int kpos = 32 * w + 32 * kt + r32;
                    const bf16x8 kf = *(const LAS bf16x8*)(Kt + ch * 4096 + ((kpos ^ ch) * 16));
                    p[kt] = __builtin_amdgcn_mfma_f32_32x32x16_bf16(kf, qf[d0], p[kt], 0, 0, 0); } } }
        const float SC = 0.125f * 1.4426950408889634f;
        float mx = -INFINITY;
#pragma unroll
        for (int kt = 0; kt < 5; ++kt) if (kt >= kt_lo) {
#pragma unroll
            for (int r = 0; r < 16; ++r) { const int c = (r & 3) + 8 * (r >> 2) + 4 * hi; bool ok = true; if (kt == 0) ok = (c >= r32); if (kt == 4) ok = (c <= r32);
                const float sv = ok ? p[kt][r] * SC : -INFINITY; p[kt][r] = sv; mx = fmaxf(mx, sv); } }
        mx = fmaxf(mx, lane_xor(mx, lane, 32));
        float lsum = 0.f;
#pragma unroll
        for (int kt = 0; kt < 5; ++kt) if (kt >= kt_lo) {
#pragma unroll
            for (int r = 0; r < 16; ++r) { const float e = __builtin_amdgcn_exp2f(p[kt][r] - mx); p[kt][r] = e; lsum += e; } }
        lsum += lane_xor(lsum, lane, 32);
        f32x16 o[2]; o[0] = f32x16{}; o[1] = f32x16{};
        const LAS unsigned char* vbase = Vt + (32 * w + 4 * hi + ((lane & 15) >> 2)) * 64 + ((lane >> 4) & 1) * 32 + (lane & 3) * 8;
#pragma unroll
        for (int kt = 0; kt < 5; ++kt) if (kt >= kt_lo) {
#pragma unroll
            for (int ks = 0; ks < 2; ++ks) {
                u32x4 pw; pw.x = cvtpk(p[kt][8 * ks + 0], p[kt][8 * ks + 1]); pw.y = cvtpk(p[kt][8 * ks + 2], p[kt][8 * ks + 3]); pw.z = cvtpk(p[kt][8 * ks + 4], p[kt][8 * ks + 5]); pw.w = cvtpk(p[kt][8 * ks + 6], p[kt][8 * ks + 7]);
                const bf16x8 pf = __builtin_bit_cast(bf16x8, pw);
#pragma unroll
                for (int dh = 0; dh < 2; ++dh) { const LAS unsigned char* va = vbase + dh * 16384 + (32 * kt + 16 * ks) * 64;
                    const s16x4 lo = vtr(va), hi8 = vtr(va + 512);
                    const bf16x8 vf = (bf16x8){lo[0], lo[1], lo[2], lo[3], hi8[0], hi8[1], hi8[2], hi8[3]};
                    o[dh] = __builtin_amdgcn_mfma_f32_32x32x16_bf16(vf, pf, o[dh], 0, 0, 0); } } }
        const float inv = 1.f / lsum; const size_t tok = tokbase + qpos;
        bf16* op = OB + ((size_t)br * NT + tok) * AW + h * HD + 4 * hi;
#pragma unroll
        for (int dh = 0; dh < 2; ++dh)
#pragma unroll
            for (int g4 = 0; g4 < 4; ++g4) *(u32x2*)(op + 32 * dh + 8 * g4) = (u32x2){cvtpk(o[dh][4 * g4] * inv, o[dh][4 * g4 + 1] * inv), cvtpk(o[dh][4 * g4 + 2] * inv, o[dh][4 * g4 + 3] * inv)};
        if (hi == 0) LSE[((size_t)br * NT + tok) * NH + h] = (mx + __builtin_amdgcn_logf(lsum)) * 0.6931471805599453f;
        __syncthreads();
    }
}
}

namespace ssm {
typedef short bf16x8 __attribute__((ext_vector_type(8)));
__device__ __forceinline__ void ssm_phase(const int tid, LAS unsigned char* lds, unsigned char* ws, unsigned char* pj, int l, int G, int bx) {
    typedef float f32x2 __attribute__((ext_vector_type(2)));
    const int lane = tid & 63, wid = __builtin_amdgcn_readfirstlane(tid >> 6), nt4 = wid & 3, ih = wid >> 2;
    const bf16* UGM = (const bf16*)(ws + WS_UGM); bf16* YG = (bf16*)(ws + WS_YG); (void)pj;
    LAS float* Ef = (LAS float*)lds;
    LAS f32x2* Tot = (LAS f32x2*)(lds + 32768);
    LAS unsigned char* Kl = lds + 36864;
    for (int it = bx; it < NG * NB; it += G) {
        const int g = it % NG, b = it / NG, lg = l * NG + g;
        const bf16* Bb2 = (const bf16*)(ws + WS_BB2) + (size_t)lg * 128 * 32; const bf16* Ccm = (const bf16*)(ws + WS_CC) + (size_t)lg * 16 * 128;
        const unsigned char* Ktg = ws + WS_KTAB + (size_t)lg * 33 * 512; const float* Lams = (const float*)(ws + WS_LAMS) + (size_t)lg * 64 * 6;
        const int c = 16 * nt4 + (lane & 15), jj = lane >> 5, h0 = 8 * ((lane >> 4) & 1), q4 = lane >> 4;
        const u32x4 kt0 = *(const u32x4*)(Ktg + tid * 16), kt1 = *(const u32x4*)(Ktg + (tid + MKT) * 16); u32x4 kt2 = (u32x4){0u, 0u, 0u, 0u}; if (tid < 32) kt2 = *(const u32x4*)(Ktg + (tid + 2 * MKT) * 16);
        bf16x8 Uf[16];
        { const bf16* up = UGM + ((size_t)g * NT + (size_t)b * SEQ + (size_t)c * CL + jj) * 16 + h0;
#pragma unroll
          for (int ks = 0; ks < 16; ++ks) Uf[ks] = *(const bf16x8*)(up + (size_t)(2 * ks) * 16); }
        bf16x8 Af[4]; float l2r[4][2], l2i[4][2];
#pragma unroll
        for (int mi = 0; mi < 4; ++mi) { const int m = ih * 4 + mi; Af[mi] = *(const bf16x8*)(Bb2 + (size_t)(16 * m + (lane & 15)) * 32 + 8 * q4);
#pragma unroll
            for (int e = 0; e < 2; ++e) { const int p = 8 * m + 2 * q4 + e; l2r[mi][e] = Lams[p * 6 + 2]; l2i[mi][e] = Lams[p * 6 + 3]; } }
        const float sc_ar = Lams[(tid & 63) * 6 + 4], sc_ai = Lams[(tid & 63) * 6 + 5];
        *(LAS u32x4*)(Kl + tid * 16) = kt0; *(LAS u32x4*)(Kl + (tid + MKT) * 16) = kt1; if (tid < 32) *(LAS u32x4*)(Kl + (tid + 2 * MKT) * 16) = kt2;
        { f32x4 acc[4];
#pragma unroll
          for (int mi = 0; mi < 4; ++mi) acc[mi] = (f32x4){0.f, 0.f, 0.f, 0.f};
#pragma unroll
          for (int ks = 0; ks < 16; ++ks) {
#pragma unroll
              for (int mi = 0; mi < 4; ++mi) { f32x4 a = acc[mi];
                  if (ks > 0) a = (f32x4){l2r[mi][0] * a[0] - l2i[mi][0] * a[1], l2r[mi][0] * a[1] + l2i[mi][0] * a[0], l2r[mi][1] * a[2] - l2i[mi][1] * a[3], l2r[mi][1] * a[3] + l2i[mi][1] * a[2]};
                  acc[mi] = __builtin_amdgcn_mfma_f32_16x16x32_bf16(Af[mi], Uf[ks], a, 0, 0, 0); } }
#pragma unroll
          for (int mi = 0; mi < 4; ++mi) *(LAS f32x4*)(Ef + c * 128 + 16 * (ih * 4 + mi) + 4 * q4) = acc[mi]; }
        __syncthreads();
        { const int p = tid & 63, seg = tid >> 6; const float ar = sc_ar, ai = sc_ai;
          float lr[8], li[8]; float sr = 0.f, si = 0.f;
#pragma unroll
          for (int cc = 0; cc < 8; ++cc) { lr[cc] = sr; li[cc] = si; const f32x2 e = *(const LAS f32x2*)(Ef + (seg * 8 + cc) * 128 + 2 * p);
              const float nr = ar * sr - ai * si + e.x, ni = ar * si + ai * sr + e.y; sr = nr; si = ni; }
          Tot[seg * 64 + p] = (f32x2){sr, si};
          float a8r = ar, a8i = ai;
#pragma unroll
          for (int q = 0; q < 3; ++q) { const float tr = a8r * a8r - a8i * a8i, ti = 2.f * a8r * a8i; a8r = tr; a8i = ti; }
          __syncthreads();
          float cr = 0.f, ci = 0.f;
          for (int s2 = 0; s2 < seg; ++s2) { const f32x2 t = Tot[s2 * 64 + p]; const float nr = a8r * cr - a8i * ci + t.x, ni = a8r * ci + a8i * cr + t.y; cr = nr; ci = ni; }
          float pr = 1.f, pi = 0.f;
#pragma unroll
          for (int cc = 0; cc < 8; ++cc) { *(LAS f32x2*)(Ef + (seg * 8 + cc) * 128 + 2 * p) = (f32x2){lr[cc] + pr * cr - pi * ci, li[cc] + pr * ci + pi * cr};
              const float tr = pr * ar - pi * ai, ti = pr * ai + pi * ar; pr = tr; pi = ti; } }
        __syncthreads();
        { bf16x8 Cf[4]; float zr[4][4], zi[4][4], l2r[4][4], l2i[4][4];
#pragma unroll
          for (int k2 = 0; k2 < 4; ++k2) { Cf[k2] = *(const bf16x8*)(Ccm + (size_t)(lane & 15) * 128 + 32 * k2 + 8 * q4);
              const f32x4 s0 = *(const LAS f32x4*)(Ef + c * 128 + 32 * k2 + 8 * q4), s1 = *(const LAS f32x4*)(Ef + c * 128 + 32 * k2 + 8 * q4 + 4);
              const float sre[4] = {s0[0], s0[2], s1[0], s1[2]}, sim[4] = {s0[1], s0[3], s1[1], s1[3]};
#pragma unroll
              for (int e = 0; e < 4; ++e) { const int p = 16 * k2 + 4 * q4 + e; const float* lp = Lams + p * 6; l2r[k2][e] = lp[2]; l2i[k2][e] = lp[3];
                  const float fr_ = ih ? lp[2] : lp[0], fi_ = ih ? lp[3] : lp[1];
                  zr[k2][e] = fr_ * sre[e] - fi_ * sim[e]; zi[k2][e] = fr_ * sim[e] + fi_ * sre[e]; } }
          const LAS unsigned char* kbase = Kl + (lane & 15) * 32 + h0 * 2;
#pragma unroll
          for (int gq = 0; gq < 4; ++gq)
#pragma unroll 1
          for (int ii4 = 0; ii4 < 4; ++ii4) { const int ii = 4 * gq + ii4; const int i = 2 * ii + ih; f32x4 acc = (f32x4){0.f, 0.f, 0.f, 0.f};
#pragma unroll
              for (int k2 = 0; k2 < 4; ++k2) { u32x4 zw; zw.x = attn::cvtpk(zr[k2][0], zi[k2][0]); zw.y = attn::cvtpk(zr[k2][1], zi[k2][1]); zw.z = attn::cvtpk(zr[k2][2], zi[k2][2]); zw.w = attn::cvtpk(zr[k2][3], zi[k2][3]);
                  acc = __builtin_amdgcn_mfma_f32_16x16x32_bf16(Cf[k2], __builtin_bit_cast(bf16x8, zw), acc, 0, 0, 0);
#pragma unroll
                  for (int e = 0; e < 4; ++e) { const float nr = l2r[k2][e] * zr[k2][e] - l2i[k2][e] * zi[k2][e], ni = l2r[k2][e] * zi[k2][e] + l2i[k2][e] * zr[k2][e]; zr[k2][e] = nr; zi[k2][e] = ni; } }
              const LAS unsigned char* kp = kbase + (i - jj + 1) * 512;
#pragma unroll
              for (int ks = 0; ks < 4 * gq; ++ks) { const bf16x8 af = *(const LAS bf16x8*)(kp - ks * 1024); acc = __builtin_amdgcn_mfma_f32_16x16x32_bf16(af, Uf[ks], acc, 0, 0, 0); }
#pragma unroll
              for (int ks = 4 * gq; ks < 4 * gq + 4; ++ks) if (ks <= ii) { const bf16x8 af = *(const LAS bf16x8*)(kp - ks * 1024); acc = __builtin_amdgcn_mfma_f32_16x16x32_bf16(af, Uf[ks], acc, 0, 0, 0); }
              const size_t tok = (size_t)b * SEQ + (size_t)c * CL + i;
              *(u32x2*)(YG + ((size_t)g * NT + tok) * 16 + 4 * q4) = (u32x2){pk2(gelu_tanh(acc[0]), gelu_tanh(acc[1])), pk2(gelu_tanh(acc[2]), gelu_tanh(acc[3]))}; } }
        __syncthreads();
    }
}
}

#define XB_TMO      128
#define XB_XCNT(j)  (256  + 64 * (j))
#define XB_XSUB(j)  (1280 + 64 * (j))
#define XB_XGEN(j)  (2304 + 64 * (j))
#define XB_TOP      3328
#define XB_TOPGEN   3392
#define XCD_BAR_WORDS 3456
#define XB_SPIN_CAP (1u << 18)
__device__ __forceinline__ unsigned xb_ld(unsigned* p)              { return __hip_atomic_load(p, __ATOMIC_RELAXED, __HIP_MEMORY_SCOPE_AGENT); }
__device__ __forceinline__ unsigned xb_add(unsigned* p, unsigned v) { return __hip_atomic_fetch_add(p, v, __ATOMIC_RELAXED, __HIP_MEMORY_SCOPE_AGENT); }
__device__ __forceinline__ unsigned xb_xcc_id() { return (unsigned)__builtin_amdgcn_s_getreg((3 << 11) | 20) & 0xFu; }
#define XB_SPIN(cond, bar) do { unsigned _sp = 0; while (cond) { __builtin_amdgcn_s_sleep(1); \
    if ((++_sp & 255u) == 0u) { if (xb_ld(&(bar)[XB_TMO])) break; if (_sp > XB_SPIN_CAP) { atomicAdd(&(bar)[XB_TMO], 1u); break; } } } } while (0)
struct XcdBarrier { unsigned* bar; unsigned x; volatile LAS unsigned* st; };
__device__ __forceinline__ XcdBarrier xcd_barrier_post(unsigned* bar, volatile LAS unsigned* st) {
    XcdBarrier b; b.bar = bar; b.x = xb_xcc_id(); b.st = st;
    if (threadIdx.x == 0) (void)xb_add(&bar[XB_XCNT(b.x)], 1u);
    return b;
}
__device__ __forceinline__ void xcd_barrier_complete(unsigned* bar, unsigned x, unsigned& nloc, unsigned& nx) {
    const unsigned G = gridDim.x * gridDim.y * gridDim.z;
    unsigned sum, cnt, mine, sp = 0u;
    for (;;) {
        sum = 0u; cnt = 0u; mine = 0u;
#pragma unroll
        for (unsigned j = 0; j < 16; ++j) { const unsigned c = xb_ld(&bar[XB_XCNT(j)]); sum += c; cnt += (c > 0u) ? 1u : 0u; mine = (j == x) ? c : mine; }
        if (sum == G) break;
        __builtin_amdgcn_s_sleep(1);
        if ((++sp & 255u) == 0u) { if (xb_ld(&bar[XB_TMO])) break; if (sp > XB_SPIN_CAP) { atomicAdd(&bar[XB_TMO], 1u); break; } }
    }
    nloc = mine > 0u ? mine : 1u; nx = cnt > 0u ? cnt : 1u;
}
__device__ __forceinline__ void xcd_barrier(const XcdBarrier& b) {
    asm volatile("s_waitcnt vmcnt(0)" ::: "memory");
    __syncthreads();
    if (threadIdx.x == 0) {
        unsigned* bar = b.bar; unsigned bx_ = b.x;
        asm volatile("" : "+s"(bar), "+s"(bx_));
        __builtin_amdgcn_s_waitcnt(0);
        unsigned nloc = b.st[0], nx = b.st[1];
        if (nloc == 0u) { xcd_barrier_complete(bar, bx_, nloc, nx); b.st[0] = nloc; b.st[1] = nx; }
        const unsigned old = xb_add(&bar[XB_XSUB(bx_)], 1u);
        const unsigned gen = old / nloc;
        if (old + 1u == (gen + 1u) * nloc) {
            __builtin_amdgcn_fence(__ATOMIC_RELEASE, "agent");
            asm volatile("s_waitcnt vmcnt(0)" ::: "memory");
            const unsigned og = xb_add(&bar[XB_TOP], 1u);
            const unsigned tg = og / nx;
            if (og + 1u == (tg + 1u) * nx) xb_add(&bar[XB_TOPGEN], 1u);
            else XB_SPIN(xb_ld(&bar[XB_TOPGEN]) == tg, bar);
            __builtin_amdgcn_fence(__ATOMIC_ACQUIRE, "agent");
            xb_add(&bar[XB_XGEN(bx_)], 1u);
            asm volatile("s_waitcnt vmcnt(0)" ::: "memory");
        } else {
            XB_SPIN(xb_ld(&bar[XB_XGEN(bx_)]) == gen, bar);
            __builtin_amdgcn_fence(__ATOMIC_ACQUIRE, "agent");
            asm volatile("s_waitcnt vmcnt(0)" ::: "memory");
        }
    }
    __syncthreads();
}

__device__ __forceinline__ void norm_rows(const float* x, bf16* xn, float* outf, const float* g, int mode, int gw, int ngw, int lane) {
    for (int row = gw; row < NT; row += ngw) {
        const f32x4* xr = (const f32x4*)(x + (size_t)row * DM) + lane; f32x4 v[4]; float s = 0.f;
#pragma unroll
        for (int j = 0; j < 4; ++j) { v[j] = xr[64 * j]; s += v[j].x * v[j].x + v[j].y * v[j].y + v[j].z * v[j].z + v[j].w * v[j].w; }
        const float ssq = wave_sum(s, lane); const float rstd = 1.f / sqrtf(ssq * (1.f / DM) + RMS_EPS);
        if (mode == 0) { u32x2* o = (u32x2*)(xn + (size_t)row * DM) + lane;
#pragma unroll
            for (int j = 0; j < 4; ++j) o[64 * j] = (u32x2){pk2(v[j].x * rstd, v[j].y * rstd), pk2(v[j].z * rstd, v[j].w * rstd)};
        } else if (mode == 1) { u32x2* o = (u32x2*)(xn + (size_t)row * DM) + lane;
#pragma unroll
            for (int j = 0; j < 4; ++j) o[64 * j] = (u32x2){pk2(v[j].x, v[j].y), pk2(v[j].z, v[j].w)};
            if (lane < 16) outf[(size_t)row * 16 + lane] = lane == 0 ? ssq : 0.f;
        } else { f32x4* o = (f32x4*)(outf + (size_t)row * DM) + lane; const f32x4* gg = (const f32x4*)g + lane;
#pragma unroll
            for (int j = 0; j < 4; ++j) { const f32x4 gv = gg[64 * j]; o[64 * j] = (f32x4){v[j].x * rstd * gv.x, v[j].y * rstd * gv.y, v[j].z * rstd * gv.z, v[j].w * rstd * gv.w}; } }
    }
}

__device__ __forceinline__ void final_rows(const bf16* XB, float* out, const float* g, int gw, int ngw, int lane) {
    for (int row = gw; row < NT; row += ngw) { const u32x4* xr = (const u32x4*)(XB + (size_t)row * DM) + lane; float v[2][8]; float s = 0.f;
#pragma unroll
        for (int j = 0; j < 2; ++j) { unpack8(xr[64 * j], v[j]);
#pragma unroll
            for (int c = 0; c < 8; ++c) s += v[j][c] * v[j][c]; }
        const float rstd = 1.f / sqrtf(wave_sum(s, lane) * (1.f / DM) + RMS_EPS);
#pragma unroll
        for (int j = 0; j < 2; ++j) { const f32x4* gp = (const f32x4*)(g + 512 * j + 8 * lane); const f32x4 g0 = gp[0], g1 = gp[1]; f32x4* op = (f32x4*)(out + (size_t)row * DM + 512 * j + 8 * lane);
            op[0] = (f32x4){v[j][0] * rstd * g0[0], v[j][1] * rstd * g0[1], v[j][2] * rstd * g0[2], v[j][3] * rstd * g0[3]};
            op[1] = (f32x4){v[j][4] * rstd * g1[0], v[j][5] * rstd * g1[1], v[j][6] * rstd * g1[2], v[j][7] * rstd * g1[3]}; } }
}

#ifndef TL_MASK
#define TL_MASK 0ull
#endif
#define TL_K 4ull
#ifndef REP_ATTN
#define REP_ATTN 1
#endif
#ifndef REP_P0
#define REP_P0 1
#endif
#ifndef REP_NORM
#define REP_NORM 1
#endif
#ifndef REP_INPROJ
#define REP_INPROJ 1
#endif
#ifndef REP_GLU
#define REP_GLU 1
#endif
#ifndef REP_MIX
#define REP_MIX 1
#endif
#ifndef REP_OUT
#define REP_OUT 1
#endif
#ifndef REP_ROUTE
#define REP_ROUTE 1
#endif
#ifndef REP_MOEUP
#define REP_MOEUP 1
#endif
#ifndef REP_MOEDN
#define REP_MOEDN 1
#endif

#ifndef REP_SSM
#define REP_SSM 1
#endif
constexpr int MK_THREADS = 512, MK_LDS = 147456;
constexpr int CW_BAR = 4096;
constexpr int LDS_CTL_OFF = 131072, LDS_MISC_OFF = LDS_CTL_OFF + 512;
enum { ST_P0 = 0, ST_NORM = 1, ST_INPROJ = 2, ST_MIXERS = 3, ST_GLU = 4, ST_MIX = 5, ST_OUT = 6, ST_ROUTE = 7, ST_MOEUP = 8, ST_MOEDN = 9, ST_FINAL = 10 };
constexpr int PROG_LEN = 2 + 9 * NL;
__host__ __device__ __forceinline__ void prog_decode(int pi, int& step, int& layer) {
    if (pi == 0) { step = ST_P0; layer = 0; return; }
    if (pi == PROG_LEN - 1) { step = ST_FINAL; layer = NL - 1; return; }
    int q = pi - 1;
    if (q < 8) { layer = 0; step = ST_INPROJ + q; return; }
    q -= 8; layer = 1 + q / 9; step = ST_NORM + q % 9;
}
struct MkArgs { Ptrs P; int s_lo, s_hi, flags, pad1; };
#if defined(__HIP_DEVICE_COMPILE__)
#define CAS __attribute__((address_space(4)))
#else
#define CAS
#endif
__global__ void __launch_bounds__(MK_THREADS, 2) mk(MkArgs args) {
    extern __shared__ __attribute__((aligned(16))) unsigned char lds_raw[];
    LAS unsigned char* const lds0 = (LAS unsigned char*)lds_raw;
    const CAS MkArgs* ap = (const CAS MkArgs*)__builtin_amdgcn_kernarg_segment_ptr();
    const int G0 = gridDim.x; const int bx0 = blockIdx.x;
    const int tid0 = threadIdx.x;
    for (int u = tid0; u < (MK_LDS - LDS_CTL_OFF) / 4; u += MK_THREADS) ((LAS unsigned*)(lds0 + LDS_CTL_OFF))[u] = 0u;
    __syncthreads();
    const int lo = args.s_lo, hi = args.s_hi;
#if TL_MASK
    unsigned long long tl_prev = __builtin_amdgcn_s_memrealtime(), tl_sum = 0;
#endif
    XcdBarrier bar; bar.bar = (unsigned*)(args.P.ws + WS_CTL) + CW_BAR; bar.x = 0; bar.st = nullptr;
    if (hi - lo > 1) bar = xcd_barrier_post(bar.bar, (volatile LAS unsigned*)(lds0 + LDS_MISC_OFF));
#if TL_MASK
#define TL_MARK(k) { const unsigned long long tn_ = __builtin_amdgcn_s_memrealtime(); if ((TL_MASK >> (k)) & 1ull) tl_sum += tn_ - tl_prev; tl_prev = tn_; }
#else
#define TL_MARK(k)
#endif
#define STEP_BEGIN(k) if (lo <= (k) && (k) < hi) { int G = G0, bx = bx0, tid = tid0; unsigned ldsv = (unsigned)(uintptr_t)lds0; asm volatile("" : "+s"(ap), "+s"(G), "+s"(bx), "+v"(tid), "+s"(ldsv)); \
    LAS unsigned char* const lds = (LAS unsigned char*)(uintptr_t)ldsv; const int lane = tid & 63, wave = __builtin_amdgcn_readfirstlane(tid >> 6); (void)lane; const int gw = bx * 8 + wave, ngw = G * 8; (void)gw; (void)ngw; const Ptrs P = ap->P; unsigned char* const ws = P.ws; unsigned char* const pj = (unsigned char*)P.out; (void)pj; unsigned* const ctl = (unsigned*)(ws + WS_CTL); (void)ctl;
#define STEP_OFF(k) if (0) { const int G = 1, bx = 0, gw = 0, ngw = 1, tid = 0, lane = 0, wave = 0; LAS unsigned char* const lds = lds0; (void)lane; (void)wave; const Ptrs P{}; unsigned char* const ws = nullptr; unsigned char* const pj = nullptr; unsigned* const ctl = nullptr; (void)ctl;
#define STEP_END(k) if ((k) + 1 < hi) xcd_barrier(bar); TL_MARK(k) }
    STEP_BEGIN(0)
      for (int rep = 0; rep < REP_P0; ++rep) {
        for (int ti = bx; ti < 2 * NL * NG; ti += G) p0_tables_item(P, ti >> 1, ti & 1, (LAS float*)lds, tid, MK_THREADS);
        __syncthreads();
        p0_transposes(P, (LAS float*)lds + wave * 64 * 33, gw, ngw, lane);
        norm_rows(P.x, (bf16*)(ws + WS_XB), (float*)(ws + WS_SS1), nullptr, 1, gw, ngw, lane);
        __syncthreads(); }
    STEP_END(0)
#pragma unroll 1
    for (int l = 0; l < NL; ++l) {
        const int kb = 1 + 9 * l;
        STEP_BEGIN(kb + 1)
            pg8::DenseSched S{(const char*)(ws + WS_XB), (const char*)(ws + WS_WIN) + (size_t)l * INW * DM * 2, NT / 256, INW / 256, G, bx, (size_t)256 * DM * 2, (size_t)256 * DM * 2};
            pg8::EpiStoreBf16 E{(bf16*)(pj), INW, (const float*)(ws + WS_SS1), (bf16*)(ws + WS_UGM)};
            for (int rep = 0; rep < REP_INPROJ; ++rep) pg8::gemm_phase<pg8::EpiStoreBf16, pg8::DenseSched, false, true>(tid, lds, DM, DM, DM, S, E);
        STEP_END(kb + 1)
        STEP_BEGIN(kb + 2)
            for (int rep = 0; rep < REP_ATTN; ++rep) attn::attn_phase(tid, lds, (const bf16*)(pj), (bf16*)(ws + WS_OB), (float*)(ws + WS_LSE), G, bx);
            TL_MARK(40)
            for (int rep = 0; rep < REP_SSM; ++rep) ssm::ssm_phase(tid, lds, ws, pj, l, G, bx);
        STEP_END(kb + 2)
        STEP_BEGIN(kb + 3)
            { pg8::GluSched S{(const char*)(ws + WS_YG), (const char*)(ws + WS_WGLU) + (size_t)l * SW * SW * 2, NT / 256, SW / 256, G, bx};
              pg8::EpiGlu E{(bf16*)(ws + WS_AB) + AW, (const bf16*)(ws + WS_YG), DM, (float*)(ws + WS_SSG)};
              pg8::gemm_phase<pg8::EpiGlu, pg8::GluSched, false, true>(tid, lds, SW, SW, SW, S, E, (size_t)4 * NT * 32); }
            { const int nglu = (NT / 256) * (SW / 256); const int mb = G > nglu ? bx - nglu : bx, nmb = G > nglu ? G - nglu : G;
              if (mb >= 0) for (int row = mb * 8 + wave; row < NT; row += nmb * 8) mix_row_attn(row, lane, (const bf16*)(ws + WS_OB), (const float*)(ws + WS_LSE), (bf16*)(ws + WS_AB)); }
        STEP_END(kb + 3)
        STEP_BEGIN(kb + 5)
            pg8::OutSched S{(const char*)(ws + WS_AB), (const char*)(ws + WS_WOUT) + (size_t)l * DM * DM * 2, G, bx};
            pg8::EpiResid E{(bf16*)(ws + WS_XB), DM, (const float*)(ws + WS_SSG)};
            pg8::gemm_phase<pg8::EpiResid, pg8::OutSched, false, false>(tid, lds, DM, DM, SW, S, E);
        STEP_END(kb + 5)
        STEP_BEGIN(kb + 6)
            LAS f32x4* GW = (LAS f32x4*)lds; LAS int* lcnt = (LAS int*)(lds + 98304); LAS int* lbase = lcnt + 32; LAS int* lpart = lcnt + 64;
            if (tid < 32) lcnt[tid] = 0;
            route_build_lds(P, l, GW, tid);
            int* cnt2 = (int*)(ws + WS_CNT2) + (size_t)l * 1024 * 32;
            {
#pragma unroll 1
              for (int r0 = gw; r0 < NT; r0 += 2 * ngw) { route_rows<2>(P, l, r0, ngw, lane, GW, (const bf16*)(ws + WS_XB), (unsigned*)(ws + WS_TROUTE), (f32x4*)(ws + WS_TW), lcnt); }
              __syncthreads();
              if (tid < 32) cnt2[bx * 32 + tid] = lcnt[tid];
              xcd_barrier(bar);
              { const int c = tid >> 4, part = tid & 15; int sum = 0, tot = 0;
                for (int b2 = part; b2 < G; b2 += 16) { const int v = __hip_atomic_load(cnt2 + b2 * 32 + c, __ATOMIC_RELAXED, __HIP_MEMORY_SCOPE_AGENT); tot += v; if (b2 < bx) sum += v; }
                lpart[tid] = sum; lpart[512 + tid] = tot; }
              __syncthreads();
              if (tid < 32) { int sum = 0, tot = 0; for (int q = 0; q < 16; ++q) { sum += lpart[tid * 16 + q]; tot += lpart[512 + tid * 16 + q]; } lbase[tid] = sum; if (bx == 0 && tid < NCLS) ctl[CW_CNT + l * 32 + tid] = (unsigned)tot; }
              __syncthreads();
              if (lane == 0) { int* ltok = (int*)(ws + WS_LTOK); f32x4* lw = (f32x4*)(ws + WS_LW); const unsigned* troute = (const unsigned*)(ws + WS_TROUTE); const f32x4* tw = (const f32x4*)(ws + WS_TW);
#pragma unroll 1
                for (int row = gw; row < NT; row += ngw) { const unsigned rt = troute[row]; const int cls = (int)((rt >> 16) & 255u), slot = lbase[cls] + (int)(rt >> 24);
                    ltok[(size_t)cls * NT + slot] = row; lw[(size_t)cls * NT + slot] = tw[row]; } } }
        STEP_END(kb + 6)
        STEP_BEGIN(kb + 7)
            LAS int* tpre = (LAS int*)(lds + LDS_CTL_OFF); pg8::moe_build_prefix(tid, tpre, ctl + CW_CNT + l * 32);
            unsigned* ucnt = ctl + CW_UCNT + l * 128; unsigned* tmo = ctl + CW_BAR + XB_TMO;
            { pg8::MoeSched S{tpre, (const int*)(ws + WS_LTOK), (const char*)(ws + WS_XB), (const char*)(ws + WS_WGU), G, bx, l, 1, ucnt, tmo};
              pg8::EpiMoeUp E{(bf16*)(pj), (const f32x4*)(ws + WS_LW)};
              pg8::gemm_phase<pg8::EpiMoeUp, pg8::MoeSched, true, true>(tid, lds, DM, DM, DM, S, E); }
            { pg8::MoeSched S{tpre, (const int*)(ws + WS_LTOK), (const char*)(pj), (const char*)(ws + WS_WD), G, bx, l, 0, ucnt, tmo};
              pg8::EpiMoeDown<false> E{(bf16*)(ws + WS_XB), (const int*)(ws + WS_LTOK), (float*)(ws + WS_SS1)};
              pg8::gemm_phase<pg8::EpiMoeDown<false>, pg8::MoeSched, false, true>(tid, lds, 512, EFF, EFF, S, E); }
        STEP_END(kb + 7)
    }
    STEP_BEGIN(1 + 9 * NL)
        final_rows((const bf16*)(ws + WS_XB), P.out, P.final_g, gw, ngw, lane);
    STEP_END(1 + 9 * NL)
#if TL_MASK
    if (bx0 == 0) { const unsigned long long t0_ = __builtin_amdgcn_s_memrealtime(); while (__builtin_amdgcn_s_memrealtime() - t0_ < TL_K * tl_sum) __builtin_amdgcn_s_sleep(8); }
#endif
#undef STEP_BEGIN
#undef STEP_OFF
#undef STEP_END
}

#ifndef MK_SPLIT
#define MK_SPLIT 0
#endif
extern "C" void kernel_launch(void* const* d_in, const int* in_sizes, int n_in, void* d_out, int out_size, void* d_ws, size_t ws_size, hipStream_t stream) {
    if (n_in != 24 || out_size != NT * DM || ws_size < WS_END) { fprintf(stderr, "kernel_launch: unexpected shapes n_in %d out %d ws %zu (need %zu)\n", n_in, out_size, ws_size, (size_t)WS_END); return; }
    static int grid = 0;
    if (grid == 0) {
        int dev = 0, cus = 0, per_cu = 0;
        if (hipFuncSetAttribute((const void*)mk, hipFuncAttributeMaxDynamicSharedMemorySize, MK_LDS) != hipSuccess) { fprintf(stderr, "kernel_launch: hipFuncSetAttribute failed\n"); grid = -1; return; }
        if (hipGetDevice(&dev) != hipSuccess || hipDeviceGetAttribute(&cus, hipDeviceAttributeMultiprocessorCount, dev) != hipSuccess) { fprintf(stderr, "kernel_launch: device query failed\n"); grid = -1; return; }
        if (hipOccupancyMaxActiveBlocksPerMultiprocessor(&per_cu, (const void*)mk, MK_THREADS, MK_LDS) != hipSuccess || per_cu < 1) { fprintf(stderr, "kernel_launch: occupancy query failed (%d)\n", per_cu); grid = -1; return; }
        grid = cus * per_cu;
        fprintf(stderr, "kernel_launch: %d CUs x %d blocks/CU -> grid %d\n", cus, per_cu, grid);
    }
    if (grid < 0) return;
    Ptrs P{};
    const float** pf = (const float**)&P;
    for (int i = 0; i < 24; ++i) pf[i] = (const float*)d_in[i];
    P.out = (float*)d_out; P.ws = (unsigned char*)d_ws;
    (void)hipMemsetAsync(P.ws + WS_CTL, 0, 65536, stream);
    MkArgs a{}; a.P = P;
#if MK_SPLIT
    for (int pi = 0; pi < PROG_LEN; ++pi) { a.s_lo = pi; a.s_hi = pi + 1; hipLaunchKernelGGL(mk, dim3(grid), dim3(MK_THREADS), MK_LDS, stream, a); }
#else
    a.s_lo = 0; a.s_hi = PROG_LEN;
    void* kargs[] = {&a};
    const hipError_t e = hipLaunchCooperativeKernel((const void*)mk, dim3(grid), dim3(MK_THREADS), kargs, MK_LDS, stream);
    if (e != hipSuccess) fprintf(stderr, "kernel_launch: cooperative launch failed: %s (grid %d)\n", hipGetErrorString(e), grid);
#endif
}
```

```cpp
#include <hip/hip_runtime.h>
#include <cstdio>
#include <cstdint>

typedef unsigned short bf16;
typedef float f32x4 __attribute__((ext_vector_type(4)));
typedef unsigned u32x4 __attribute__((ext_vector_type(4)));
typedef unsigned u32x2 __attribute__((ext_vector_type(2)));
#define LAS __attribute__((address_space(3)))

constexpr int NB = 8, SEQ = 2048, DM = 1024, NL = 4, NT = NB * SEQ;
constexpr int AW = 512, HD = 64, NH = 8, SW = 512, GC = 16, NG = 32, NP = 64, INW = 2048;
constexpr int NE = 16, EFF = 256, NCLS = 24;
constexpr float RMS_EPS = 1e-6f;
constexpr int CL = 32;
constexpr int NCH = SEQ / CL;
constexpr int MKT = 512;

constexpr size_t al256(size_t x) { return (x + 255) & ~(size_t)255; }
constexpr size_t WS_CTL = 0, CTL_BYTES = 1u << 20;
constexpr size_t WS_WIN  = WS_CTL + CTL_BYTES;
constexpr size_t WS_WGLU = WS_WIN  + (size_t)NL * INW * DM * 2;
constexpr size_t WS_WOUT = WS_WGLU + (size_t)NL * SW * SW * 2;
constexpr size_t WS_WGU  = WS_WOUT + (size_t)NL * DM * DM * 2;
constexpr size_t WS_WD   = WS_WGU  + (size_t)NL * NE * 512 * DM * 2;
constexpr size_t WS_KTAB = WS_WD   + (size_t)NL * NE * DM * EFF * 2;
constexpr size_t WS_BB2  = WS_KTAB + al256((size_t)NL * NG * 33 * 256 * 2);
constexpr size_t WS_CC   = WS_BB2  + (size_t)NL * NG * 128 * 32 * 2;
constexpr size_t WS_LAMS = WS_CC   + (size_t)NL * NG * 16 * 128 * 2;
constexpr size_t WS_AB   = WS_LAMS + (size_t)NL * NG * 64 * 6 * 4;
constexpr size_t WS_UGM  = WS_AB + (size_t)NT * SW * 2;
constexpr size_t WS_OB   = WS_AB + (size_t)NT * DM * 2;
constexpr size_t WS_TROUTE = WS_OB + (size_t)3 * NT * AW * 2;
constexpr size_t WS_TW   = WS_TROUTE + (size_t)NT * 4;
constexpr size_t WS_LTOK = WS_TW + (size_t)NT * 16;
constexpr size_t WS_LW   = WS_LTOK + (size_t)NCLS * NT * 4;
constexpr size_t WS_LSE  = WS_LW + (size_t)NCLS * NT * 16;
constexpr size_t WS_SS1  = WS_LSE + (size_t)3 * NT * NH * 4;
constexpr size_t WS_CNT2 = WS_SS1 + (size_t)NT * 16 * 4;
constexpr size_t WS_XB   = WS_CNT2 + (size_t)NL * 1024 * 32 * 4;
constexpr size_t WS_RS2  = WS_XB + (size_t)NT * DM * 2;
constexpr size_t WS_SSG  = WS_RS2 + (size_t)NT * 4;
constexpr size_t WS_YG   = WS_SSG + (size_t)NT * 8 * 4;
constexpr size_t WS_END  = WS_YG + (size_t)NT * SW * 2;
static_assert(WS_END <= 325000000, "workspace map exceeds the guaranteed size");
constexpr int CW_CNT = 1024;
constexpr int CW_UCNT = 2048;

__device__ __forceinline__ unsigned f2bf(float f) { unsigned u = __builtin_bit_cast(unsigned, f); return (u + 0x7fffu + ((u >> 16) & 1u)) >> 16; }
__device__ __forceinline__ float bf2f(unsigned h) { return __builtin_bit_cast(float, h << 16); }
__device__ __forceinline__ unsigned pk2(float lo, float hi) { return f2bf(lo) | (f2bf(hi) << 16); }
__device__ __forceinline__ float lane_xor(float v, int lane, int o) { return __builtin_bit_cast(float, __builtin_amdgcn_ds_bpermute((lane ^ o) << 2, __builtin_bit_cast(int, v))); }
#define DPP_ADD(x, ctrl, rmask) ((x) + __builtin_bit_cast(float, __builtin_amdgcn_update_dpp(0, __builtin_bit_cast(int, (x)), (ctrl), (rmask), 0xf, true)))
__device__ __forceinline__ float wave_sum(float v, int) {
    v = DPP_ADD(v, 0x111, 0xf); v = DPP_ADD(v, 0x112, 0xf); v = DPP_ADD(v, 0x114, 0xf); v = DPP_ADD(v, 0x118, 0xf);
    v = DPP_ADD(v, 0x142, 0xa); v = DPP_ADD(v, 0x143, 0xc);
    return __builtin_bit_cast(float, __builtin_amdgcn_readlane(__builtin_bit_cast(int, v), 63));
}
__device__ __forceinline__ void store16_wt(void* p, u32x4 v) { asm volatile("global_store_dwordx4 %0, %1, off sc1\n\ts_nop 1" :: "v"(p), "v"(v) : "memory"); }
__device__ __forceinline__ void store16f_wt(void* p, f32x4 v) { asm volatile("global_store_dwordx4 %0, %1, off sc1\n\ts_nop 1" :: "v"(p), "v"(v) : "memory"); }
__device__ __forceinline__ float gelu_tanh(float y) {
    const float u = 0.7978845608028654f * (y + 0.044715f * y * y * y);
    const float e = __expf(2.f * u);
    const float th = 1.f - 2.f / (e + 1.f);
    return 0.5f * y * (1.f + th);
}
__device__ __forceinline__ float sigmoidf_(float z) { return 1.f / (1.f + __expf(-z)); }

struct Ptrs {
    const float *x, *ln1_g, *w_in, *lam_re, *lam_im, *log_dt, *b_re, *b_im, *c_re, *c_im, *d_skip, *w_glu, *gn_attn, *gn_ssm, *w_out, *ln2_g,
        *w_rg, *b_rg, *w_re, *b_re_, *w_gate, *w_up, *w_down, *final_g;
    float* out; unsigned char* ws;
};

__device__ __forceinline__ void unpack8(const u32x4 q, float (&o)[8]) { o[0] = bf2f(q.x & 0xffffu); o[1] = bf2f(q.x >> 16); o[2] = bf2f(q.y & 0xffffu); o[3] = bf2f(q.y >> 16); o[4] = bf2f(q.z & 0xffffu); o[5] = bf2f(q.z >> 16); o[6] = bf2f(q.w & 0xffffu); o[7] = bf2f(q.w >> 16); }
__device__ __forceinline__ void p0_transpose_item(const float* W, int N, const float* gain, bf16* WT, int K, LAS float* scr, int kb, int nb, int dst_row0, int lane) {
    const int k0 = 64 * kb, n0 = 32 * nb;
    const float* wp = W + (size_t)(k0 + (lane >> 5)) * N + n0 + (lane & 31);
    float v[32];
#pragma unroll
    for (int i = 0; i < 32; ++i) v[i] = wp[(size_t)(2 * i) * N];
    const int c = lane & 7;
    f32x4 g0 = (f32x4){1.f, 1.f, 1.f, 1.f}, g1 = g0;
    if (gain) { g0 = *(const f32x4*)(gain + k0 + 8 * c); g1 = *(const f32x4*)(gain + k0 + 8 * c + 4); }
#pragma unroll
    for (int i = 0; i < 32; ++i) scr[(2 * i + (lane >> 5)) * 33 + (lane & 31)] = v[i];
    asm volatile("s_waitcnt lgkmcnt(0)" ::: "memory");
#pragma unroll
    for (int j = 0; j < 4; ++j) { const int n = (lane >> 3) + 8 * j; const LAS float* s = scr + (8 * c) * 33 + n;
        u32x4 o; o.x = pk2(s[0 * 33] * g0[0], s[1 * 33] * g0[1]); o.y = pk2(s[2 * 33] * g0[2], s[3 * 33] * g0[3]); o.z = pk2(s[4 * 33] * g1[0], s[5 * 33] * g1[1]); o.w = pk2(s[6 * 33] * g1[2], s[7 * 33] * g1[3]);
        *(u32x4*)(WT + (size_t)(dst_row0 + n) * K + k0 + 8 * c) = o; }
    asm volatile("s_waitcnt lgkmcnt(0)" ::: "memory");
}
constexpr int IT_WIN = (DM / 64) * (INW / 32);
constexpr int IT_WGLU = (SW / 64) * (SW / 32);
constexpr int IT_WOUT = (DM / 64) * (DM / 32);
constexpr int IT_WG = (DM / 64) * (EFF / 32);
constexpr int IT_WDN = (EFF / 64) * (DM / 32);
constexpr int IT_PER_LAYER = IT_WIN + IT_WGLU + IT_WOUT + NE * (2 * IT_WG + IT_WDN);
constexpr int IT_TOTAL = NL * IT_PER_LAYER;
__device__ __forceinline__ void p0_transposes(const Ptrs& P, LAS float* scr, int gw, int ngw, int lane) {
    unsigned char* ws = P.ws;
#pragma unroll 1
    for (int it = gw; it < IT_TOTAL; it += ngw) {
        const int l = it / IT_PER_LAYER; int r = it % IT_PER_LAYER;
        if (r < IT_WIN) { const int nblk = INW / 32; p0_transpose_item(P.w_in + (size_t)l * DM * INW, INW, P.ln1_g + l * DM, (bf16*)(ws + WS_WIN) + (size_t)l * INW * DM, DM, scr, r / nblk, r % nblk, 32 * (r % nblk), lane); continue; }
        r -= IT_WIN;
        if (r < IT_WGLU) { const int nblk = SW / 32; p0_transpose_item(P.w_glu + (size_t)l * SW * SW, SW, nullptr, (bf16*)(ws + WS_WGLU) + (size_t)l * SW * SW, SW, scr, r / nblk, r % nblk, 32 * (r % nblk), lane); continue; }
        r -= IT_WGLU;
        if (r < IT_WOUT) { const int nblk = DM / 32; const int kb = r / nblk; const float* g = (kb < 8) ? (P.gn_attn + l * AW) : (P.gn_ssm + l * SW - AW);
            p0_transpose_item(P.w_out + (size_t)l * DM * DM, DM, g, (bf16*)(ws + WS_WOUT) + (size_t)l * DM * DM, DM, scr, kb, r % nblk, 32 * (r % nblk), lane); continue; }
        r -= IT_WOUT;
        const int e = r / (2 * IT_WG + IT_WDN); r %= (2 * IT_WG + IT_WDN);
        if (r < 2 * IT_WG) { const int up = r / IT_WG; r %= IT_WG; const int nblk = EFF / 32; const int kb = r / nblk, nb = r % nblk; const int f0 = 32 * nb;
            const float* src = (up ? P.w_up : P.w_gate) + ((size_t)l * NE + e) * DM * EFF;
            bf16* dst = (bf16*)(ws + WS_WGU) + ((size_t)l * NE + e) * 512 * DM;
            p0_transpose_item(src, EFF, P.ln2_g + l * DM, dst, DM, scr, kb, nb, (f0 / 128) * 256 + up * 128 + (f0 % 128), lane); continue; }
        r -= 2 * IT_WG;
        { const int nblk = DM / 32; p0_transpose_item(P.w_down + ((size_t)l * NE + e) * EFF * DM, DM, nullptr, (bf16*)(ws + WS_WD) + ((size_t)l * NE + e) * DM * EFF, EFF, scr, r / nblk, r % nblk, 32 * (r % nblk), lane); }
    }
}

__device__ __forceinline__ void p0_tables_item(const Ptrs& P, int lg, int half, LAS float* scr, int tid, int nthr) {
    typedef float f32x2 __attribute__((ext_vector_type(2)));
    LAS f32x2* pw = (LAS f32x2*)scr; LAS f32x2* Bb = pw + 33 * 64; LAS f32x2* Cc = Bb + 64 * 16;
    const int l = lg / NG, g = lg % NG;
    const float dt = expf(P.log_dt[lg]);
    const float* lre = P.lam_re + (size_t)lg * NP; const float* lim = P.lam_im + (size_t)lg * NP;
#pragma unroll 1
    for (int i = tid; i < 33 * 64; i += nthr) { const int tau = i / 64, p = i % 64;
        const float a = lre[p] * dt * (float)tau; const float turns = lim[p] * dt * 0.15915494309189535f;
        const float xh = (float)tau * turns, xl = fmaf((float)tau, turns, -xh); const float fr = (xh - rintf(xh)) + xl;
        float sn, cs; sincosf(6.283185307179586f * fr, &sn, &cs); const float mg = expf(a);
        pw[i] = (f32x2){mg * cs, mg * sn}; }
#pragma unroll 1
    for (int i = tid; i < 64 * 16; i += nthr) { const int p = i / 16, h = i % 16;
        const float a = lre[p] * dt, th = lim[p] * dt; float sn, cs; sincosf(th, &sn, &cs); float sh, ch; sincosf(0.5f * th, &sh, &ch); (void)ch;
        const float em1 = expm1f(a), ea = em1 + 1.f;
        const float nr = em1 * cs - 2.f * sh * sh, ni = ea * sn;
        const float c = lre[p], d = lim[p], den = 1.f / (c * c + d * d);
        const float qr = (nr * c + ni * d) * den, qi = (ni * c - nr * d) * den;
        const float br = P.b_re[((size_t)lg * NP + p) * GC + h], bi = P.b_im[((size_t)lg * NP + p) * GC + h];
        Bb[i] = (f32x2){qr * br - qi * bi, qr * bi + qi * br}; }
#pragma unroll 1
    for (int i = tid; i < 16 * 64; i += nthr) { const int h = i / 64, p = i % 64;
        Cc[i] = (f32x2){P.c_re[((size_t)lg * GC + h) * NP + p], P.c_im[((size_t)lg * GC + h) * NP + p]}; }
    __syncthreads();
    unsigned char* ws = P.ws;
    bf16* Bb2 = (bf16*)(ws + WS_BB2) + (size_t)lg * 128 * 32;
    bf16* Ccm = (bf16*)(ws + WS_CC) + (size_t)lg * 16 * 128;
    bf16* Kt = (bf16*)(ws + WS_KTAB) + (size_t)lg * 33 * 256;
    float* Lams = (float*)(ws + WS_LAMS) + (size_t)lg * 64 * 6;
    if (half == 0)
#pragma unroll 1
    for (int i = tid; i < 128 * 32; i += nthr) { const int row = i >> 5, col = i & 31; const int p = row >> 1, cc = row & 1, h = col & 15; f32x2 b = Bb[p * 16 + h];
        if (col < 16) { const f32x2 w = pw[64 + p]; b = (f32x2){w.x * b.x - w.y * b.y, w.x * b.y + w.y * b.x}; }
        Bb2[i] = (bf16)f2bf(cc ? b.y : b.x); }
    if (half == 1)
#pragma unroll 1
    for (int i = tid; i < 16 * 128; i += nthr) { const int h = i >> 7, st = i & 127; const f32x2 c = Cc[h * 64 + (st >> 1)]; Ccm[i] = (bf16)f2bf((st & 1) ? -c.y : c.x); }
#pragma unroll 1
    for (int i = (half ? 17 * 256 : 0) + tid; i < (half ? 33 * 256 : 17 * 256); i += nthr) { const int t1 = i / 256, h = (i >> 4) & 15, hp = i & 15; float sacc = 0.f;
        if (t1 > 0) { const int tau = t1 - 1;
            for (int p = 0; p < 64; ++p) { const f32x2 c = Cc[h * 64 + p], w = pw[tau * 64 + p], b = Bb[p * 16 + hp]; const float cr = c.x * w.x - c.y * w.y, ci = c.x * w.y + c.y * w.x; sacc += cr * b.x - ci * b.y; }
            if (tau == 0 && h == hp) sacc += P.d_skip[(size_t)lg * GC + h]; }
        Kt[i] = (bf16)f2bf(sacc); }
    if (half == 1)
#pragma unroll 1
    for (int i = tid; i < 64; i += nthr) { const f32x2 w1 = pw[64 + i], w2 = pw[128 + i], w32 = pw[32 * 64 + i]; float* o = Lams + i * 6; o[0] = w1.x; o[1] = w1.y; o[2] = w2.x; o[3] = w2.y; o[4] = w32.x; o[5] = w32.y; }
    __syncthreads();
    (void)l; (void)g;
}

__device__ __forceinline__ void route_build_lds(const Ptrs& P, int l, LAS f32x4* GW, int tid) {
    for (int idx = tid; idx < 5 * DM; idx += MKT) { const int ep = idx >> 10, k = idx & 1023; const int j = k >> 9, c = k & 7, ln = (k & 511) >> 3;
        const float g = P.ln2_g[l * DM + k];
        const f32x4 w = ep == 0 ? *(const f32x4*)(P.w_rg + ((size_t)l * DM + k) * 4) : *(const f32x4*)(P.w_re + (((size_t)l * 4 + (ep - 1)) * DM + k) * 4);
        GW[((ep * 2 + j) * 8 + c) * 64 + ln] = w * g; }
    __syncthreads();
}
template <int NR> __device__ __forceinline__ void route_rows(const Ptrs& P, int l, const int r0, const int rstride, int lane, const LAS f32x4* GW, const u32x4 (&raw)[NR][2], unsigned* troute, f32x4* tw, LAS int* lcnt) {
    float v[NR][2][8]; float rstd[NR];
#pragma unroll
    for (int q = 0; q < NR; ++q) {
#pragma unroll
        for (int j = 0; j < 2; ++j) unpack8(raw[q][j], v[q][j]); }
#pragma unroll
    for (int q = 0; q < NR; ++q) { float s = 0.f;
#pragma unroll
        for (int j = 0; j < 2; ++j)
#pragma unroll
            for (int c = 0; c < 8; ++c) s += v[q][j][c] * v[q][j][c];
        rstd[q] = 1.f / sqrtf(wave_sum(s, lane) * (1.f / DM) + RMS_EPS); }
    f32x4 acc[NR];
#pragma unroll
    for (int q = 0; q < NR; ++q) acc[q] = (f32x4){0.f, 0.f, 0.f, 0.f};
#pragma unroll
    for (int j = 0; j < 2; ++j)
#pragma unroll
        for (int c = 0; c < 8; ++c) { const f32x4 w = GW[(j * 8 + c) * 64 + lane];
#pragma unroll
            for (int q = 0; q < NR; ++q) acc[q] += v[q][j][c] * w; }
    int grp[NR]; float g1[NR];
#pragma unroll
    for (int q = 0; q < NR; ++q) { float gl[4];
#pragma unroll
        for (int e = 0; e < 4; ++e) gl[e] = wave_sum(acc[q][e], lane) * rstd[q] + P.b_rg[l * 4 + e];
        int gi = 0; float gm = gl[0];
#pragma unroll
        for (int e = 1; e < 4; ++e) if (gl[e] > gm) { gm = gl[e]; gi = e; }
        float gs = 0.f;
#pragma unroll
        for (int e = 0; e < 4; ++e) gs += expf(gl[e] - gm);
        grp[q] = gi; g1[q] = 1.f / gs; acc[q] = (f32x4){0.f, 0.f, 0.f, 0.f}; }
#pragma unroll
    for (int j = 0; j < 2; ++j)
#pragma unroll
        for (int c = 0; c < 8; ++c)
#pragma unroll
            for (int q = 0; q < NR; ++q) acc[q] += v[q][j][c] * GW[(((1 + grp[q]) * 2 + j) * 8 + c) * 64 + lane];
#pragma unroll
    for (int q = 0; q < NR; ++q) { float el[4];
#pragma unroll
        for (int e = 0; e < 4; ++e) el[e] = wave_sum(acc[q][e], lane) * rstd[q] + P.b_re_[(l * 4 + grp[q]) * 4 + e];
        int i1 = 0; float v1 = el[0];
#pragma unroll
        for (int e = 1; e < 4; ++e) if (el[e] > v1) { v1 = el[e]; i1 = e; }
        int i2 = -1; float v2 = -INFINITY;
#pragma unroll
        for (int e = 0; e < 4; ++e) if (e != i1 && el[e] > v2) { v2 = el[e]; i2 = e; }
        const float e2 = expf(v2 - v1); const float w1 = g1[q] / (1.f + e2), w2 = g1[q] * e2 / (1.f + e2);
        const int a = i1 < i2 ? i1 : i2, b = i1 < i2 ? i2 : i1; const float wa = i1 < i2 ? w1 : w2, wb = i1 < i2 ? w2 : w1;
        const int pair = (a == 0) ? (b - 1) : (a == 1 ? (b + 1) : 5);
        const int cls = grp[q] * 6 + pair; const int row = r0 + q * rstride;
        if (lane == 0) {
            const int lslot = __hip_atomic_fetch_add(lcnt + cls, 1, __ATOMIC_RELAXED, __HIP_MEMORY_SCOPE_WORKGROUP);
            troute[row] = (unsigned)(grp[q] * 4 + a) | ((unsigned)(grp[q] * 4 + b) << 8) | ((unsigned)cls << 16) | ((unsigned)lslot << 24);
            tw[row] = (f32x4){wa, wb, rstd[q], 0.f};
        } }
}

__device__ __forceinline__ void mix_row_attn(int row, int lane, const bf16* OB, const float* LSE, bf16* AB) {
    const int h = lane >> 3;
    float ls[3], m = -INFINITY;
#pragma unroll
    for (int b = 0; b < 3; ++b) { ls[b] = LSE[((size_t)b * NT + row) * NH + h]; m = fmaxf(m, ls[b]); }
    float w[3], ws_ = 0.f;
#pragma unroll
    for (int b = 0; b < 3; ++b) { w[b] = expf(ls[b] - m); ws_ += w[b]; }
    float o[8];
#pragma unroll
    for (int i = 0; i < 8; ++i) o[i] = 0.f;
#pragma unroll
    for (int b = 0; b < 3; ++b) { const u32x4 q = *((const u32x4*)(OB + ((size_t)b * NT + row) * AW) + lane); const float wb = w[b] / ws_;
        o[0] += wb * bf2f(q.x & 0xffffu); o[1] += wb * bf2f(q.x >> 16); o[2] += wb * bf2f(q.y & 0xffffu); o[3] += wb * bf2f(q.y >> 16);
        o[4] += wb * bf2f(q.z & 0xffffu); o[5] += wb * bf2f(q.z >> 16); o[6] += wb * bf2f(q.w & 0xffffu); o[7] += wb * bf2f(q.w >> 16); }
    float s = 0.f;
#pragma unroll
    for (int i = 0; i < 8; ++i) s += o[i] * o[i];
    const float rstd = 1.f / sqrtf(wave_sum(s, lane) * (1.f / AW) + RMS_EPS);
    *((u32x4*)(AB + (size_t)row * DM) + lane) = (u32x4){pk2(o[0] * rstd, o[1] * rstd), pk2(o[2] * rstd, o[3] * rstd), pk2(o[4] * rstd, o[5] * rstd), pk2(o[6] * rstd, o[7] * rstd)};
}
namespace pg8 {
typedef short bf16x8 __attribute__((ext_vector_type(8)));
constexpr int BM = 256, BK = 64, HALF = 128, HTB = HALF * BK * 2, STAGE_BYTES = 8 * HTB, NXCD = 8, WGM = 8;
__host__ __device__ __forceinline__ int lds_byte(int r, int c) { const int st = (r >> 4) * 2 + (c >> 5), rr = r & 15, cc = c & 31, ob = rr * 64 + cc * 2; return st * 1024 + (ob ^ (((ob >> 9) & 1) << 5)); }
__host__ __device__ __forceinline__ void stage_rc(int b, int& R, int& C) { const int st = b / 1024, sb = b % 1024, swz = sb ^ (((sb >> 9) & 1) << 5); R = (st >> 1) * 16 + swz / 64; C = (st & 1) * 32 + (swz % 64) / 2; }
__host__ __device__ __forceinline__ int perm32(int rho) { const int n = rho >> 4, i = rho & 15; return 8 * (i >> 2) + 4 * n + (i & 3); }
struct Unit { int pm, pn; const char* a; const char* b; int x0, x1, x2, fl; };
__device__ __forceinline__ bool static_order(int nM, int nN, int G, int c, int i, int& pm, int& pn) {
    const int nwg = nM * nN; const long L = (long)i * G + c; if (L >= nwg) return false;
    int wgid = (int)L; { const int q = nwg / NXCD, r = nwg % NXCD, xcd = wgid % NXCD, off = wgid / NXCD; wgid = (xcd < r ? xcd * (q + 1) : r * (q + 1) + (xcd - r) * q) + off; }
    const int nig = WGM * nN, gid = wgid / nig, fm = gid * WGM, gsz = (nM - fm) < WGM ? (nM - fm) : WGM;
    pm = fm + ((wgid % nig) % gsz); pn = (wgid % nig) / gsz; return true;
}
__device__ __forceinline__ unsigned cvt_pk_bf16(float lo, float hi) { unsigned r; asm volatile("v_cvt_pk_bf16_f32 %0, %1, %2" : "=v"(r) : "v"(lo), "v"(hi)); return r; }
template <class Epi, class Sched, bool GATHER, bool ALIGN_EPI>
__device__ __forceinline__ void gemm_phase(const int tid, LAS unsigned char* lds, const int lda, const int ldb, const int K, const Sched& S, const Epi& E, const size_t kstepA = (size_t)(BK * 2)) {
    const int wid = __builtin_amdgcn_readfirstlane(tid >> 6), lane = tid & 63, wr = wid >> 2, wc = wid & 3, fr = lane & 15, fq = lane >> 4;
    const int nt = K / BK;
    int Rr[2], Cc[2]; unsigned voffB[2], cvA0[2], cvA1[2], nvA0[2], nvA1[2];
#pragma unroll
    for (int i = 0; i < 2; ++i) { stage_rc(tid * 16 + i * 8192, Rr[i], Cc[i]); const int Rb = Epi::PERM ? ((Rr[i] & ~31) + perm32(Rr[i] & 31)) : Rr[i]; voffB[i] = (unsigned)(Rb * ldb + Cc[i]) * 2u; }
    const size_t kstep = (size_t)(BK * 2);
    const size_t hstepB = (size_t)HALF * ldb * 2;
    const unsigned ldsw = (unsigned)wid * 1024u;
    const int aoff = lds_byte(wr * 64 + fr, fq * 8), boff = lds_byte(wc * 32 + fr, fq * 8);
#define PG8_SA(b, h) (((b) * 2 + (h)) * HTB)
#define PG8_SB(b, h) ((4 + (b) * 2 + (h)) * HTB)
#define PG8_STAGE(bufoff, gbase, voff) do { _Pragma("unroll") for (int _i = 0; _i < 2; ++_i) \
        __builtin_amdgcn_global_load_lds((const unsigned*)((const char*)(gbase) + (voff)[_i]), (LAS unsigned*)(lds + (bufoff) + ldsw + _i * 8192), 16, 0, 0); } while (0)
#define PG8_LDA(dst, b, h) do { _Pragma("unroll") for (int m = 0; m < 4; ++m) _Pragma("unroll") for (int k = 0; k < 2; ++k) dst[m][k] = *(const LAS bf16x8*)(lds + PG8_SA(b, h) + aoff + m * 2048 + k * 1024); } while (0)
#define PG8_LDB(dst, b, h) do { _Pragma("unroll") for (int n = 0; n < 2; ++n) _Pragma("unroll") for (int k = 0; k < 2; ++k) dst[n][k] = *(const LAS bf16x8*)(lds + PG8_SB(b, h) + boff + n * 2048 + k * 1024); } while (0)
#define PG8_MMA(ai, bj, At, Bt) do { __builtin_amdgcn_s_setprio(1); _Pragma("unroll") for (int m = 0; m < 4; ++m) _Pragma("unroll") for (int n = 0; n < 2; ++n) _Pragma("unroll") for (int k = 0; k < 2; ++k) \
        acc[ai][bj][m][n] = __builtin_amdgcn_mfma_f32_16x16x32_bf16(Bt[n][k], At[m][k], acc[ai][bj][m][n], 0, 0, 0); __builtin_amdgcn_s_setprio(0); } while (0)
#define PG8_WAIT_V(n) asm volatile("s_waitcnt vmcnt(" #n ")" ::: "memory")
#define PG8_WAIT_L(n) asm volatile("s_waitcnt lgkmcnt(" #n ")" ::: "memory")
#define PG8_BAR __builtin_amdgcn_s_barrier()
#define PG8_SCHED __builtin_amdgcn_sched_barrier(0)
#define PG8_BP(u, tile) ((u).b + (size_t)(tile) * kstep)
#define PG8_SETA(u, v0, v1) do { _Pragma("unroll") for (int _i = 0; _i < 2; ++_i) { v0[_i] = S.aoff(u, Rr[_i], Cc[_i], lda); v1[_i] = S.aoff(u, HALF + Rr[_i], Cc[_i], lda); } } while (0)
    Unit cur, nxt; int ui = 0;
    if (!S.next(0, cur)) return;
    S.a_ready(cur);
    PG8_SETA(cur, cvA0, cvA1);
    f32x4 acc[2][2][4][2];
#pragma unroll
    for (int a = 0; a < 2; ++a)
#pragma unroll
        for (int b = 0; b < 2; ++b)
#pragma unroll
            for (int m = 0; m < 4; ++m)
#pragma unroll
                for (int n = 0; n < 2; ++n) acc[a][b][m][n] = (f32x4){0.f, 0.f, 0.f, 0.f};
    bf16x8 At[4][2], B0[2][2], B1[2][2];
    {   const char* cB = PG8_BP(cur, 0); const char* cB1 = PG8_BP(cur, 1);
        PG8_STAGE(PG8_SB(0, 0), cB, voffB); PG8_STAGE(PG8_SB(0, 1), cB + hstepB, voffB); PG8_STAGE(PG8_SA(0, 0), cur.a, cvA0); PG8_STAGE(PG8_SA(0, 1), cur.a, cvA1);
        if (wr == 1) PG8_BAR;
        PG8_WAIT_V(2); PG8_BAR;
        PG8_STAGE(PG8_SB(1, 0), cB1, voffB); PG8_STAGE(PG8_SA(1, 0), cur.a + kstepA, cvA0); PG8_STAGE(PG8_SB(1, 1), cB1 + hstepB, voffB);
        PG8_WAIT_V(6); PG8_BAR; }
    for (;;) {
        const bool has_next = S.next(ui + 1, nxt);
        if (has_next) { S.a_ready(nxt); PG8_SETA(nxt, nvA0, nvA1); } else {
#pragma unroll
            for (int i = 0; i < 2; ++i) { nvA0[i] = cvA0[i]; nvA1[i] = cvA1[i]; } }
        const char* nA = has_next ? nxt.a : cur.a; const char* nB = has_next ? PG8_BP(nxt, 0) : PG8_BP(cur, 0);
        for (int t = 0; t < nt; t += 2) {
            const bool last = (t == nt - 2);
            const char* a1 = cur.a + (size_t)(t + 1) * kstepA;
            const char* a2 = last ? nA : cur.a + (size_t)(t + 2) * kstepA; const char* b2 = last ? nB : PG8_BP(cur, t + 2);
            const char* a3 = a2 + kstepA; const char* b3 = b2 + kstep;
            unsigned vo0[2], vo1[2];
#pragma unroll
            for (int i = 0; i < 2; ++i) { vo0[i] = last ? nvA0[i] : cvA0[i]; vo1[i] = last ? nvA1[i] : cvA1[i]; }
            PG8_LDB(B0, 0, 0); PG8_LDB(B1, 0, 1); PG8_SCHED; PG8_LDA(At, 0, 0); PG8_STAGE(PG8_SA(1, 1), a1, cvA1);
            PG8_WAIT_V(8); PG8_WAIT_L(0); PG8_BAR; PG8_MMA(0, 0, At, B0); PG8_MMA(0, 1, At, B1); PG8_BAR; PG8_SCHED;
            PG8_LDA(At, 0, 1); PG8_STAGE(PG8_SB(0, 0), b2, voffB); PG8_STAGE(PG8_SB(0, 1), b2 + hstepB, voffB); PG8_STAGE(PG8_SA(0, 0), a2, vo0);
            PG8_WAIT_V(8); PG8_WAIT_L(0); PG8_BAR; PG8_MMA(1, 0, At, B0); PG8_MMA(1, 1, At, B1); PG8_BAR; PG8_SCHED;
            PG8_LDB(B0, 1, 0); PG8_LDB(B1, 1, 1); PG8_SCHED; PG8_LDA(At, 1, 0); PG8_STAGE(PG8_SA(0, 1), a2, vo1);
            PG8_WAIT_V(8); PG8_WAIT_L(0); PG8_BAR; PG8_MMA(0, 0, At, B0); PG8_MMA(0, 1, At, B1); PG8_BAR; PG8_SCHED;
            PG8_LDA(At, 1, 1); PG8_STAGE(PG8_SB(1, 0), b3, voffB); PG8_STAGE(PG8_SB(1, 1), b3 + hstepB, voffB); PG8_STAGE(PG8_SA(1, 0), a3, vo0);
            PG8_WAIT_V(8); PG8_WAIT_L(0); PG8_BAR; PG8_MMA(1, 0, At, B0); PG8_MMA(1, 1, At, B1); PG8_BAR; PG8_SCHED;
        }
        const bool epi = (cur.fl & 2) != 0;
        if (epi) {
            if constexpr (ALIGN_EPI) { if (wr == 0) PG8_BAR; }
            { int t2 = tid; asm volatile("" : "+v"(t2));
              const int w2 = __builtin_amdgcn_readfirstlane(t2 >> 6), l2 = t2 & 63; E(acc, cur, w2 >> 2, w2 & 3, l2 & 15, l2 >> 4); S.done(cur, l2); }
        }
        if (!epi) { int t2 = tid; asm volatile("" : "+v"(t2)); const int w2 = __builtin_amdgcn_readfirstlane(t2 >> 6), l2 = t2 & 63; E.mid(acc, cur, w2 >> 2, w2 & 3, l2 & 15, l2 >> 4); }
        if (!has_next) break;
        if (nxt.fl & 1) {
#pragma unroll
            for (int a = 0; a < 2; ++a)
#pragma unroll
                for (int b = 0; b < 2; ++b)
#pragma unroll
                    for (int m = 0; m < 4; ++m)
#pragma unroll
                        for (int n = 0; n < 2; ++n) acc[a][b][m][n] = (f32x4){0.f, 0.f, 0.f, 0.f};
        }
        cur = nxt; ++ui;
#pragma unroll
        for (int i = 0; i < 2; ++i) { cvA0[i] = nvA0[i]; cvA1[i] = nvA1[i]; }
        if (epi) { if constexpr (ALIGN_EPI) { if (wr == 1) PG8_BAR; } }
    }
    PG8_WAIT_V(0);
    if constexpr (!ALIGN_EPI) { if (wr == 0) PG8_BAR; }
    PG8_BAR;
#undef PG8_SA
#undef PG8_SB
#undef PG8_STAGE
#undef PG8_LDA
#undef PG8_LDB
#undef PG8_MMA
#undef PG8_WAIT_V
#undef PG8_WAIT_L
#undef PG8_BAR
#undef PG8_SCHED
#undef PG8_BP
#undef PG8_SETA
}

struct DenseSched {
    const char* A; const char* Bt; int nM, nN, G, c; size_t atile, btile;
    __device__ __forceinline__ bool next(int i, Unit& u) const { int pm, pn; if (!static_order(nM, nN, G, c, i, pm, pn)) return false;
        u.pm = pm; u.pn = pn; u.a = A + (size_t)pm * atile; u.b = Bt + (size_t)pn * btile; u.x0 = u.x1 = u.x2 = 0; u.fl = 3; return true; }
    __device__ __forceinline__ unsigned aoff(const Unit&, int r, int c, int lda) const { return (unsigned)(r * lda + c) * 2u; }
    __device__ __forceinline__ void a_ready(const Unit&) const {}
    __device__ __forceinline__ void done(const Unit&, int) const {}
};
struct InSched {
    const char* A; const char* Bt; int nM, nN, G, c; size_t atile, btile; const float* ss; LAS float* tab;
    __device__ __forceinline__ bool next(int i, Unit& u) const { int pm, pn; if (!static_order(nM, nN, G, c, i, pm, pn)) return false;
        u.pm = pm; u.pn = pn; u.a = A + (size_t)pm * atile; u.b = Bt + (size_t)pn * btile; u.x0 = i & 1; u.x1 = u.x2 = 0; u.fl = 3; return true; }
    __device__ __forceinline__ unsigned aoff(const Unit&, int r, int c, int lda) const { return (unsigned)(r * lda + c) * 2u; }
    __device__ __forceinline__ void a_ready(const Unit& u) const {
        const int t = threadIdx.x;
        if (t < 256) { const f32x4* sp = (const f32x4*)(ss + (size_t)(u.pm * 256 + t) * 16); const f32x4 s4 = (sp[0] + sp[1]) + (sp[2] + sp[3]); tab[u.x0 * 256 + t] = 1.f / sqrtf(((s4[0] + s4[1]) + (s4[2] + s4[3])) * (1.f / DM) + RMS_EPS); }
        asm volatile("s_waitcnt lgkmcnt(0)" ::: "memory"); __builtin_amdgcn_s_barrier(); asm volatile("" ::: "memory");
    }
    __device__ __forceinline__ void done(const Unit&, int) const {}
};
struct GluSched {
    const char* A; const char* Bt; int nM, nN, G, c;
    __device__ __forceinline__ bool next(int i, Unit& u) const { int pm, pn; if (!static_order(nM, nN, G, c, i, pm, pn)) return false;
        u.pm = pm; u.pn = pn; u.a = A + (size_t)pm * 256 * 32; u.b = Bt + (size_t)pn * 256 * SW * 2; u.x0 = u.x1 = u.x2 = 0; u.fl = 3; return true; }
    __device__ __forceinline__ unsigned aoff(const Unit&, int r, int c, int) const { return (unsigned)((c >> 4) * NT + r) * 32u + (unsigned)(c & 15) * 2u; }
    __device__ __forceinline__ void a_ready(const Unit&) const {}
    __device__ __forceinline__ void done(const Unit&, int) const {}
};
struct EpiStoreBf16 {
    static constexpr bool PERM = true; bf16* C; int ldc; const LAS float* tab; bf16* UGM;
    __device__ __forceinline__ void mid(f32x4 (&)[2][2][4][2], const Unit&, int, int, int, int) const {}
    __device__ __forceinline__ void operator()(const f32x4 (&acc)[2][2][4][2], const Unit& u, int wr, int wc, int fr, int fq) const {
        const int row0 = u.pm * BM + wr * 64 + fr, col0 = u.pn * BM + wc * 32 + 8 * fq; const bool isu = col0 >= 3 * AW; const LAS float* tp = tab + u.x0 * 256 + wr * 64 + fr;
#pragma unroll
        for (int ai = 0; ai < 2; ++ai)
#pragma unroll
            for (int m = 0; m < 4; ++m) { const int row = row0 + ai * HALF + m * 16; const float r = tp[ai * HALF + m * 16];
#pragma unroll
                for (int bj = 0; bj < 2; ++bj) { const f32x4 v0 = acc[ai][bj][m][0] * r, v1 = acc[ai][bj][m][1] * r; const int col = col0 + bj * HALF;
                    bf16* dst = isu ? UGM + ((size_t)((col - 3 * AW) >> 4) * NT + row) * 16 + (col & 15) : C + (size_t)row * ldc + col;
                    store16_wt(dst, (u32x4){cvt_pk_bf16(v0[0], v0[1]), cvt_pk_bf16(v0[2], v0[3]), cvt_pk_bf16(v1[0], v1[1]), cvt_pk_bf16(v1[2], v1[3])}); } }
    }
};
struct EpiGlu {
    static constexpr bool PERM = true; bf16* C; const bf16* aux; int ldc; float* SSG;
    __device__ __forceinline__ void mid(f32x4 (&)[2][2][4][2], const Unit&, int, int, int, int) const {}
    __device__ __forceinline__ void operator()(const f32x4 (&acc)[2][2][4][2], const Unit& u, int wr, int wc, int fr, int fq) const {
        const int row0 = u.pm * BM + wr * 64 + fr, col0 = u.pn * BM + wc * 32 + 8 * fq; const int lane = fr + 16 * fq;
#pragma unroll
        for (int ai = 0; ai < 2; ++ai) { u32x4 yv[4][2];
#pragma unroll
            for (int m = 0; m < 4; ++m)
#pragma unroll
                for (int bj = 0; bj < 2; ++bj) { const int col_ = col0 + bj * HALF; yv[m][bj] = *(const u32x4*)(aux + ((size_t)(col_ >> 4) * NT + (row0 + ai * HALF + m * 16)) * 16 + (col_ & 15)); }
#pragma unroll
            for (int m = 0; m < 4; ++m) { const int row = row0 + ai * HALF + m * 16; const size_t ro = (size_t)row * ldc + col0; float ssq = 0.f;
#pragma unroll
                for (int bj = 0; bj < 2; ++bj) { const f32x4 v0 = acc[ai][bj][m][0], v1 = acc[ai][bj][m][1]; float y[8]; unpack8(yv[m][bj], y);
                    float r[8]; r[0] = y[0] * sigmoidf_(v0[0]); r[1] = y[1] * sigmoidf_(v0[1]); r[2] = y[2] * sigmoidf_(v0[2]); r[3] = y[3] * sigmoidf_(v0[3]);
                    r[4] = y[4] * sigmoidf_(v1[0]); r[5] = y[5] * sigmoidf_(v1[1]); r[6] = y[6] * sigmoidf_(v1[2]); r[7] = y[7] * sigmoidf_(v1[3]);
                    const u32x4 o = (u32x4){cvt_pk_bf16(r[0], r[1]), cvt_pk_bf16(r[2], r[3]), cvt_pk_bf16(r[4], r[5]), cvt_pk_bf16(r[6], r[7])}; float rb[8]; unpack8(o, rb);
#pragma unroll
                    for (int e = 0; e < 8; ++e) ssq += rb[e] * rb[e];
                    *(u32x4*)(C + ro + bj * HALF) = o; }
                ssq += lane_xor(ssq, lane, 16); ssq += lane_xor(ssq, lane, 32);
                if (fq == 0) SSG[(size_t)row * 8 + u.pn * 4 + wc] = ssq; }
            asm volatile("" ::: "memory"); }
    }
};
struct EpiResid {
    static constexpr bool PERM = true; bf16* XB; int ldc; const LAS float* tab;
    __device__ __forceinline__ void mid(f32x4 (&acc)[2][2][4][2], const Unit& u, int wr, int wc, int fr, int fq) const {
        const LAS float* tp = tab + u.x0 * 256 + wr * 64 + fr; (void)wc; (void)fq;
#pragma unroll
        for (int ai = 0; ai < 2; ++ai)
#pragma unroll
            for (int m = 0; m < 4; ++m) { const float irs = tp[ai * HALF + m * 16];
#pragma unroll
                for (int bj = 0; bj < 2; ++bj)
#pragma unroll
                    for (int n = 0; n < 2; ++n) acc[ai][bj][m][n] *= irs; }
    }
    __device__ __forceinline__ void operator()(const f32x4 (&acc)[2][2][4][2], const Unit& u, int wr, int wc, int fr, int fq) const {
        const int row0 = u.pm * BM + wr * 64 + fr, col0 = u.pn * BM + wc * 32 + 8 * fq; const LAS float* tp = tab + u.x0 * 256 + wr * 64 + fr;
#pragma unroll
        for (int ai = 0; ai < 2; ++ai) { u32x4 xv[4][2];
#pragma unroll
            for (int m = 0; m < 4; ++m)
#pragma unroll
                for (int bj = 0; bj < 2; ++bj) xv[m][bj] = *(const u32x4*)(XB + (size_t)(row0 + ai * HALF + m * 16) * ldc + col0 + bj * HALF);
#pragma unroll
            for (int m = 0; m < 4; ++m) { const int row = row0 + ai * HALF + m * 16; const size_t ro = (size_t)row * ldc + col0; const float rs = 1.f / tp[ai * HALF + m * 16];
#pragma unroll
                for (int bj = 0; bj < 2; ++bj) { float b[8]; unpack8(xv[m][bj], b); const f32x4 a0 = acc[ai][bj][m][0] * rs, a1 = acc[ai][bj][m][1] * rs;
                    *(u32x4*)(XB + ro + bj * HALF) = (u32x4){cvt_pk_bf16(b[0] + a0[0], b[1] + a0[1]), cvt_pk_bf16(b[2] + a0[2], b[3] + a0[3]), cvt_pk_bf16(b[4] + a1[0], b[5] + a1[1]), cvt_pk_bf16(b[6] + a1[2], b[7] + a1[3])}; } }
            asm volatile("" ::: "memory"); }
    }
};
struct OutSched {
    const char* AB; const char* Wt; int G, c; const float* SSG; LAS float* tab;
    __device__ __forceinline__ bool next(int i, Unit& u) const { int pm, pn; if (!static_order(NT / 256, DM / 256, G, c, i >> 1, pm, pn)) return false; const int seg = i & 1;
        u.pm = pm; u.pn = pn; u.x0 = (i >> 1) & 1; u.x1 = u.x2 = 0; u.fl = seg ? 2 : 1;
        u.a = AB + (size_t)pm * 256 * DM * 2 + (seg ? AW * 2 : 0); u.b = Wt + (size_t)pn * 256 * DM * 2 + (seg ? AW * 2 : 0); return true; }
    __device__ __forceinline__ unsigned aoff(const Unit&, int r, int c, int lda) const { return (unsigned)(r * lda + c) * 2u; }
    __device__ __forceinline__ void a_ready(const Unit& u) const {
        if (!(u.fl & 1)) return;
        const int t = threadIdx.x;
        if (t < 256) { const f32x4* sp = (const f32x4*)(SSG + (size_t)(u.pm * 256 + t) * 8); const f32x4 s4 = sp[0] + sp[1]; tab[u.x0 * 256 + t] = sqrtf(((s4[0] + s4[1]) + (s4[2] + s4[3])) * (1.f / SW) + RMS_EPS); }
        asm volatile("s_waitcnt lgkmcnt(0)" ::: "memory"); __builtin_amdgcn_s_barrier(); asm volatile("" ::: "memory");
    }
    __device__ __forceinline__ void done(const Unit&, int) const {}
};
__device__ __forceinline__ void moe_build_prefix(const int tid, LAS int* tpre, unsigned* cnt) {
    __syncthreads();
    if (tid == 0) { int s = 0;
#pragma unroll 1
        for (int c = 0; c < NCLS; ++c) { const int n = (int)__hip_atomic_load(cnt + c, __ATOMIC_RELAXED, __HIP_MEMORY_SCOPE_AGENT); tpre[c] = s; tpre[32 + c] = n; const int nt_ = (n + 255) >> 8; for (int t = 0; t < nt_; ++t) tpre[256 + s + t] = c; s += nt_; } tpre[NCLS] = s; }
    __syncthreads();
}
__device__ __forceinline__ void pair_decode(int pair, int& a, int& b) { a = pair < 3 ? 0 : (pair < 5 ? 1 : 2); b = pair < 3 ? pair + 1 : (pair < 5 ? pair - 1 : 3); }
struct MoeSched {
    const LAS int* tpre; const int* ltok; const char* A; const char* W; int G, c, l, up; unsigned* ucnt; unsigned* tmo;
    __device__ __forceinline__ void fill(int pm, int pn, int seg, Unit& u) const {
        const int cls = __builtin_amdgcn_readfirstlane(tpre[256 + pm]);
        const int grp = cls / 6; int ea, eb; pair_decode(cls % 6, ea, eb); ea += grp * 4; eb += grp * 4;
        u.pm = pm; u.pn = pn; u.x0 = cls; u.x1 = (pm - __builtin_amdgcn_readfirstlane(tpre[cls])) * 256; u.x2 = __builtin_amdgcn_readfirstlane(tpre[32 + cls]);
        if (up) { const int e = pn < 2 ? ea : eb; u.a = A; u.b = W + ((size_t)((l * NE + e) * 2 + (pn & 1))) * 256 * DM * 2; u.fl = 3; }
        else { const int e = seg ? eb : ea; u.a = A + (size_t)pm * 256 * 512 * 2 + seg * (EFF * 2); u.b = W + ((size_t)(l * NE + e) * DM + pn * 256) * EFF * 2; u.fl = seg ? 2 : 1; }
    }
    __device__ __forceinline__ bool next(int i, Unit& u) const {
        const int MT = __builtin_amdgcn_readfirstlane(tpre[NCLS]);
        if (G == 256) {
            const int x = c & 7, j = c >> 3; const int cb0 = (x * MT) >> 3, cb1 = ((x + 1) * MT) >> 3; const int n4 = (cb1 - cb0 - 8) * 4;
            if (up) { int pm, pn;
                if (i == 0) { pm = cb0 + (j & 7); pn = j >> 3; }
                else if (i == 1 && j < n4) { pm = cb0 + 8 + (j >> 2); pn = j & 3; }
                else return false;
                fill(pm, pn, 0, u); return true; }
            const int jd = i >> 1, seg = i & 1; int pm, pn;
            if (j >= n4) { const int F = 32 - n4, e = (j - n4) + jd * F; if (e >= 32) return false; pm = cb0 + (e & 7); pn = e >> 3; }
            else { if (jd > 0) return false; pm = cb0 + 8 + (j >> 2); pn = j & 3; }
            fill(pm, pn, seg, u); return true;
        }
        const int E0 = G >> 2;
        const int R = (MT - E0) * 4;
        if (up) { int pm, pn;
            if (i == 0) { pm = (c & 7) + 8 * (c >> 5); pn = (c >> 3) & 3; }
            else { const int L2 = (i - 1) * G + c; if (L2 >= R) return false; pm = E0 + (L2 >> 2); pn = L2 & 3; }
            fill(pm, pn, 0, u); return true; }
        const int jd = i >> 1, seg = i & 1; int pm, pn;
        const int Rc = R < G ? R : G;
        if (c >= Rc) { const int F = G - Rc, e = (c - Rc) + jd * F; if (e >= G) return false; pm = (e & 7) + 8 * (e >> 5); pn = (e >> 3) & 3; }
        else { const int q = c + jd * G; if (q >= R) return false; pm = E0 + (q >> 2); pn = q & 3; }
        fill(pm, pn, seg, u); return true;
    }
    __device__ __forceinline__ unsigned aoff(const Unit& u, int r, int c, int lda) const {
        if (!up) return (unsigned)(r * lda + c) * 2u;
        int i = u.x1 + r; i = i < u.x2 ? i : u.x2 - 1; return (unsigned)ltok[(size_t)u.x0 * NT + i] * (unsigned)(DM * 2) + (unsigned)c * 2u; }
    __device__ __forceinline__ void a_ready(const Unit& u) const {
        if (up || !(u.fl & 1)) return;
        if (threadIdx.x < 64) { unsigned sp = 0;
            while ((unsigned)__builtin_amdgcn_readfirstlane((int)__hip_atomic_load(ucnt + u.pm, __ATOMIC_RELAXED, __HIP_MEMORY_SCOPE_AGENT)) < 32u) {
                __builtin_amdgcn_s_sleep(2);
                if ((++sp & 255u) == 0u) { if (__hip_atomic_load(tmo, __ATOMIC_RELAXED, __HIP_MEMORY_SCOPE_AGENT) != 0u) break; if (sp > (1u << 20)) { atomicAdd(tmo, 1u); break; } } }
            __builtin_amdgcn_fence(__ATOMIC_ACQUIRE, "agent");
            asm volatile("s_waitcnt vmcnt(0)" ::: "memory"); }
        asm volatile("" ::: "memory"); __builtin_amdgcn_s_barrier(); asm volatile("" ::: "memory");
    }
    __device__ __forceinline__ void done(const Unit& u, int lane) const {
        if (!up) return;
        asm volatile("s_waitcnt vmcnt(0)" ::: "memory");
        if (lane == 0) __hip_atomic_fetch_add(ucnt + u.pm, 1u, __ATOMIC_RELAXED, __HIP_MEMORY_SCOPE_AGENT);
    }
};
struct EpiMoeUp {
    static constexpr bool PERM = true; bf16* ACT; const f32x4* lw;
    __device__ __forceinline__ void mid(f32x4 (&)[2][2][4][2], const Unit&, int, int, int, int) const {}
    __device__ __forceinline__ void operator()(const f32x4 (&acc)[2][2][4][2], const Unit& u, int wr, int wc, int fr, int fq) const {
        const int col0 = (u.pn >> 1) * 256 + (u.pn & 1) * 128 + wc * 32 + 8 * fq;
        f32x4 lwq[8];
#pragma unroll
        for (int q = 0; q < 8; ++q) { int i = u.x1 + (q >> 2) * HALF + wr * 64 + (q & 3) * 16 + fr; i = i < u.x2 ? i : u.x2 - 1; lwq[q] = lw[(size_t)u.x0 * NT + i]; }
#pragma unroll
        for (int ai = 0; ai < 2; ++ai)
#pragma unroll
            for (int m = 0; m < 4; ++m) { const int r = ai * HALF + wr * 64 + m * 16 + fr;
                const f32x4 lwv = lwq[ai * 4 + m]; const float w = (u.pn >> 1) ? lwv[1] : lwv[0], rs = lwv[2];
                const f32x4 g0 = acc[ai][0][m][0], g1 = acc[ai][0][m][1], u0 = acc[ai][1][m][0], u1 = acc[ai][1][m][1]; float v[8];
#pragma unroll
                for (int j = 0; j < 4; ++j) { const float ga = g0[j] * rs, gb = g1[j] * rs; v[j] = ga * sigmoidf_(ga) * (u0[j] * rs) * w; v[4 + j] = gb * sigmoidf_(gb) * (u1[j] * rs) * w; }
                store16_wt(ACT + (size_t)(u.pm * BM + r) * 512 + col0, (u32x4){cvt_pk_bf16(v[0], v[1]), cvt_pk_bf16(v[2], v[3]), cvt_pk_bf16(v[4], v[5]), cvt_pk_bf16(v[6], v[7])}); }
    }
};
template <bool DRY> struct EpiMoeDown {
    static constexpr bool PERM = true; bf16* XB; const int* ltok; float* SS;
    __device__ __forceinline__ void mid(f32x4 (&)[2][2][4][2], const Unit&, int, int, int, int) const {}
    __device__ __forceinline__ void operator()(const f32x4 (&acc)[2][2][4][2], const Unit& u, int wr, int wc, int fr, int fq) const {
        const int col0 = u.pn * BM + wc * 32 + 8 * fq; const int lane = fr + 16 * fq;
        int tok[8];
#pragma unroll
        for (int q = 0; q < 8; ++q) { const int i = u.x1 + (q >> 2) * HALF + wr * 64 + (q & 3) * 16 + fr; tok[q] = ltok[(size_t)u.x0 * NT + (i < u.x2 ? i : u.x2 - 1)]; }
#pragma unroll
        for (int ai = 0; ai < 2; ++ai) { u32x4 xv[4][2];
#pragma unroll
            for (int m = 0; m < 4; ++m)
#pragma unroll
                for (int bj = 0; bj < 2; ++bj) xv[m][bj] = *(const u32x4*)(XB + (size_t)tok[ai * 4 + m] * DM + col0 + bj * HALF);
#pragma unroll
            for (int m = 0; m < 4; ++m) { const int i = u.x1 + ai * HALF + wr * 64 + m * 16 + fr; const bool ok = i < u.x2; const size_t ro = (size_t)tok[ai * 4 + m] * DM + col0;
                float ssq = 0.f;
#pragma unroll
                for (int bj = 0; bj < 2; ++bj) { float b[8]; unpack8(xv[m][bj], b); const f32x4 a0 = acc[ai][bj][m][0], a1 = acc[ai][bj][m][1];
                    if (!DRY) { b[0] += a0[0]; b[1] += a0[1]; b[2] += a0[2]; b[3] += a0[3]; b[4] += a1[0]; b[5] += a1[1]; b[6] += a1[2]; b[7] += a1[3]; }
                    const u32x4 o = (u32x4){cvt_pk_bf16(b[0], b[1]), cvt_pk_bf16(b[2], b[3]), cvt_pk_bf16(b[4], b[5]), cvt_pk_bf16(b[6], b[7])};
                    float rb[8]; unpack8(o, rb);
#pragma unroll
                    for (int e = 0; e < 8; ++e) ssq += rb[e] * rb[e];
                    if (ok) *(u32x4*)(XB + ro + bj * HALF) = o; }
                ssq += lane_xor(ssq, lane, 16); ssq += lane_xor(ssq, lane, 32);
                if (ok && fq == 0 && !DRY) SS[(size_t)tok[ai * 4 + m] * 16 + u.pn * 4 + wc] = ssq; }
            asm volatile("" ::: "memory"); }
    }
};
}


namespace attn {
typedef short bf16x8 __attribute__((ext_vector_type(8)));
typedef short s16x4 __attribute__((ext_vector_type(4)));
typedef float f32x16 __attribute__((ext_vector_type(16)));
__device__ __forceinline__ unsigned cvtpk(float lo, float hi) { typedef float f2 __attribute__((ext_vector_type(2))); typedef __bf16 b2 __attribute__((ext_vector_type(2))); f2 v = {lo, hi}; b2 b = __builtin_convertvector(v, b2); return __builtin_bit_cast(unsigned, b); }
__device__ __forceinline__ s16x4 vtr(const LAS unsigned char* p) { return __builtin_bit_cast(s16x4, __builtin_amdgcn_ds_read_tr16_b64_v4i16((LAS s16x4*)p)); }
constexpr int N_ITEMS = NB * NH * 48, N_STEPS = N_ITEMS / 2;
__device__ __forceinline__ void attn_phase(const int tid, LAS unsigned char* lds, const bf16* PROJ, bf16* OB, float* LSE, int G, int bx) {
    const int lane = tid & 63, wid = __builtin_amdgcn_readfirstlane(tid >> 6), half = wid >> 2, w = wid & 3, tid4 = tid & 255;
    const int r32 = lane & 31, hi = lane >> 5;
    LAS unsigned char* Kt = lds + half * 65536;
    LAS unsigned char* Vt = Kt + 32768;
    for (int step = bx; step < N_STEPS; step += G) {
        const int it = step * 2 + half; const int bh = it / 48, rem = it % 48, br = rem >> 4, tile = rem & 15;
        const int b = bh >> 3, h = bh & 7;
        const int dil = br == 0 ? 1 : (br == 1 ? 4 : 16); const int rr = br == 0 ? 0 : (br == 1 ? (tile & 3) : tile); const int blk = br == 0 ? tile : (br == 1 ? (tile >> 2) : 0);
        const bool first = (blk == 0);
        const size_t tokbase = (size_t)b * SEQ;
#pragma unroll
        for (int j = 0; j < 8; ++j) { const int row = j * 32 + (tid4 >> 3), ch = tid4 & 7; const bool valid = !(first && row < 128);
            u32x4 kv = (u32x4){0u, 0u, 0u, 0u}, vv = (u32x4){0u, 0u, 0u, 0u};
            if (valid) { const int pos = dil * (128 * (blk - 1) + row) + rr; const bf16* src = PROJ + (tokbase + pos) * INW + AW + h * HD + ch * 8; kv = *(const u32x4*)src; vv = *(const u32x4*)(src + AW); }
            *(LAS u32x4*)(Kt + ch * 4096 + ((row ^ ch) * 16)) = kv;
            *(LAS u32x4*)(Vt + (ch >> 2) * 16384 + row * 64 + (ch & 3) * 16) = vv; }
        const int qrow = 32 * w + r32; const int qpos = dil * (128 * blk + qrow) + rr;
        const bf16* qp = PROJ + (tokbase + qpos) * INW + h * HD + hi * 8;
        bf16x8 qf[4];
#pragma unroll
        for (int d0 = 0; d0 < 4; ++d0) qf[d0] = *(const bf16x8*)(qp + d0 * 16);
        __syncthreads();
        const int kt_lo = first ? (4 - w) : 0;
        f32x16 p[5];
#pragma unroll
        for (int kt = 0; kt < 5; ++kt) { p[kt] = f32x16{};
            if (kt >= kt_lo) {
#pragma unroll
                for (int d0 = 0; d0 < 4; ++d0) { const int ch = 2 * d0 + hi; const int kpos = 32 * w + 32 * kt + r32;
                    const bf16x8 kf = *(const LAS bf16x8*)(Kt + ch * 4096 + ((kpos ^ ch) * 16));
                    p[kt] = __builtin_amdgcn_mfma_f32_32x32x16_bf16(kf, qf[d0], p[kt], 0, 0, 0); } } }
        const float SC = 0.125f * 1.4426950408889634f;
        float mx = -INFINITY;
#pragma unroll
        for (int kt = 0; kt < 5; ++kt) if (kt >= kt_lo) {
#pragma unroll
            for (int r = 0; r < 16; ++r) { const int c = (r & 3) + 8 * (r >> 2) + 4 * hi; bool ok = true; if (kt == 0) ok = (c >= r32); if (kt == 4) ok = (c <= r32);
                const float sv = ok ? p[kt][r] * SC : -INFINITY; p[kt][r] = sv; mx = fmaxf(mx, sv); } }
        mx = fmaxf(mx, lane_xor(mx, lane, 32));
        float lsum = 0.f;
#pragma unroll
        for (int kt = 0; kt < 5; ++kt) if (kt >= kt_lo) {
#pragma unroll
            for (int r = 0; r < 16; ++r) { const float e = __builtin_amdgcn_exp2f(p[kt][r] - mx); p[kt][r] = e; lsum += e; } }
        lsum += lane_xor(lsum, lane, 32);
        f32x16 o[2]; o[0] = f32x16{}; o[1] = f32x16{};
        const LAS unsigned char* vbase = Vt + (32 * w + 4 * hi + ((lane & 15) >> 2)) * 64 + ((lane >> 4) & 1) * 32 + (lane & 3) * 8;
#pragma unroll
        for (int kt = 0; kt < 5; ++kt) if (kt >= kt_lo) {
#pragma unroll
            for (int ks = 0; ks < 2; ++ks) {
                u32x4 pw; pw.x = cvtpk(p[kt][8 * ks + 0], p[kt][8 * ks + 1]); pw.y = cvtpk(p[kt][8 * ks + 2], p[kt][8 * ks + 3]); pw.z = cvtpk(p[kt][8 * ks + 4], p[kt][8 * ks + 5]); pw.w = cvtpk(p[kt][8 * ks + 6], p[kt][8 * ks + 7]);
                const bf16x8 pf = __builtin_bit_cast(bf16x8, pw);
#pragma unroll
                for (int dh = 0; dh < 2; ++dh) { const LAS unsigned char* va = vbase + dh * 16384 + (32 * kt + 16 * ks) * 64;
                    const s16x4 lo = vtr(va), hi8 = vtr(va + 512);
                    const bf16x8 vf = (bf16x8){lo[0], lo[1], lo[2], lo[3], hi8[0], hi8[1], hi8[2], hi8[3]};
                    o[dh] = __builtin_amdgcn_mfma_f32_32x32x16_bf16(vf, pf, o[dh], 0, 0, 0); } } }
        const float inv = 1.f / lsum; const size_t tok = tokbase + qpos;
        bf16* op = OB + ((size_t)br * NT + tok) * AW + h * HD + 4 * hi;
#pragma unroll
        for (int dh = 0; dh < 2; ++dh)
#pragma unroll
            for (int g4 = 0; g4 < 4; ++g4) *(u32x2*)(op + 32 * dh + 8 * g4) = (u32x2){cvtpk(o[dh][4 * g4] * inv, o[dh][4 * g4 + 1] * inv), cvtpk(o[dh][4 * g4 + 2] * inv, o[dh][4 * g4 + 3] * inv)};
        if (hi == 0) LSE[((size_t)br * NT + tok) * NH + h] = (mx + __builtin_amdgcn_logf(lsum)) * 0.6931471805599453f;
        __syncthreads();
    }
}
}

namespace ssm {
typedef short bf16x8 __attribute__((ext_vector_type(8)));
__device__ __forceinline__ void ssm_phase(const int tid, LAS unsigned char* lds, unsigned char* ws, unsigned char* pj, int l, int G, int bx) {
    typedef float f32x2 __attribute__((ext_vector_type(2)));
    const int lane = tid & 63, wid = __builtin_amdgcn_readfirstlane(tid >> 6), nt4 = wid & 3, ih = wid >> 2;
    const bf16* UGM = (const bf16*)(ws + WS_UGM); bf16* YG = (bf16*)(ws + WS_YG); (void)pj;
    LAS float* Ef = (LAS float*)lds;
    LAS f32x2* Tot = (LAS f32x2*)(lds + 32768);
    LAS unsigned char* Kl = lds + 36864;
    for (int it = bx; it < NG * NB; it += G) {
        const int g = it % NG, b = it / NG, lg = l * NG + g;
        const bf16* Bb2 = (const bf16*)(ws + WS_BB2) + (size_t)lg * 128 * 32; const bf16* Ccm = (const bf16*)(ws + WS_CC) + (size_t)lg * 16 * 128;
        const unsigned char* Ktg = ws + WS_KTAB + (size_t)lg * 33 * 512; const float* Lams = (const float*)(ws + WS_LAMS) + (size_t)lg * 64 * 6;
        const int c = 16 * nt4 + (lane & 15), jj = lane >> 5, h0 = 8 * ((lane >> 4) & 1), q4 = lane >> 4;
        const u32x4 kt0 = *(const u32x4*)(Ktg + tid * 16), kt1 = *(const u32x4*)(Ktg + (tid + MKT) * 16); u32x4 kt2 = (u32x4){0u, 0u, 0u, 0u}; if (tid < 32) kt2 = *(const u32x4*)(Ktg + (tid + 2 * MKT) * 16);
        bf16x8 Uf[16];
        { const bf16* up = UGM + ((size_t)g * NT + (size_t)b * SEQ + (size_t)c * CL + jj) * 16 + h0;
#pragma unroll
          for (int ks = 0; ks < 16; ++ks) Uf[ks] = *(const bf16x8*)(up + (size_t)(2 * ks) * 16); }
        bf16x8 Af[4]; float l2r[4][2], l2i[4][2];
#pragma unroll
        for (int mi = 0; mi < 4; ++mi) { const int m = ih * 4 + mi; Af[mi] = *(const bf16x8*)(Bb2 + (size_t)(16 * m + (lane & 15)) * 32 + 8 * q4);
#pragma unroll
            for (int e = 0; e < 2; ++e) { const int p = 8 * m + 2 * q4 + e; l2r[mi][e] = Lams[p * 6 + 2]; l2i[mi][e] = Lams[p * 6 + 3]; } }
        const float sc_ar = Lams[(tid & 63) * 6 + 4], sc_ai = Lams[(tid & 63) * 6 + 5];
        *(LAS u32x4*)(Kl + tid * 16) = kt0; *(LAS u32x4*)(Kl + (tid + MKT) * 16) = kt1; if (tid < 32) *(LAS u32x4*)(Kl + (tid + 2 * MKT) * 16) = kt2;
        { f32x4 acc[4];
#pragma unroll
          for (int mi = 0; mi < 4; ++mi) acc[mi] = (f32x4){0.f, 0.f, 0.f, 0.f};
#pragma unroll
          for (int ks = 0; ks < 16; ++ks) {
#pragma unroll
              for (int mi = 0; mi < 4; ++mi) { f32x4 a = acc[mi];
                  if (ks > 0) a = (f32x4){l2r[mi][0] * a[0] - l2i[mi][0] * a[1], l2r[mi][0] * a[1] + l2i[mi][0] * a[0], l2r[mi][1] * a[2] - l2i[mi][1] * a[3], l2r[mi][1] * a[3] + l2i[mi][1] * a[2]};
                  acc[mi] = __builtin_amdgcn_mfma_f32_16x16x32_bf16(Af[mi], Uf[ks], a, 0, 0, 0); } }
#pragma unroll
          for (int mi = 0; mi < 4; ++mi) *(LAS f32x4*)(Ef + c * 128 + 16 * (ih * 4 + mi) + 4 * q4) = acc[mi]; }
        __syncthreads();
        { const int p = tid & 63, seg = tid >> 6; const float ar = sc_ar, ai = sc_ai;
          float lr[8], li[8]; float sr = 0.f, si = 0.f;
#pragma unroll
          for (int cc = 0; cc < 8; ++cc) { lr[cc] = sr; li[cc] = si; const f32x2 e = *(const LAS f32x2*)(Ef + (seg * 8 + cc) * 128 + 2 * p);
              const float nr = ar * sr - ai * si + e.x, ni = ar * si + ai * sr + e.y; sr = nr; si = ni; }
          Tot[seg * 64 + p] = (f32x2){sr, si};
          float a8r = ar, a8i = ai;
#pragma unroll
          for (int q = 0; q < 3; ++q) { const float tr = a8r * a8r - a8i * a8i, ti = 2.f * a8r * a8i; a8r = tr; a8i = ti; }
          __syncthreads();
          float cr = 0.f, ci = 0.f;
          for (int s2 = 0; s2 < seg; ++s2) { const f32x2 t = Tot[s2 * 64 + p]; const float nr = a8r * cr - a8i * ci + t.x, ni = a8r * ci + a8i * cr + t.y; cr = nr; ci = ni; }
          float pr = 1.f, pi = 0.f;
#pragma unroll
          for (int cc = 0; cc < 8; ++cc) { *(LAS f32x2*)(Ef + (seg * 8 + cc) * 128 + 2 * p) = (f32x2){lr[cc] + pr * cr - pi * ci, li[cc] + pr * ci + pi * cr};
              const float tr = pr * ar - pi * ai, ti = pr * ai + pi * ar; pr = tr; pi = ti; } }
        __syncthreads();
        { bf16x8 Cf[4]; float zr[4][4], zi[4][4], l2r[4][4], l2i[4][4];
#pragma unroll
          for (int k2 = 0; k2 < 4; ++k2) { Cf[k2] = *(const bf16x8*)(Ccm + (size_t)(lane & 15) * 128 + 32 * k2 + 8 * q4);
              const f32x4 s0 = *(const LAS f32x4*)(Ef + c * 128 + 32 * k2 + 8 * q4), s1 = *(const LAS f32x4*)(Ef + c * 128 + 32 * k2 + 8 * q4 + 4);
              const float sre[4] = {s0[0], s0[2], s1[0], s1[2]}, sim[4] = {s0[1], s0[3], s1[1], s1[3]};
#pragma unroll
              for (int e = 0; e < 4; ++e) { const int p = 16 * k2 + 4 * q4 + e; const float* lp = Lams + p * 6; l2r[k2][e] = lp[2]; l2i[k2][e] = lp[3];
                  const float fr_ = ih ? lp[2] : lp[0], fi_ = ih ? lp[3] : lp[1];
                  zr[k2][e] = fr_ * sre[e] - fi_ * sim[e]; zi[k2][e] = fr_ * sim[e] + fi_ * sre[e]; } }
          const LAS unsigned char* kbase = Kl + (lane & 15) * 32 + h0 * 2;
#pragma unroll
          for (int gq = 0; gq < 4; ++gq)
#pragma unroll 1
          for (int ii4 = 0; ii4 < 4; ++ii4) { const int ii = 4 * gq + ii4; const int i = 2 * ii + ih; f32x4 acc = (f32x4){0.f, 0.f, 0.f, 0.f};
#pragma unroll
              for (int k2 = 0; k2 < 4; ++k2) { u32x4 zw; zw.x = attn::cvtpk(zr[k2][0], zi[k2][0]); zw.y = attn::cvtpk(zr[k2][1], zi[k2][1]); zw.z = attn::cvtpk(zr[k2][2], zi[k2][2]); zw.w = attn::cvtpk(zr[k2][3], zi[k2][3]);
                  acc = __builtin_amdgcn_mfma_f32_16x16x32_bf16(Cf[k2], __builtin_bit_cast(bf16x8, zw), acc, 0, 0, 0);
#pragma unroll
                  for (int e = 0; e < 4; ++e) { const float nr = l2r[k2][e] * zr[k2][e] - l2i[k2][e] * zi[k2][e], ni = l2r[k2][e] * zi[k2][e] + l2i[k2][e] * zr[k2][e]; zr[k2][e] = nr; zi[k2][e] = ni; } }
              const LAS unsigned char* kp = kbase + (i - jj + 1) * 512;
#pragma unroll
              for (int ks = 0; ks < 4 * gq; ++ks) { const bf16x8 af = *(const LAS bf16x8*)(kp - ks * 1024); acc = __builtin_amdgcn_mfma_f32_16x16x32_bf16(af, Uf[ks], acc, 0, 0, 0); }
#pragma unroll
              for (int ks = 4 * gq; ks < 4 * gq + 4; ++ks) if (ks <= ii) { const bf16x8 af = *(const LAS bf16x8*)(kp - ks * 1024); acc = __builtin_amdgcn_mfma_f32_16x16x32_bf16(af, Uf[ks], acc, 0, 0, 0); }
              const size_t tok = (size_t)b * SEQ + (size_t)c * CL + i;
              *(u32x2*)(YG + ((size_t)g * NT + tok) * 16 + 4 * q4) = (u32x2){pk2(gelu_tanh(acc[0]), gelu_tanh(acc[1])), pk2(gelu_tanh(acc[2]), gelu_tanh(acc[3]))}; } }
        __syncthreads();
    }
}
}

#define XB_TMO      128
#define XB_XCNT(j)  (256  + 64 * (j))
#define XB_XSUB(j)  (1280 + 64 * (j))
#define XB_XGEN(j)  (2304 + 64 * (j))
#define XB_TOP      3328
#define XB_TOPGEN   3392
#define XCD_BAR_WORDS 3456
#define XB_SPIN_CAP (1u << 18)
__device__ __forceinline__ unsigned xb_ld(unsigned* p)              { return __hip_atomic_load(p, __ATOMIC_RELAXED, __HIP_MEMORY_SCOPE_AGENT); }
__device__ __forceinline__ unsigned xb_add(unsigned* p, unsigned v) { return __hip_atomic_fetch_add(p, v, __ATOMIC_RELAXED, __HIP_MEMORY_SCOPE_AGENT); }
__device__ __forceinline__ unsigned xb_xcc_id() { return (unsigned)__builtin_amdgcn_s_getreg((3 << 11) | 20) & 0xFu; }
#define XB_SPIN(cond, bar) do { unsigned _sp = 0; while (cond) { __builtin_amdgcn_s_sleep(1); \
    if ((++_sp & 255u) == 0u) { if (xb_ld(&(bar)[XB_TMO])) break; if (_sp > XB_SPIN_CAP) { atomicAdd(&(bar)[XB_TMO], 1u); break; } } } } while (0)
struct XcdBarrier { unsigned* bar; unsigned x; volatile LAS unsigned* st; };
__device__ __forceinline__ XcdBarrier xcd_barrier_post(unsigned* bar, volatile LAS unsigned* st) {
    XcdBarrier b; b.bar = bar; b.x = xb_xcc_id(); b.st = st;
    if (threadIdx.x == 0) (void)xb_add(&bar[XB_XCNT(b.x)], 1u);
    return b;
}
__device__ __forceinline__ void xcd_barrier_complete(unsigned* bar, unsigned x, unsigned& nloc, unsigned& nx) {
    const unsigned G = gridDim.x * gridDim.y * gridDim.z;
    unsigned sum, cnt, mine, sp = 0u;
    for (;;) {
        sum = 0u; cnt = 0u; mine = 0u;
#pragma unroll
        for (unsigned j = 0; j < 16; ++j) { const unsigned c = xb_ld(&bar[XB_XCNT(j)]); sum += c; cnt += (c > 0u) ? 1u : 0u; mine = (j == x) ? c : mine; }
        if (sum == G) break;
        __builtin_amdgcn_s_sleep(1);
        if ((++sp & 255u) == 0u) { if (xb_ld(&bar[XB_TMO])) break; if (sp > XB_SPIN_CAP) { atomicAdd(&bar[XB_TMO], 1u); break; } }
    }
    nloc = mine > 0u ? mine : 1u; nx = cnt > 0u ? cnt : 1u;
}
__device__ __forceinline__ void xcd_barrier(const XcdBarrier& b) {
    asm volatile("s_waitcnt vmcnt(0)" ::: "memory");
    __syncthreads();
    if (threadIdx.x == 0) {
        unsigned* bar = b.bar; unsigned bx_ = b.x;
        asm volatile("" : "+s"(bar), "+s"(bx_));
        __builtin_amdgcn_s_waitcnt(0);
        unsigned nloc = b.st[0], nx = b.st[1];
        if (nloc == 0u) { xcd_barrier_complete(bar, bx_, nloc, nx); b.st[0] = nloc; b.st[1] = nx; }
        const unsigned old = xb_add(&bar[XB_XSUB(bx_)], 1u);
        const unsigned gen = old / nloc;
        if (old + 1u == (gen + 1u) * nloc) {
            __builtin_amdgcn_fence(__ATOMIC_RELEASE, "agent");
            asm volatile("s_waitcnt vmcnt(0)" ::: "memory");
            const unsigned og = xb_add(&bar[XB_TOP], 1u);
            const unsigned tg = og / nx;
            if (og + 1u == (tg + 1u) * nx) xb_add(&bar[XB_TOPGEN], 1u);
            else XB_SPIN(xb_ld(&bar[XB_TOPGEN]) == tg, bar);
            __builtin_amdgcn_fence(__ATOMIC_ACQUIRE, "agent");
            xb_add(&bar[XB_XGEN(bx_)], 1u);
            asm volatile("s_waitcnt vmcnt(0)" ::: "memory");
        } else {
            XB_SPIN(xb_ld(&bar[XB_XGEN(bx_)]) == gen, bar);
            __builtin_amdgcn_fence(__ATOMIC_ACQUIRE, "agent");
            asm volatile("s_waitcnt vmcnt(0)" ::: "memory");
        }
    }
    __syncthreads();
}

__device__ __forceinline__ void norm_rows(const float* x, bf16* xn, float* outf, const float* g, int mode, int gw, int ngw, int lane) {
    for (int row = gw; row < NT; row += ngw) {
        const f32x4* xr = (const f32x4*)(x + (size_t)row * DM) + lane; f32x4 v[4]; float s = 0.f;
#pragma unroll
        for (int j = 0; j < 4; ++j) { v[j] = xr[64 * j]; s += v[j].x * v[j].x + v[j].y * v[j].y + v[j].z * v[j].z + v[j].w * v[j].w; }
        const float ssq = wave_sum(s, lane); const float rstd = 1.f / sqrtf(ssq * (1.f / DM) + RMS_EPS);
        if (mode == 0) { u32x2* o = (u32x2*)(xn + (size_t)row * DM) + lane;
#pragma unroll
            for (int j = 0; j < 4; ++j) o[64 * j] = (u32x2){pk2(v[j].x * rstd, v[j].y * rstd), pk2(v[j].z * rstd, v[j].w * rstd)};
        } else if (mode == 1) { u32x2* o = (u32x2*)(xn + (size_t)row * DM) + lane;
#pragma unroll
            for (int j = 0; j < 4; ++j) o[64 * j] = (u32x2){pk2(v[j].x, v[j].y), pk2(v[j].z, v[j].w)};
            if (lane < 16) outf[(size_t)row * 16 + lane] = lane == 0 ? ssq : 0.f;
        } else { f32x4* o = (f32x4*)(outf + (size_t)row * DM) + lane; const f32x4* gg = (const f32x4*)g + lane;
#pragma unroll
            for (int j = 0; j < 4; ++j) { const f32x4 gv = gg[64 * j]; o[64 * j] = (f32x4){v[j].x * rstd * gv.x, v[j].y * rstd * gv.y, v[j].z * rstd * gv.z, v[j].w * rstd * gv.w}; } }
    }
}

__device__ __forceinline__ void final_rows(const bf16* XB, float* out, const float* g, int gw, int ngw, int lane) {
    for (int row = gw; row < NT; row += ngw) { const u32x4* xr = (const u32x4*)(XB + (size_t)row * DM) + lane; float v[2][8]; float s = 0.f;
#pragma unroll
        for (int j = 0; j < 2; ++j) { unpack8(xr[64 * j], v[j]);
#pragma unroll
            for (int c = 0; c < 8; ++c) s += v[j][c] * v[j][c]; }
        const float rstd = 1.f / sqrtf(wave_sum(s, lane) * (1.f / DM) + RMS_EPS);
#pragma unroll
        for (int j = 0; j < 2; ++j) { const f32x4* gp = (const f32x4*)(g + 512 * j + 8 * lane); const f32x4 g0 = gp[0], g1 = gp[1]; f32x4* op = (f32x4*)(out + (size_t)row * DM + 512 * j + 8 * lane);
            op[0] = (f32x4){v[j][0] * rstd * g0[0], v[j][1] * rstd * g0[1], v[j][2] * rstd * g0[2], v[j][3] * rstd * g0[3]};
            op[1] = (f32x4){v[j][4] * rstd * g1[0], v[j][5] * rstd * g1[1], v[j][6] * rstd * g1[2], v[j][7] * rstd * g1[3]}; } }
}

#ifndef TL_MASK
#define TL_MASK 0ull
#endif
#define TL_K 4ull
#ifndef REP_ATTN
#define REP_ATTN 1
#endif
#ifndef REP_P0
#define REP_P0 1
#endif
#ifndef REP_NORM
#define REP_NORM 1
#endif
#ifndef REP_INPROJ
#define REP_INPROJ 1
#endif
#ifndef REP_GLU
#define REP_GLU 1
#endif
#ifndef REP_MIX
#define REP_MIX 1
#endif
#ifndef REP_OUT
#define REP_OUT 1
#endif
#ifndef REP_ROUTE
#define REP_ROUTE 1
#endif
#ifndef REP_MOEUP
#define REP_MOEUP 1
#endif
#ifndef REP_MOEDN
#define REP_MOEDN 1
#endif

#ifndef REP_SSM
#define REP_SSM 1
#endif
constexpr int MK_THREADS = 512, MK_LDS = 147456;
constexpr int CW_BAR = 4096;
constexpr int LDS_CTL_OFF = 131072, LDS_MISC_OFF = LDS_CTL_OFF + 512;
enum { ST_P0 = 0, ST_NORM = 1, ST_INPROJ = 2, ST_MIXERS = 3, ST_GLU = 4, ST_MIX = 5, ST_OUT = 6, ST_ROUTE = 7, ST_MOEUP = 8, ST_MOEDN = 9, ST_FINAL = 10 };
constexpr int PROG_LEN = 2 + 9 * NL;
__host__ __device__ __forceinline__ void prog_decode(int pi, int& step, int& layer) {
    if (pi == 0) { step = ST_P0; layer = 0; return; }
    if (pi == PROG_LEN - 1) { step = ST_FINAL; layer = NL - 1; return; }
    int q = pi - 1;
    if (q < 8) { layer = 0; step = ST_INPROJ + q; return; }
    q -= 8; layer = 1 + q / 9; step = ST_NORM + q % 9;
}
struct MkArgs { Ptrs P; int s_lo, s_hi, flags, pad1; };
#if defined(__HIP_DEVICE_COMPILE__)
#define CAS __attribute__((address_space(4)))
#else
#define CAS
#endif
__global__ void __launch_bounds__(MK_THREADS, 2) mk(MkArgs args) {
    extern __shared__ __attribute__((aligned(16))) unsigned char lds_raw[];
    LAS unsigned char* const lds0 = (LAS unsigned char*)lds_raw;
    const CAS MkArgs* ap = (const CAS MkArgs*)__builtin_amdgcn_kernarg_segment_ptr();
    const int G0 = gridDim.x; const int bx0 = blockIdx.x;
    const int tid0 = threadIdx.x;
    for (int u = tid0; u < (MK_LDS - LDS_CTL_OFF) / 4; u += MK_THREADS) ((LAS unsigned*)(lds0 + LDS_CTL_OFF))[u] = 0u;
    __syncthreads();
    const int lo = args.s_lo, hi = args.s_hi;
#if TL_MASK
    unsigned long long tl_prev = __builtin_amdgcn_s_memrealtime(), tl_sum = 0;
#endif
    XcdBarrier bar; bar.bar = (unsigned*)(args.P.ws + WS_CTL) + CW_BAR; bar.x = 0; bar.st = nullptr;
    if (hi - lo > 1) bar = xcd_barrier_post(bar.bar, (volatile LAS unsigned*)(lds0 + LDS_MISC_OFF));
#if TL_MASK
#define TL_MARK(k) { const unsigned long long tn_ = __builtin_amdgcn_s_memrealtime(); if ((TL_MASK >> (k)) & 1ull) tl_sum += tn_ - tl_prev; tl_prev = tn_; }
#else
#define TL_MARK(k)
#endif
#define STEP_BEGIN(k) if (lo <= (k) && (k) < hi) { int G = G0, bx = bx0, tid = tid0; unsigned ldsv = (unsigned)(uintptr_t)lds0; asm volatile("" : "+s"(ap), "+s"(G), "+s"(bx), "+v"(tid), "+s"(ldsv)); \
    LAS unsigned char* const lds = (LAS unsigned char*)(uintptr_t)ldsv; const int lane = tid & 63, wave = __builtin_amdgcn_readfirstlane(tid >> 6); (void)lane; const int gw = bx * 8 + wave, ngw = G * 8; (void)gw; (void)ngw; const Ptrs P = ap->P; unsigned char* const ws = P.ws; unsigned char* const pj = (unsigned char*)P.out; (void)pj; unsigned* const ctl = (unsigned*)(ws + WS_CTL); (void)ctl;
#define STEP_OFF(k) if (0) { const int G = 1, bx = 0, gw = 0, ngw = 1, tid = 0, lane = 0, wave = 0; LAS unsigned char* const lds = lds0; (void)lane; (void)wave; const Ptrs P{}; unsigned char* const ws = nullptr; unsigned char* const pj = nullptr; unsigned* const ctl = nullptr; (void)ctl;
#define STEP_END(k) if ((k) + 1 < hi) xcd_barrier(bar); TL_MARK(k) }
    STEP_BEGIN(0)
      for (int rep = 0; rep < REP_P0; ++rep) {
        for (int ti = bx; ti < 2 * NL * NG; ti += G) p0_tables_item(P, ti >> 1, ti & 1, (LAS float*)lds, tid, MK_THREADS);
        __syncthreads();
        p0_transposes(P, (LAS float*)lds + wave * 64 * 33, gw, ngw, lane);
        norm_rows(P.x, (bf16*)(ws + WS_XB), (float*)(ws + WS_SS1), nullptr, 1, gw, ngw, lane);
        __syncthreads(); }
    STEP_END(0)
#pragma unroll 1
    for (int l = 0; l < NL; ++l) {
        const int kb = 1 + 9 * l;
        STEP_BEGIN(kb + 1)
            LAS float* rtab = (LAS float*)(lds + LDS_CTL_OFF + 4096);
            pg8::InSched S{(const char*)(ws + WS_XB), (const char*)(ws + WS_WIN) + (size_t)l * INW * DM * 2, NT / 256, INW / 256, G, bx, (size_t)256 * DM * 2, (size_t)256 * DM * 2, (const float*)(ws + WS_SS1), rtab};
            pg8::EpiStoreBf16 E{(bf16*)(pj), INW, rtab, (bf16*)(ws + WS_UGM)};
            pg8::gemm_phase<pg8::EpiStoreBf16, pg8::InSched, false, true>(tid, lds, DM, DM, DM, S, E);
        STEP_END(kb + 1)
        STEP_BEGIN(kb + 2)
            for (int rep = 0; rep < REP_ATTN; ++rep) attn::attn_phase(tid, lds, (const bf16*)(pj), (bf16*)(ws + WS_OB), (float*)(ws + WS_LSE), G, bx);
            TL_MARK(40)
            for (int rep = 0; rep < REP_SSM; ++rep) ssm::ssm_phase(tid, lds, ws, pj, l, G, bx);
        STEP_END(kb + 2)
        STEP_BEGIN(kb + 3)
            { pg8::GluSched S{(const char*)(ws + WS_YG), (const char*)(ws + WS_WGLU) + (size_t)l * SW * SW * 2, NT / 256, SW / 256, G, bx};
              pg8::EpiGlu E{(bf16*)(ws + WS_AB) + AW, (const bf16*)(ws + WS_YG), DM, (float*)(ws + WS_SSG)};
              pg8::gemm_phase<pg8::EpiGlu, pg8::GluSched, false, true>(tid, lds, SW, SW, SW, S, E, (size_t)4 * NT * 32); }
            { const int nglu = (NT / 256) * (SW / 256); const int mb = G > nglu ? bx - nglu : bx, nmb = G > nglu ? G - nglu : G;
              if (mb >= 0) for (int row = mb * 8 + wave; row < NT; row += nmb * 8) mix_row_attn(row, lane, (const bf16*)(ws + WS_OB), (const float*)(ws + WS_LSE), (bf16*)(ws + WS_AB)); }
        STEP_END(kb + 3)
        STEP_BEGIN(kb + 5)
            LAS float* rtab = (LAS float*)(lds + LDS_CTL_OFF + 4096);
            pg8::OutSched S{(const char*)(ws + WS_AB), (const char*)(ws + WS_WOUT) + (size_t)l * DM * DM * 2, G, bx, (const float*)(ws + WS_SSG), rtab};
            pg8::EpiResid E{(bf16*)(ws + WS_XB), DM, rtab};
            pg8::gemm_phase<pg8::EpiResid, pg8::OutSched, false, false>(tid, lds, DM, DM, SW, S, E);
        STEP_END(kb + 5)
        STEP_BEGIN(kb + 6)
            LAS f32x4* GW = (LAS f32x4*)lds; LAS int* lcnt = (LAS int*)(lds + 98304); LAS int* lbase = lcnt + 32; LAS int* lpart = lcnt + 64;
            if (tid < 32) lcnt[tid] = 0;
            route_build_lds(P, l, GW, tid);
            int* cnt2 = (int*)(ws + WS_CNT2) + (size_t)l * 1024 * 32;
            {
              { const bf16* XBp = (const bf16*)(ws + WS_XB); u32x4 nx[2][2];
#pragma unroll
                for (int q = 0; q < 2; ++q)
#pragma unroll
                    for (int j = 0; j < 2; ++j) nx[q][j] = *((const u32x4*)(XBp + (size_t)(gw + q * ngw) * DM) + lane + 64 * j);
#pragma unroll 1
                for (int r0 = gw; r0 < NT; r0 += 2 * ngw) { u32x4 cur[2][2];
#pragma unroll
                    for (int q = 0; q < 2; ++q)
#pragma unroll
                        for (int j = 0; j < 2; ++j) cur[q][j] = nx[q][j];
                    if (r0 + 2 * ngw < NT) {
#pragma unroll
                        for (int q = 0; q < 2; ++q)
#pragma unroll
                            for (int j = 0; j < 2; ++j) nx[q][j] = *((const u32x4*)(XBp + (size_t)(r0 + 2 * ngw + q * ngw) * DM) + lane + 64 * j); }
                    route_rows<2>(P, l, r0, ngw, lane, GW, cur, (unsigned*)(ws + WS_TROUTE), (f32x4*)(ws + WS_TW), lcnt); } }
              __syncthreads();
              if (tid < 32) cnt2[bx * 32 + tid] = lcnt[tid];
              xcd_barrier(bar);
              { const int c = tid >> 4, part = tid & 15; int sum = 0, tot = 0;
                for (int b2 = part; b2 < G; b2 += 16) { const int v = __hip_atomic_load(cnt2 + b2 * 32 + c, __ATOMIC_RELAXED, __HIP_MEMORY_SCOPE_AGENT); tot += v; if (b2 < bx) sum += v; }
                lpart[tid] = sum; lpart[512 + tid] = tot; }
              __syncthreads();
              if (tid < 32) { int sum = 0, tot = 0; for (int q = 0; q < 16; ++q) { sum += lpart[tid * 16 + q]; tot += lpart[512 + tid * 16 + q]; } lbase[tid] = sum; if (bx == 0 && tid < NCLS) ctl[CW_CNT + l * 32 + tid] = (unsigned)tot; }
              __syncthreads();
              if (lane == 0) { int* ltok = (int*)(ws + WS_LTOK); f32x4* lw = (f32x4*)(ws + WS_LW); const unsigned* troute = (const unsigned*)(ws + WS_TROUTE); const f32x4* tw = (const f32x4*)(ws + WS_TW);
#pragma unroll 1
                for (int row = gw; row < NT; row += ngw) { const unsigned rt = troute[row]; const int cls = (int)((rt >> 16) & 255u), slot = lbase[cls] + (int)(rt >> 24);
                    ltok[(size_t)cls * NT + slot] = row; lw[(size_t)cls * NT + slot] = tw[row]; } } }
        STEP_END(kb + 6)
        STEP_BEGIN(kb + 7)
            LAS int* tpre = (LAS int*)(lds + LDS_CTL_OFF); pg8::moe_build_prefix(tid, tpre, ctl + CW_CNT + l * 32);
            unsigned* ucnt = ctl + CW_UCNT + l * 128; unsigned* tmo = ctl + CW_BAR + XB_TMO;
            { pg8::MoeSched S{tpre, (const int*)(ws + WS_LTOK), (const char*)(ws + WS_XB), (const char*)(ws + WS_WGU), G, bx, l, 1, ucnt, tmo};
              pg8::EpiMoeUp E{(bf16*)(pj), (const f32x4*)(ws + WS_LW)};
              pg8::gemm_phase<pg8::EpiMoeUp, pg8::MoeSched, true, true>(tid, lds, DM, DM, DM, S, E); }
            { pg8::MoeSched S{tpre, (const int*)(ws + WS_LTOK), (const char*)(pj), (const char*)(ws + WS_WD), G, bx, l, 0, ucnt, tmo};
              pg8::EpiMoeDown<false> E{(bf16*)(ws + WS_XB), (const int*)(ws + WS_LTOK), (float*)(ws + WS_SS1)};
              pg8::gemm_phase<pg8::EpiMoeDown<false>, pg8::MoeSched, false, true>(tid, lds, 512, EFF, EFF, S, E); }
        STEP_END(kb + 7)
    }
    STEP_BEGIN(1 + 9 * NL)
        final_rows((const bf16*)(ws + WS_XB), P.out, P.final_g, gw, ngw, lane);
    STEP_END(1 + 9 * NL)
#if TL_MASK
    if (bx0 == 0) { const unsigned long long t0_ = __builtin_amdgcn_s_memrealtime(); while (__builtin_amdgcn_s_memrealtime() - t0_ < TL_K * tl_sum) __builtin_amdgcn_s_sleep(8); }
#endif
#undef STEP_BEGIN
#undef STEP_OFF
#undef STEP_END
}

#ifndef MK_SPLIT
#define MK_SPLIT 0
#endif
extern "C" void kernel_launch(void* const* d_in, const int* in_sizes, int n_in, void* d_out, int out_size, void* d_ws, size_t ws_size, hipStream_t stream) {
    if (n_in != 24 || out_size != NT * DM || ws_size < WS_END) { fprintf(stderr, "kernel_launch: unexpected shapes n_in %d out %d ws %zu (need %zu)\n", n_in, out_size, ws_size, (size_t)WS_END); return; }
    static int grid = 0;
    if (grid == 0) {
        int dev = 0, cus = 0, per_cu = 0;
        if (hipFuncSetAttribute((const void*)mk, hipFuncAttributeMaxDynamicSharedMemorySize, MK_LDS) != hipSuccess) { fprintf(stderr, "kernel_launch: hipFuncSetAttribute failed\n"); grid = -1; return; }
        if (hipGetDevice(&dev) != hipSuccess || hipDeviceGetAttribute(&cus, hipDeviceAttributeMultiprocessorCount, dev) != hipSuccess) { fprintf(stderr, "kernel_launch: device query failed\n"); grid = -1; return; }
        if (hipOccupancyMaxActiveBlocksPerMultiprocessor(&per_cu, (const void*)mk, MK_THREADS, MK_LDS) != hipSuccess || per_cu < 1) { fprintf(stderr, "kernel_launch: occupancy query failed (%d)\n", per_cu); grid = -1; return; }
        grid = cus * per_cu;
        fprintf(stderr, "kernel_launch: %d CUs x %d blocks/CU -> grid %d\n", cus, per_cu, grid);
    }
    if (grid < 0) return;
    Ptrs P{};
    const float** pf = (const float**)&P;
    for (int i = 0; i < 24; ++i) pf[i] = (const float*)d_in[i];
    P.out = (float*)d_out; P.ws = (unsigned char*)d_ws;
    (void)hipMemsetAsync(P.ws + WS_CTL, 0, 65536, stream);
    MkArgs a{}; a.P = P;
#if MK_SPLIT
    for (int pi = 0; pi < PROG_LEN; ++pi) { a.s_lo = pi; a.s_hi = pi + 1; hipLaunchKernelGGL(mk, dim3(grid), dim3(MK_THREADS), MK_LDS, stream, a); }
#else
    a.s_lo = 0; a.s_hi = PROG_LEN;
    void* kargs[] = {&a};
    const hipError_t e = hipLaunchCooperativeKernel((const void*)mk, dim3(grid), dim3(MK_THREADS), kargs, MK_LDS, stream);
    if (e != hipSuccess) fprintf(stderr, "kernel_launch: cooperative launch failed: %s (grid %d)\n", hipGetErrorString(e), grid);
#endif
}
```

```cpp
#include <hip/hip_runtime.h>
#include <cstdio>
#include <cstdint>

typedef unsigned short bf16;
typedef float f32x4 __attribute__((ext_vector_type(4)));
typedef unsigned u32x4 __attribute__((ext_vector_type(4)));
typedef unsigned u32x2 __attribute__((ext_vector_type(2)));
#define LAS __attribute__((address_space(3)))

constexpr int NB = 8, SEQ = 2048, DM = 1024, NL = 4, NT = NB * SEQ;
constexpr int AW = 512, HD = 64, NH = 8, SW = 512, GC = 16, NG = 32, NP = 64, INW = 2048;
constexpr int NE = 16, EFF = 256, NCLS = 24;
constexpr float RMS_EPS = 1e-6f;
constexpr int CL = 32;
constexpr int NCH = SEQ / CL;
constexpr int MKT = 512;

constexpr size_t al256(size_t x) { return (x + 255) & ~(size_t)255; }
constexpr size_t WS_CTL = 0, CTL_BYTES = 1u << 20;
constexpr size_t WS_WIN  = WS_CTL + CTL_BYTES;
constexpr size_t WS_WGLU = WS_WIN  + (size_t)NL * INW * DM * 2;
constexpr size_t WS_WOUT = WS_WGLU + (size_t)NL * SW * SW * 2;
constexpr size_t WS_WGU  = WS_WOUT + (size_t)NL * DM * DM * 2;
constexpr size_t WS_WD   = WS_WGU  + (size_t)NL * NE * 512 * DM * 2;
constexpr size_t WS_KTAB = WS_WD   + (size_t)NL * NE * DM * EFF * 2;
constexpr size_t WS_BB2  = WS_KTAB + al256((size_t)NL * NG * 33 * 256 * 2);
constexpr size_t WS_CC   = WS_BB2  + (size_t)NL * NG * 128 * 32 * 2;
constexpr size_t WS_LAMS = WS_CC   + (size_t)NL * NG * 16 * 128 * 2;
constexpr size_t WS_AB   = WS_LAMS + (size_t)NL * NG * 64 * 6 * 4;
constexpr size_t WS_UGM  = WS_AB + (size_t)NT * SW * 2;
constexpr size_t WS_OB   = WS_AB + (size_t)NT * DM * 2;
constexpr size_t WS_TROUTE = WS_OB + (size_t)3 * NT * AW * 2;
constexpr size_t WS_TW   = WS_TROUTE + (size_t)NT * 4;
constexpr size_t WS_LTOK = WS_TW + (size_t)NT * 16;
constexpr size_t WS_LW   = WS_LTOK + (size_t)NCLS * NT * 4;
constexpr size_t WS_LSE  = WS_LW + (size_t)NCLS * NT * 16;
constexpr size_t WS_SS1  = WS_LSE + (size_t)3 * NT * NH * 4;
constexpr size_t WS_CNT2 = WS_SS1 + (size_t)NT * 16 * 4;
constexpr size_t WS_XB   = WS_CNT2 + (size_t)NL * 1024 * 32 * 4;
constexpr size_t WS_RS2  = WS_XB + (size_t)NT * DM * 2;
constexpr size_t WS_SSG  = WS_RS2 + (size_t)NT * 4;
constexpr size_t WS_YG   = WS_SSG + (size_t)NT * 8 * 4;
constexpr size_t WS_END  = WS_YG + (size_t)NT * SW * 2;
static_assert(WS_END <= 325000000, "workspace map exceeds the guaranteed size");
constexpr int CW_CNT = 1024;
constexpr int CW_UCNT = 2048;

__device__ __forceinline__ unsigned f2bf(float f) { unsigned u = __builtin_bit_cast(unsigned, f); return (u + 0x7fffu + ((u >> 16) & 1u)) >> 16; }
__device__ __forceinline__ float bf2f(unsigned h) { return __builtin_bit_cast(float, h << 16); }
__device__ __forceinline__ unsigned pk2(float lo, float hi) { return f2bf(lo) | (f2bf(hi) << 16); }
__device__ __forceinline__ float lane_xor(float v, int lane, int o) { return __builtin_bit_cast(float, __builtin_amdgcn_ds_bpermute((lane ^ o) << 2, __builtin_bit_cast(int, v))); }
#define DPP_ADD(x, ctrl, rmask) ((x) + __builtin_bit_cast(float, __builtin_amdgcn_update_dpp(0, __builtin_bit_cast(int, (x)), (ctrl), (rmask), 0xf, true)))
__device__ __forceinline__ float wave_sum(float v, int) {
    v = DPP_ADD(v, 0x111, 0xf); v = DPP_ADD(v, 0x112, 0xf); v = DPP_ADD(v, 0x114, 0xf); v = DPP_ADD(v, 0x118, 0xf);
    v = DPP_ADD(v, 0x142, 0xa); v = DPP_ADD(v, 0x143, 0xc);
    return __builtin_bit_cast(float, __builtin_amdgcn_readlane(__builtin_bit_cast(int, v), 63));
}
__device__ __forceinline__ void store16_wt(void* p, u32x4 v) { asm volatile("global_store_dwordx4 %0, %1, off sc1\n\ts_nop 1" :: "v"(p), "v"(v) : "memory"); }
__device__ __forceinline__ void store16f_wt(void* p, f32x4 v) { asm volatile("global_store_dwordx4 %0, %1, off sc1\n\ts_nop 1" :: "v"(p), "v"(v) : "memory"); }
__device__ __forceinline__ float gelu_tanh(float y) {
    const float u2 = 1.5957691216057308f * (y + 0.044715f * y * y * y);
    return y * __builtin_amdgcn_rcpf(1.f + __expf(-u2));
}
__device__ __forceinline__ float sigmoidf_(float z) { return __builtin_amdgcn_rcpf(1.f + __expf(-z)); }

struct Ptrs {
    const float *x, *ln1_g, *w_in, *lam_re, *lam_im, *log_dt, *b_re, *b_im, *c_re, *c_im, *d_skip, *w_glu, *gn_attn, *gn_ssm, *w_out, *ln2_g,
        *w_rg, *b_rg, *w_re, *b_re_, *w_gate, *w_up, *w_down, *final_g;
    float* out; unsigned char* ws;
};

__device__ __forceinline__ void unpack8(const u32x4 q, float (&o)[8]) { o[0] = bf2f(q.x & 0xffffu); o[1] = bf2f(q.x >> 16); o[2] = bf2f(q.y & 0xffffu); o[3] = bf2f(q.y >> 16); o[4] = bf2f(q.z & 0xffffu); o[5] = bf2f(q.z >> 16); o[6] = bf2f(q.w & 0xffffu); o[7] = bf2f(q.w >> 16); }
__device__ __forceinline__ void p0_transpose_item(const float* W, int N, const float* gain, bf16* WT, int K, LAS float* scr, int kb, int nb, int dst_row0, int lane) {
    const int k0 = 64 * kb, n0 = 64 * nb;
    const float* wp = W + (size_t)(k0 + (lane >> 4)) * N + n0 + (lane & 15) * 4;
    f32x4 v[16];
#pragma unroll
    for (int i = 0; i < 16; ++i) v[i] = *(const f32x4*)(wp + (size_t)(4 * i) * N);
    const int c = lane & 7;
    f32x4 g0 = (f32x4){1.f, 1.f, 1.f, 1.f}, g1 = g0;
    if (gain) { g0 = *(const f32x4*)(gain + k0 + 8 * c); g1 = *(const f32x4*)(gain + k0 + 8 * c + 4); }
#pragma unroll
    for (int i = 0; i < 16; ++i) { const int k = 4 * i + (lane >> 4); *(LAS f32x4*)(scr + k * 64 + (((lane & 15) * 4) ^ (((k >> 3) & 7) << 2))) = v[i]; }
    asm volatile("s_waitcnt lgkmcnt(0)" ::: "memory");
#pragma unroll
    for (int j = 0; j < 8; ++j) { const int n = (lane >> 3) + 8 * j; const LAS float* sp = scr + (8 * c) * 64 + (n ^ (c << 2));
        u32x4 o; o.x = pk2(sp[0 * 64] * g0[0], sp[1 * 64] * g0[1]); o.y = pk2(sp[2 * 64] * g0[2], sp[3 * 64] * g0[3]); o.z = pk2(sp[4 * 64] * g1[0], sp[5 * 64] * g1[1]); o.w = pk2(sp[6 * 64] * g1[2], sp[7 * 64] * g1[3]);
        *(u32x4*)(WT + (size_t)(dst_row0 + n) * K + k0 + 8 * c) = o; }
    asm volatile("s_waitcnt lgkmcnt(0)" ::: "memory");
}
constexpr int IT_WIN = (DM / 64) * (INW / 64);
constexpr int IT_WGLU = (SW / 64) * (SW / 64);
constexpr int IT_WOUT = (DM / 64) * (DM / 64);
constexpr int IT_WG = (DM / 64) * (EFF / 64);
constexpr int IT_WDN = (EFF / 64) * (DM / 64);
constexpr int IT_PER_LAYER = IT_WIN + IT_WGLU + IT_WOUT + NE * (2 * IT_WG + IT_WDN);
constexpr int IT_TOTAL = NL * IT_PER_LAYER;
__device__ __forceinline__ void p0_transposes(const Ptrs& P, LAS float* scr, int gw, int ngw, int lane) {
    unsigned char* ws = P.ws;
#pragma unroll 1
    for (int it = gw; it < IT_TOTAL; it += ngw) {
        const int l = it / IT_PER_LAYER; int r = it % IT_PER_LAYER;
        if (r < IT_WIN) { const int nblk = INW / 64; p0_transpose_item(P.w_in + (size_t)l * DM * INW, INW, P.ln1_g + l * DM, (bf16*)(ws + WS_WIN) + (size_t)l * INW * DM, DM, scr, r / nblk, r % nblk, 64 * (r % nblk), lane); continue; }
        r -= IT_WIN;
        if (r < IT_WGLU) { const int nblk = SW / 64; p0_transpose_item(P.w_glu + (size_t)l * SW * SW, SW, nullptr, (bf16*)(ws + WS_WGLU) + (size_t)l * SW * SW, SW, scr, r / nblk, r % nblk, 64 * (r % nblk), lane); continue; }
        r -= IT_WGLU;
        if (r < IT_WOUT) { const int nblk = DM / 64; const int kb = r / nblk; const float* g = (kb < 8) ? (P.gn_attn + l * AW) : (P.gn_ssm + l * SW - AW);
            p0_transpose_item(P.w_out + (size_t)l * DM * DM, DM, g, (bf16*)(ws + WS_WOUT) + (size_t)l * DM * DM, DM, scr, kb, r % nblk, 64 * (r % nblk), lane); continue; }
        r -= IT_WOUT;
        const int e = r / (2 * IT_WG + IT_WDN); r %= (2 * IT_WG + IT_WDN);
        if (r < 2 * IT_WG) { const int up = r / IT_WG; r %= IT_WG; const int nblk = EFF / 64; const int kb = r / nblk, nb = r % nblk; const int f0 = 64 * nb;
            const float* src = (up ? P.w_up : P.w_gate) + ((size_t)l * NE + e) * DM * EFF;
            bf16* dst = (bf16*)(ws + WS_WGU) + ((size_t)l * NE + e) * 512 * DM;
            p0_transpose_item(src, EFF, P.ln2_g + l * DM, dst, DM, scr, kb, nb, (f0 / 128) * 256 + up * 128 + (f0 % 128), lane); continue; }
        r -= 2 * IT_WG;
        { const int nblk = DM / 64; p0_transpose_item(P.w_down + ((size_t)l * NE + e) * EFF * DM, DM, nullptr, (bf16*)(ws + WS_WD) + ((size_t)l * NE + e) * DM * EFF, EFF, scr, r / nblk, r % nblk, 64 * (r % nblk), lane); }
    }
}

__device__ __forceinline__ void p0_tables_item(const Ptrs& P, int lg, int half, LAS float* scr, int tid, int nthr) {
    typedef float f32x2 __attribute__((ext_vector_type(2)));
    LAS f32x2* pw = (LAS f32x2*)scr; LAS f32x2* Bb = pw + 33 * 64; LAS f32x2* Cc = Bb + 64 * 16;
    const int l = lg / NG, g = lg % NG;
    const float dt = expf(P.log_dt[lg]);
    const float* lre = P.lam_re + (size_t)lg * NP; const float* lim = P.lam_im + (size_t)lg * NP;
#pragma unroll 1
    for (int i = tid; i < 33 * 64; i += nthr) { const int tau = i / 64, p = i % 64;
        const float a = lre[p] * dt * (float)tau; const float turns = lim[p] * dt * 0.15915494309189535f;
        const float xh = (float)tau * turns, xl = fmaf((float)tau, turns, -xh); const float fr = (xh - rintf(xh)) + xl;
        float sn, cs; sincosf(6.283185307179586f * fr, &sn, &cs); const float mg = expf(a);
        pw[i] = (f32x2){mg * cs, mg * sn}; }
#pragma unroll 1
    for (int i = tid; i < 64 * 16; i += nthr) { const int p = i / 16, h = i % 16;
        const float a = lre[p] * dt, th = lim[p] * dt; float sn, cs; sincosf(th, &sn, &cs); float sh, ch; sincosf(0.5f * th, &sh, &ch); (void)ch;
        const float em1 = expm1f(a), ea = em1 + 1.f;
        const float nr = em1 * cs - 2.f * sh * sh, ni = ea * sn;
        const float c = lre[p], d = lim[p], den = 1.f / (c * c + d * d);
        const float qr = (nr * c + ni * d) * den, qi = (ni * c - nr * d) * den;
        const float br = P.b_re[((size_t)lg * NP + p) * GC + h], bi = P.b_im[((size_t)lg * NP + p) * GC + h];
        Bb[i] = (f32x2){qr * br - qi * bi, qr * bi + qi * br}; }
#pragma unroll 1
    for (int i = tid; i < 16 * 64; i += nthr) { const int h = i / 64, p = i % 64;
        Cc[i] = (f32x2){P.c_re[((size_t)lg * GC + h) * NP + p], P.c_im[((size_t)lg * GC + h) * NP + p]}; }
    __syncthreads();
    unsigned char* ws = P.ws;
    bf16* Bb2 = (bf16*)(ws + WS_BB2) + (size_t)lg * 128 * 32;
    bf16* Ccm = (bf16*)(ws + WS_CC) + (size_t)lg * 16 * 128;
    bf16* Kt = (bf16*)(ws + WS_KTAB) + (size_t)lg * 33 * 256;
    float* Lams = (float*)(ws + WS_LAMS) + (size_t)lg * 64 * 6;
    if (half == 0)
#pragma unroll 1
    for (int i = tid; i < 128 * 32; i += nthr) { const int row = i >> 5, col = i & 31; const int p = row >> 1, cc = row & 1, h = col & 15; f32x2 b = Bb[p * 16 + h];
        if (col < 16) { const f32x2 w = pw[64 + p]; b = (f32x2){w.x * b.x - w.y * b.y, w.x * b.y + w.y * b.x}; }
        Bb2[i] = (bf16)f2bf(cc ? b.y : b.x); }
    if (half == 1)
#pragma unroll 1
    for (int i = tid; i < 16 * 128; i += nthr) { const int h = i >> 7, st = i & 127; const f32x2 c = Cc[h * 64 + (st >> 1)]; Ccm[i] = (bf16)f2bf((st & 1) ? -c.y : c.x); }
#pragma unroll 1
    for (int i = (half ? 17 * 256 : 0) + tid; i < (half ? 33 * 256 : 17 * 256); i += nthr) { const int t1 = i / 256, h = (i >> 4) & 15, hp = i & 15; float sacc = 0.f;
        if (t1 > 0) { const int tau = t1 - 1;
            for (int p = 0; p < 64; ++p) { const f32x2 c = Cc[h * 64 + p], w = pw[tau * 64 + p], b = Bb[p * 16 + hp]; const float cr = c.x * w.x - c.y * w.y, ci = c.x * w.y + c.y * w.x; sacc += cr * b.x - ci * b.y; }
            if (tau == 0 && h == hp) sacc += P.d_skip[(size_t)lg * GC + h]; }
        Kt[i] = (bf16)f2bf(sacc); }
    if (half == 1)
#pragma unroll 1
    for (int i = tid; i < 64; i += nthr) { const f32x2 w1 = pw[64 + i], w2 = pw[128 + i], w32 = pw[32 * 64 + i]; float* o = Lams + i * 6; o[0] = w1.x; o[1] = w1.y; o[2] = w2.x; o[3] = w2.y; o[4] = w32.x; o[5] = w32.y; }
    __syncthreads();
    (void)l; (void)g;
}

__device__ __forceinline__ void route_build_lds(const Ptrs& P, int l, LAS f32x4* GW, int tid) {
#pragma unroll
    for (int idx = tid; idx < 5 * DM; idx += MKT) { const int ep = idx >> 10, k = idx & 1023; const int j = k >> 9, c = k & 7, ln = (k & 511) >> 3;
        const float g = P.ln2_g[l * DM + k];
        const f32x4 w = ep == 0 ? *(const f32x4*)(P.w_rg + ((size_t)l * DM + k) * 4) : *(const f32x4*)(P.w_re + (((size_t)l * 4 + (ep - 1)) * DM + k) * 4);
        GW[((ep * 2 + j) * 8 + c) * 64 + ln] = w * g; }
    __syncthreads();
}
template <int NR> __device__ __forceinline__ void route_rows(const Ptrs& P, int l, const int r0, const int rstride, int lane, const LAS f32x4* GW, const u32x4 (&raw)[NR][2], unsigned* troute, f32x4* tw, LAS int* lcnt) {
    float v[NR][2][8]; float rstd[NR];
#pragma unroll
    for (int q = 0; q < NR; ++q) {
#pragma unroll
        for (int j = 0; j < 2; ++j) unpack8(raw[q][j], v[q][j]); }
#pragma unroll
    for (int q = 0; q < NR; ++q) { float s = 0.f;
#pragma unroll
        for (int j = 0; j < 2; ++j)
#pragma unroll
            for (int c = 0; c < 8; ++c) s += v[q][j][c] * v[q][j][c];
        rstd[q] = 1.f / sqrtf(wave_sum(s, lane) * (1.f / DM) + RMS_EPS); }
    f32x4 acc[NR];
#pragma unroll
    for (int q = 0; q < NR; ++q) acc[q] = (f32x4){0.f, 0.f, 0.f, 0.f};
#pragma unroll
    for (int j = 0; j < 2; ++j)
#pragma unroll
        for (int c = 0; c < 8; ++c) { const f32x4 w = GW[(j * 8 + c) * 64 + lane];
#pragma unroll
            for (int q = 0; q < NR; ++q) acc[q] += v[q][j][c] * w; }
    int grp[NR]; float g1[NR];
#pragma unroll
    for (int q = 0; q < NR; ++q) { float gl[4];
#pragma unroll
        for (int e = 0; e < 4; ++e) gl[e] = wave_sum(acc[q][e], lane) * rstd[q] + P.b_rg[l * 4 + e];
        int gi = 0; float gm = gl[0];
#pragma unroll
        for (int e = 1; e < 4; ++e) if (gl[e] > gm) { gm = gl[e]; gi = e; }
        float gs = 0.f;
#pragma unroll
        for (int e = 0; e < 4; ++e) gs += expf(gl[e] - gm);
        grp[q] = gi; g1[q] = 1.f / gs; acc[q] = (f32x4){0.f, 0.f, 0.f, 0.f}; }
#pragma unroll
    for (int j = 0; j < 2; ++j)
#pragma unroll
        for (int c = 0; c < 8; ++c)
#pragma unroll
            for (int q = 0; q < NR; ++q) acc[q] += v[q][j][c] * GW[(((1 + grp[q]) * 2 + j) * 8 + c) * 64 + lane];
#pragma unroll
    for (int q = 0; q < NR; ++q) { float el[4];
#pragma unroll
        for (int e = 0; e < 4; ++e) el[e] = wave_sum(acc[q][e], lane) * rstd[q] + P.b_re_[(l * 4 + grp[q]) * 4 + e];
        int i1 = 0; float v1 = el[0];
#pragma unroll
        for (int e = 1; e < 4; ++e) if (el[e] > v1) { v1 = el[e]; i1 = e; }
        int i2 = -1; float v2 = -INFINITY;
#pragma unroll
        for (int e = 0; e < 4; ++e) if (e != i1 && el[e] > v2) { v2 = el[e]; i2 = e; }
        const float e2 = expf(v2 - v1); const float w1 = g1[q] / (1.f + e2), w2 = g1[q] * e2 / (1.f + e2);
        const int a = i1 < i2 ? i1 : i2, b = i1 < i2 ? i2 : i1; const float wa = i1 < i2 ? w1 : w2, wb = i1 < i2 ? w2 : w1;
        const int pair = (a == 0) ? (b - 1) : (a == 1 ? (b + 1) : 5);
        const int cls = grp[q] * 6 + pair; const int row = r0 + q * rstride;
        if (lane == 0) {
            const int lslot = __hip_atomic_fetch_add(lcnt + cls, 1, __ATOMIC_RELAXED, __HIP_MEMORY_SCOPE_WORKGROUP);
            troute[row] = (unsigned)(grp[q] * 4 + a) | ((unsigned)(grp[q] * 4 + b) << 8) | ((unsigned)cls << 16) | ((unsigned)lslot << 24);
            tw[row] = (f32x4){wa, wb, rstd[q], 0.f};
        } }
}

template <int NR> __device__ __forceinline__ void mix_rows_attn(const int row0, const int rstride, int lane, const bf16* OB, const float* LSE, bf16* AB) {
    const int h = lane >> 3;
    float ls[NR][3]; u32x4 qv[NR][3];
#pragma unroll
    for (int r = 0; r < NR; ++r)
#pragma unroll
        for (int b = 0; b < 3; ++b) { const int row = row0 + r * rstride; ls[r][b] = LSE[((size_t)b * NT + row) * NH + h]; qv[r][b] = *((const u32x4*)(OB + ((size_t)b * NT + row) * AW) + lane); }
#pragma unroll
    for (int r = 0; r < NR; ++r) { const int row = row0 + r * rstride;
        const float m = fmaxf(fmaxf(ls[r][0], ls[r][1]), ls[r][2]); float w[3], ws_ = 0.f;
#pragma unroll
        for (int b = 0; b < 3; ++b) { w[b] = expf(ls[r][b] - m); ws_ += w[b]; }
        float o[8];
#pragma unroll
        for (int i = 0; i < 8; ++i) o[i] = 0.f;
#pragma unroll
        for (int b = 0; b < 3; ++b) { float q[8]; unpack8(qv[r][b], q); const float wb = w[b] / ws_;
#pragma unroll
            for (int i = 0; i < 8; ++i) o[i] += wb * q[i]; }
        float s = 0.f;
#pragma unroll
        for (int i = 0; i < 8; ++i) s += o[i] * o[i];
        const float rstd = 1.f / sqrtf(wave_sum(s, lane) * (1.f / AW) + RMS_EPS);
        *((u32x4*)(AB + (size_t)row * DM) + lane) = (u32x4){pk2(o[0] * rstd, o[1] * rstd), pk2(o[2] * rstd, o[3] * rstd), pk2(o[4] * rstd, o[5] * rstd), pk2(o[6] * rstd, o[7] * rstd)}; }
}
namespace pg8 {
typedef short bf16x8 __attribute__((ext_vector_type(8)));
constexpr int BM = 256, BK = 64, HALF = 128, HTB = HALF * BK * 2, STAGE_BYTES = 8 * HTB, NXCD = 8, WGM = 8;
__host__ __device__ __forceinline__ int lds_byte(int r, int c) { const int st = (r >> 4) * 2 + (c >> 5), rr = r & 15, cc = c & 31, ob = rr * 64 + cc * 2; return st * 1024 + (ob ^ (((ob >> 9) & 1) << 5)); }
__host__ __device__ __forceinline__ void stage_rc(int b, int& R, int& C) { const int st = b / 1024, sb = b % 1024, swz = sb ^ (((sb >> 9) & 1) << 5); R = (st >> 1) * 16 + swz / 64; C = (st & 1) * 32 + (swz % 64) / 2; }
__host__ __device__ __forceinline__ int perm32(int rho) { const int n = rho >> 4, i = rho & 15; return 8 * (i >> 2) + 4 * n + (i & 3); }
struct Unit { int pm, pn; const char* a; const char* b; int x0, x1, x2, fl; };
__device__ __forceinline__ bool static_order(int nM, int nN, int G, int c, int i, int& pm, int& pn) {
    const int nwg = nM * nN; const long L = (long)i * G + c; if (L >= nwg) return false;
    int wgid = (int)L; { const int q = nwg / NXCD, r = nwg % NXCD, xcd = wgid % NXCD, off = wgid / NXCD; wgid = (xcd < r ? xcd * (q + 1) : r * (q + 1) + (xcd - r) * q) + off; }
    const int nig = WGM * nN, gid = wgid / nig, fm = gid * WGM, gsz = (nM - fm) < WGM ? (nM - fm) : WGM;
    pm = fm + ((wgid % nig) % gsz); pn = (wgid % nig) / gsz; return true;
}
__device__ __forceinline__ unsigned cvt_pk_bf16(float lo, float hi) { unsigned r; asm volatile("v_cvt_pk_bf16_f32 %0, %1, %2" : "=v"(r) : "v"(lo), "v"(hi)); return r; }
template <class Epi, class Sched, bool GATHER, bool ALIGN_EPI>
__device__ __forceinline__ void gemm_phase(const int tid, LAS unsigned char* lds, const int lda, const int ldb, const int K, const Sched& S, const Epi& E, const size_t kstepA = (size_t)(BK * 2)) {
    const int wid = __builtin_amdgcn_readfirstlane(tid >> 6), lane = tid & 63, wr = wid >> 2, wc = wid & 3, fr = lane & 15, fq = lane >> 4;
    const int nt = K / BK;
    int Rr[2], Cc[2]; unsigned voffB[2], cvA0[2], cvA1[2], nvA0[2], nvA1[2];
#pragma unroll
    for (int i = 0; i < 2; ++i) { stage_rc(tid * 16 + i * 8192, Rr[i], Cc[i]); const int Rb = Epi::PERM ? ((Rr[i] & ~31) + perm32(Rr[i] & 31)) : Rr[i]; voffB[i] = (unsigned)(Rb * ldb + Cc[i]) * 2u; }
    const size_t kstep = (size_t)(BK * 2);
    const size_t hstepB = (size_t)HALF * ldb * 2;
    const unsigned ldsw = (unsigned)wid * 1024u;
    const int aoff = lds_byte(wr * 64 + fr, fq * 8), boff = lds_byte(wc * 32 + fr, fq * 8);
#define PG8_SA(b, h) (((b) * 2 + (h)) * HTB)
#define PG8_SB(b, h) ((4 + (b) * 2 + (h)) * HTB)
#define PG8_STAGE(bufoff, gbase, voff) do { _Pragma("unroll") for (int _i = 0; _i < 2; ++_i) \
        __builtin_amdgcn_global_load_lds((const unsigned*)((const char*)(gbase) + (voff)[_i]), (LAS unsigned*)(lds + (bufoff) + ldsw + _i * 8192), 16, 0, 0); } while (0)
#define PG8_LDA(dst, b, h) do { _Pragma("unroll") for (int m = 0; m < 4; ++m) _Pragma("unroll") for (int k = 0; k < 2; ++k) dst[m][k] = *(const LAS bf16x8*)(lds + PG8_SA(b, h) + aoff + m * 2048 + k * 1024); } while (0)
#define PG8_LDB(dst, b, h) do { _Pragma("unroll") for (int n = 0; n < 2; ++n) _Pragma("unroll") for (int k = 0; k < 2; ++k) dst[n][k] = *(const LAS bf16x8*)(lds + PG8_SB(b, h) + boff + n * 2048 + k * 1024); } while (0)
#define PG8_MMA(ai, bj, At, Bt) do { __builtin_amdgcn_s_setprio(1); _Pragma("unroll") for (int m = 0; m < 4; ++m) _Pragma("unroll") for (int n = 0; n < 2; ++n) _Pragma("unroll") for (int k = 0; k < 2; ++k) \
        acc[ai][bj][m][n] = __builtin_amdgcn_mfma_f32_16x16x32_bf16(Bt[n][k], At[m][k], acc[ai][bj][m][n], 0, 0, 0); __builtin_amdgcn_s_setprio(0); } while (0)
#define PG8_WAIT_V(n) asm volatile("s_waitcnt vmcnt(" #n ")" ::: "memory")
#define PG8_WAIT_L(n) asm volatile("s_waitcnt lgkmcnt(" #n ")" ::: "memory")
#define PG8_BAR __builtin_amdgcn_s_barrier()
#define PG8_SCHED __builtin_amdgcn_sched_barrier(0)
#define PG8_BP(u, tile) ((u).b + (size_t)(tile) * kstep)
#define PG8_SETA(u, v0, v1) do { _Pragma("unroll") for (int _i = 0; _i < 2; ++_i) { v0[_i] = S.aoff(u, Rr[_i], Cc[_i], lda); v1[_i] = S.aoff(u, HALF + Rr[_i], Cc[_i], lda); } } while (0)
    Unit cur, nxt; int ui = 0;
    if (!S.next(0, cur)) return;
    S.a_ready(cur);
    PG8_SETA(cur, cvA0, cvA1);
    f32x4 acc[2][2][4][2];
#pragma unroll
    for (int a = 0; a < 2; ++a)
#pragma unroll
        for (int b = 0; b < 2; ++b)
#pragma unroll
            for (int m = 0; m < 4; ++m)
#pragma unroll
                for (int n = 0; n < 2; ++n) acc[a][b][m][n] = (f32x4){0.f, 0.f, 0.f, 0.f};
    bf16x8 At[4][2], B0[2][2], B1[2][2];
    {   const char* cB = PG8_BP(cur, 0); const char* cB1 = PG8_BP(cur, 1);
        PG8_STAGE(PG8_SB(0, 0), cB, voffB); PG8_STAGE(PG8_SB(0, 1), cB + hstepB, voffB); PG8_STAGE(PG8_SA(0, 0), cur.a, cvA0); PG8_STAGE(PG8_SA(0, 1), cur.a, cvA1);
        if (wr == 1) PG8_BAR;
        PG8_WAIT_V(2); PG8_BAR;
        PG8_STAGE(PG8_SB(1, 0), cB1, voffB); PG8_STAGE(PG8_SA(1, 0), cur.a + kstepA, cvA0); PG8_STAGE(PG8_SB(1, 1), cB1 + hstepB, voffB);
        PG8_WAIT_V(6); PG8_BAR; }
    for (;;) {
        const bool has_next = S.next(ui + 1, nxt);
        if (has_next) { S.a_ready(nxt); PG8_SETA(nxt, nvA0, nvA1); } else {
#pragma unroll
            for (int i = 0; i < 2; ++i) { nvA0[i] = cvA0[i]; nvA1[i] = cvA1[i]; } }
        const char* nA = has_next ? nxt.a : cur.a; const char* nB = has_next ? PG8_BP(nxt, 0) : PG8_BP(cur, 0);
        for (int t = 0; t < nt; t += 2) {
            const bool last = (t == nt - 2);
            const char* a1 = cur.a + (size_t)(t + 1) * kstepA;
            const char* a2 = last ? nA : cur.a + (size_t)(t + 2) * kstepA; const char* b2 = last ? nB : PG8_BP(cur, t + 2);
            const char* a3 = a2 + kstepA; const char* b3 = b2 + kstep;
            unsigned vo0[2], vo1[2];
#pragma unroll
            for (int i = 0; i < 2; ++i) { vo0[i] = last ? nvA0[i] : cvA0[i]; vo1[i] = last ? nvA1[i] : cvA1[i]; }
            PG8_LDB(B0, 0, 0); PG8_LDB(B1, 0, 1); PG8_SCHED; PG8_LDA(At, 0, 0); PG8_STAGE(PG8_SA(1, 1), a1, cvA1);
            PG8_WAIT_V(8); PG8_WAIT_L(0); PG8_BAR; PG8_MMA(0, 0, At, B0); PG8_MMA(0, 1, At, B1); PG8_BAR; PG8_SCHED;
            PG8_LDA(At, 0, 1); PG8_STAGE(PG8_SB(0, 0), b2, voffB); PG8_STAGE(PG8_SB(0, 1), b2 + hstepB, voffB); PG8_STAGE(PG8_SA(0, 0), a2, vo0);
            PG8_WAIT_V(8); PG8_WAIT_L(0); PG8_BAR; PG8_MMA(1, 0, At, B0); PG8_MMA(1, 1, At, B1); PG8_BAR; PG8_SCHED;
            PG8_LDB(B0, 1, 0); PG8_LDB(B1, 1, 1); PG8_SCHED; PG8_LDA(At, 1, 0); PG8_STAGE(PG8_SA(0, 1), a2, vo1);
            PG8_WAIT_V(8); PG8_WAIT_L(0); PG8_BAR; PG8_MMA(0, 0, At, B0); PG8_MMA(0, 1, At, B1); PG8_BAR; PG8_SCHED;
            PG8_LDA(At, 1, 1); PG8_STAGE(PG8_SB(1, 0), b3, voffB); PG8_STAGE(PG8_SB(1, 1), b3 + hstepB, voffB); PG8_STAGE(PG8_SA(1, 0), a3, vo0);
            PG8_WAIT_V(8); PG8_WAIT_L(0); PG8_BAR; PG8_MMA(1, 0, At, B0); PG8_MMA(1, 1, At, B1); PG8_BAR; PG8_SCHED;
        }
        const bool epi = (cur.fl & 2) != 0;
        if (epi) {
            if constexpr (ALIGN_EPI) { if (wr == 0) PG8_BAR; }
            { int t2 = tid; asm volatile("" : "+v"(t2));
              const int w2 = __builtin_amdgcn_readfirstlane(t2 >> 6), l2 = t2 & 63; E(acc, cur, w2 >> 2, w2 & 3, l2 & 15, l2 >> 4); S.done(cur, l2); }
        }
        if (!epi) { int t2 = tid; asm volatile("" : "+v"(t2)); const int w2 = __builtin_amdgcn_readfirstlane(t2 >> 6), l2 = t2 & 63; E.mid(acc, cur, w2 >> 2, w2 & 3, l2 & 15, l2 >> 4); }
        if (!has_next) break;
        if (nxt.fl & 1) {
#pragma unroll
            for (int a = 0; a < 2; ++a)
#pragma unroll
                for (int b = 0; b < 2; ++b)
#pragma unroll
                    for (int m = 0; m < 4; ++m)
#pragma unroll
                        for (int n = 0; n < 2; ++n) acc[a][b][m][n] = (f32x4){0.f, 0.f, 0.f, 0.f};
        }
        cur = nxt; ++ui;
#pragma unroll
        for (int i = 0; i < 2; ++i) { cvA0[i] = nvA0[i]; cvA1[i] = nvA1[i]; }
        if (epi) { if constexpr (ALIGN_EPI) { if (wr == 1) PG8_BAR; } }
    }
    PG8_WAIT_V(0);
    if constexpr (!ALIGN_EPI) { if (wr == 0) PG8_BAR; }
    PG8_BAR;
#undef PG8_SA
#undef PG8_SB
#undef PG8_STAGE
#undef PG8_LDA
#undef PG8_LDB
#undef PG8_MMA
#undef PG8_WAIT_V
#undef PG8_WAIT_L
#undef PG8_BAR
#undef PG8_SCHED
#undef PG8_BP
#undef PG8_SETA
}

struct DenseSched {
    const char* A; const char* Bt; int nM, nN, G, c; size_t atile, btile;
    __device__ __forceinline__ bool next(int i, Unit& u) const { int pm, pn; if (!static_order(nM, nN, G, c, i, pm, pn)) return false;
        u.pm = pm; u.pn = pn; u.a = A + (size_t)pm * atile; u.b = Bt + (size_t)pn * btile; u.x0 = u.x1 = u.x2 = 0; u.fl = 3; return true; }
    __device__ __forceinline__ unsigned aoff(const Unit&, int r, int c, int lda) const { return (unsigned)(r * lda + c) * 2u; }
    __device__ __forceinline__ void a_ready(const Unit&) const {}
    __device__ __forceinline__ void done(const Unit&, int) const {}
};
struct InSched {
    const char* A; const char* Bt; int nM, nN, G, c; size_t atile, btile; const float* ss; LAS float* tab;
    __device__ __forceinline__ bool next(int i, Unit& u) const { int pm, pn; if (!static_order(nM, nN, G, c, i, pm, pn)) return false;
        u.pm = pm; u.pn = pn; u.a = A + (size_t)pm * atile; u.b = Bt + (size_t)pn * btile; u.x0 = i & 1; u.x1 = u.x2 = 0; u.fl = 3; return true; }
    __device__ __forceinline__ unsigned aoff(const Unit&, int r, int c, int lda) const { return (unsigned)(r * lda + c) * 2u; }
    __device__ __forceinline__ void a_ready(const Unit& u) const {
        const int t = threadIdx.x;
        if (t < 256) { const f32x4* sp = (const f32x4*)(ss + (size_t)(u.pm * 256 + t) * 16); const f32x4 s4 = (sp[0] + sp[1]) + (sp[2] + sp[3]); tab[u.x0 * 256 + t] = 1.f / sqrtf(((s4[0] + s4[1]) + (s4[2] + s4[3])) * (1.f / DM) + RMS_EPS); }
        asm volatile("s_waitcnt lgkmcnt(0)" ::: "memory"); __builtin_amdgcn_s_barrier(); asm volatile("" ::: "memory");
    }
    __device__ __forceinline__ void done(const Unit&, int) const {}
};
struct GluSched {
    const char* A; const char* Bt; int nM, nN, G, c;
    __device__ __forceinline__ bool next(int i, Unit& u) const { int pm, pn; if (!static_order(nM, nN, G, c, i, pm, pn)) return false;
        u.pm = pm; u.pn = pn; u.a = A + (size_t)pm * 256 * 32; u.b = Bt + (size_t)pn * 256 * SW * 2; u.x0 = u.x1 = u.x2 = 0; u.fl = 3; return true; }
    __device__ __forceinline__ unsigned aoff(const Unit&, int r, int c, int) const { return (unsigned)((c >> 4) * NT + r) * 32u + (unsigned)(c & 15) * 2u; }
    __device__ __forceinline__ void a_ready(const Unit&) const {}
    __device__ __forceinline__ void done(const Unit&, int) const {}
};
struct EpiStoreBf16 {
    static constexpr bool PERM = true; bf16* C; int ldc; const LAS float* tab; bf16* UGM;
    __device__ __forceinline__ void mid(f32x4 (&)[2][2][4][2], const Unit&, int, int, int, int) const {}
    __device__ __forceinline__ void operator()(const f32x4 (&acc)[2][2][4][2], const Unit& u, int wr, int wc, int fr, int fq) const {
        const int row0 = u.pm * BM + wr * 64 + fr, col0 = u.pn * BM + wc * 32 + 8 * fq; const bool isu = col0 >= 3 * AW; const LAS float* tp = tab + u.x0 * 256 + wr * 64 + fr;
#pragma unroll
        for (int ai = 0; ai < 2; ++ai)
#pragma unroll
            for (int m = 0; m < 4; ++m) { const int row = row0 + ai * HALF + m * 16; const float r = tp[ai * HALF + m * 16];
#pragma unroll
                for (int bj = 0; bj < 2; ++bj) { const f32x4 v0 = acc[ai][bj][m][0] * r, v1 = acc[ai][bj][m][1] * r; const int col = col0 + bj * HALF;
                    bf16* dst = isu ? UGM + ((size_t)((col - 3 * AW) >> 4) * NT + row) * 16 + (col & 15) : C + (size_t)row * ldc + col;
                    store16_wt(dst, (u32x4){cvt_pk_bf16(v0[0], v0[1]), cvt_pk_bf16(v0[2], v0[3]), cvt_pk_bf16(v1[0], v1[1]), cvt_pk_bf16(v1[2], v1[3])}); } }
    }
};
struct EpiGlu {
    static constexpr bool PERM = true; bf16* C; const bf16* aux; int ldc; float* SSG;
    __device__ __forceinline__ void mid(f32x4 (&)[2][2][4][2], const Unit&, int, int, int, int) const {}
    __device__ __forceinline__ void operator()(const f32x4 (&acc)[2][2][4][2], const Unit& u, int wr, int wc, int fr, int fq) const {
        const int row0 = u.pm * BM + wr * 64 + fr, col0 = u.pn * BM + wc * 32 + 8 * fq; const int lane = fr + 16 * fq;
#pragma unroll
        for (int ai = 0; ai < 2; ++ai) { u32x4 yv[4][2];
#pragma unroll
            for (int m = 0; m < 4; ++m)
#pragma unroll
                for (int bj = 0; bj < 2; ++bj) { const int col_ = col0 + bj * HALF; yv[m][bj] = *(const u32x4*)(aux + ((size_t)(col_ >> 4) * NT + (row0 + ai * HALF + m * 16)) * 16 + (col_ & 15)); }
#pragma unroll
            for (int m = 0; m < 4; ++m) { const int row = row0 + ai * HALF + m * 16; const size_t ro = (size_t)row * ldc + col0; float ssq = 0.f;
#pragma unroll
                for (int bj = 0; bj < 2; ++bj) { const f32x4 v0 = acc[ai][bj][m][0], v1 = acc[ai][bj][m][1]; float y[8]; unpack8(yv[m][bj], y);
                    float r[8]; r[0] = y[0] * sigmoidf_(v0[0]); r[1] = y[1] * sigmoidf_(v0[1]); r[2] = y[2] * sigmoidf_(v0[2]); r[3] = y[3] * sigmoidf_(v0[3]);
                    r[4] = y[4] * sigmoidf_(v1[0]); r[5] = y[5] * sigmoidf_(v1[1]); r[6] = y[6] * sigmoidf_(v1[2]); r[7] = y[7] * sigmoidf_(v1[3]);
                    const u32x4 o = (u32x4){cvt_pk_bf16(r[0], r[1]), cvt_pk_bf16(r[2], r[3]), cvt_pk_bf16(r[4], r[5]), cvt_pk_bf16(r[6], r[7])}; float rb[8]; unpack8(o, rb);
#pragma unroll
                    for (int e = 0; e < 8; ++e) ssq += rb[e] * rb[e];
                    *(u32x4*)(C + ro + bj * HALF) = o; }
                ssq += lane_xor(ssq, lane, 16); ssq += lane_xor(ssq, lane, 32);
                if (fq == 0) SSG[(size_t)row * 8 + u.pn * 4 + wc] = ssq; }
            asm volatile("" ::: "memory"); }
    }
};
struct EpiResid {
    static constexpr bool PERM = true; bf16* XB; int ldc; const LAS float* tab;
    __device__ __forceinline__ void mid(f32x4 (&acc)[2][2][4][2], const Unit& u, int wr, int wc, int fr, int fq) const {
        const LAS float* tp = tab + u.x0 * 256 + wr * 64 + fr; (void)wc; (void)fq;
#pragma unroll
        for (int ai = 0; ai < 2; ++ai)
#pragma unroll
            for (int m = 0; m < 4; ++m) { const float irs = tp[ai * HALF + m * 16];
#pragma unroll
                for (int bj = 0; bj < 2; ++bj)
#pragma unroll
                    for (int n = 0; n < 2; ++n) acc[ai][bj][m][n] *= irs; }
    }
    __device__ __forceinline__ void operator()(const f32x4 (&acc)[2][2][4][2], const Unit& u, int wr, int wc, int fr, int fq) const {
        const int row0 = u.pm * BM + wr * 64 + fr, col0 = u.pn * BM + wc * 32 + 8 * fq; const LAS float* tp = tab + u.x0 * 256 + wr * 64 + fr;
#pragma unroll
        for (int ai = 0; ai < 2; ++ai) { u32x4 xv[4][2];
#pragma unroll
            for (int m = 0; m < 4; ++m)
#pragma unroll
                for (int bj = 0; bj < 2; ++bj) xv[m][bj] = *(const u32x4*)(XB + (size_t)(row0 + ai * HALF + m * 16) * ldc + col0 + bj * HALF);
#pragma unroll
            for (int m = 0; m < 4; ++m) { const int row = row0 + ai * HALF + m * 16; const size_t ro = (size_t)row * ldc + col0; const float rs = 1.f / tp[ai * HALF + m * 16];
#pragma unroll
                for (int bj = 0; bj < 2; ++bj) { float b[8]; unpack8(xv[m][bj], b); const f32x4 a0 = acc[ai][bj][m][0] * rs, a1 = acc[ai][bj][m][1] * rs;
                    *(u32x4*)(XB + ro + bj * HALF) = (u32x4){cvt_pk_bf16(b[0] + a0[0], b[1] + a0[1]), cvt_pk_bf16(b[2] + a0[2], b[3] + a0[3]), cvt_pk_bf16(b[4] + a1[0], b[5] + a1[1]), cvt_pk_bf16(b[6] + a1[2], b[7] + a1[3])}; } }
            asm volatile("" ::: "memory"); }
    }
};
struct OutSched {
    const char* AB; const char* Wt; int G, c; const float* SSG; LAS float* tab;
    __device__ __forceinline__ bool next(int i, Unit& u) const { int pm, pn; if (!static_order(NT / 256, DM / 256, G, c, i >> 1, pm, pn)) return false; const int seg = i & 1;
        u.pm = pm; u.pn = pn; u.x0 = (i >> 1) & 1; u.x1 = u.x2 = 0; u.fl = seg ? 2 : 1;
        u.a = AB + (size_t)pm * 256 * DM * 2 + (seg ? AW * 2 : 0); u.b = Wt + (size_t)pn * 256 * DM * 2 + (seg ? AW * 2 : 0); return true; }
    __device__ __forceinline__ unsigned aoff(const Unit&, int r, int c, int lda) const { return (unsigned)(r * lda + c) * 2u; }
    __device__ __forceinline__ void a_ready(const Unit& u) const {
        if (!(u.fl & 1)) return;
        const int t = threadIdx.x;
        if (t < 256) { const f32x4* sp = (const f32x4*)(SSG + (size_t)(u.pm * 256 + t) * 8); const f32x4 s4 = sp[0] + sp[1]; tab[u.x0 * 256 + t] = sqrtf(((s4[0] + s4[1]) + (s4[2] + s4[3])) * (1.f / SW) + RMS_EPS); }
        asm volatile("s_waitcnt lgkmcnt(0)" ::: "memory"); __builtin_amdgcn_s_barrier(); asm volatile("" ::: "memory");
    }
    __device__ __forceinline__ void done(const Unit&, int) const {}
};
__device__ __forceinline__ void moe_build_prefix_lds(const int tid, LAS int* tpre) {
    if (tid == 0) { int s = 0;
#pragma unroll 1
        for (int c = 0; c < NCLS; ++c) { const int n = tpre[32 + c]; tpre[c] = s; const int nt_ = (n + 255) >> 8; for (int t = 0; t < nt_; ++t) tpre[256 + s + t] = c; s += nt_; } tpre[NCLS] = s; }
    __syncthreads();
}
__device__ __forceinline__ void pair_decode(int pair, int& a, int& b) { a = pair < 3 ? 0 : (pair < 5 ? 1 : 2); b = pair < 3 ? pair + 1 : (pair < 5 ? pair - 1 : 3); }
struct MoeSched {
    const LAS int* tpre; const int* ltok; const char* A; const char* W; int G, c, l, up; unsigned* ucnt; unsigned* tmo;
    __device__ __forceinline__ void fill(int pm, int pn, int seg, Unit& u) const {
        const int cls = __builtin_amdgcn_readfirstlane(tpre[256 + pm]);
        const int grp = cls / 6; int ea, eb; pair_decode(cls % 6, ea, eb); ea += grp * 4; eb += grp * 4;
        u.pm = pm; u.pn = pn; u.x0 = cls; u.x1 = (pm - __builtin_amdgcn_readfirstlane(tpre[cls])) * 256; u.x2 = __builtin_amdgcn_readfirstlane(tpre[32 + cls]);
        if (up) { const int e = pn < 2 ? ea : eb; u.a = A; u.b = W + ((size_t)((l * NE + e) * 2 + (pn & 1))) * 256 * DM * 2; u.fl = 3; }
        else { const int e = seg ? eb : ea; u.a = A + (size_t)pm * 256 * 512 * 2 + seg * (EFF * 2); u.b = W + ((size_t)(l * NE + e) * DM + pn * 256) * EFF * 2; u.fl = seg ? 2 : 1; }
    }
    __device__ __forceinline__ bool next(int i, Unit& u) const {
        const int MT = __builtin_amdgcn_readfirstlane(tpre[NCLS]);
        if (G == 256) {
            const int x = c & 7, j = c >> 3; const int cb0 = (x * MT) >> 3, cb1 = ((x + 1) * MT) >> 3; const int n4 = (cb1 - cb0 - 8) * 4;
            if (up) { int pm, pn;
                if (i == 0) { pm = cb0 + (j & 7); pn = j >> 3; }
                else if (i == 1 && j < n4) { pm = cb0 + 8 + (j >> 2); pn = j & 3; }
                else return false;
                fill(pm, pn, 0, u); return true; }
            const int jd = i >> 1, seg = i & 1; int pm, pn;
            if (j >= n4) { const int F = 32 - n4, e = (j - n4) + jd * F; if (e >= 32) return false; pm = cb0 + (e & 7); pn = e >> 3; }
            else { if (jd > 0) return false; pm = cb0 + 8 + (j >> 2); pn = j & 3; }
            fill(pm, pn, seg, u); return true;
        }
        const int E0 = G >> 2;
        const int R = (MT - E0) * 4;
        if (up) { int pm, pn;
            if (i == 0) { pm = (c & 7) + 8 * (c >> 5); pn = (c >> 3) & 3; }
            else { const int L2 = (i - 1) * G + c; if (L2 >= R) return false; pm = E0 + (L2 >> 2); pn = L2 & 3; }
            fill(pm, pn, 0, u); return true; }
        const int jd = i >> 1, seg = i & 1; int pm, pn;
        const int Rc = R < G ? R : G;
        if (c >= Rc) { const int F = G - Rc, e = (c - Rc) + jd * F; if (e >= G) return false; pm = (e & 7) + 8 * (e >> 5); pn = (e >> 3) & 3; }
        else { const int q = c + jd * G; if (q >= R) return false; pm = E0 + (q >> 2); pn = q & 3; }
        fill(pm, pn, seg, u); return true;
    }
    __device__ __forceinline__ unsigned aoff(const Unit& u, int r, int c, int lda) const {
        if (!up) return (unsigned)(r * lda + c) * 2u;
        int i = u.x1 + r; i = i < u.x2 ? i : u.x2 - 1; return (unsigned)ltok[(size_t)u.x0 * NT + i] * (unsigned)(DM * 2) + (unsigned)c * 2u; }
    __device__ __forceinline__ void a_ready(const Unit& u) const {
        if (up || !(u.fl & 1)) return;
        if (threadIdx.x < 64) { unsigned sp = 0;
            while ((unsigned)__builtin_amdgcn_readfirstlane((int)__hip_atomic_load(ucnt + u.pm, __ATOMIC_RELAXED, __HIP_MEMORY_SCOPE_AGENT)) < 32u) {
                __builtin_amdgcn_s_sleep(2);
                if ((++sp & 255u) == 0u) { if (__hip_atomic_load(tmo, __ATOMIC_RELAXED, __HIP_MEMORY_SCOPE_AGENT) != 0u) break; if (sp > (1u << 20)) { atomicAdd(tmo, 1u); break; } } }
            __builtin_amdgcn_fence(__ATOMIC_ACQUIRE, "agent");
            asm volatile("s_waitcnt vmcnt(0)" ::: "memory"); }
        asm volatile("" ::: "memory"); __builtin_amdgcn_s_barrier(); asm volatile("" ::: "memory");
    }
    __device__ __forceinline__ void done(const Unit& u, int lane) const {
        if (!up) return;
        asm volatile("s_waitcnt vmcnt(0)" ::: "memory");
        if (lane == 0) __hip_atomic_fetch_add(ucnt + u.pm, 1u, __ATOMIC_RELAXED, __HIP_MEMORY_SCOPE_AGENT);
    }
};
struct EpiMoeUp {
    static constexpr bool PERM = true; bf16* ACT; const f32x4* lw;
    __device__ __forceinline__ void mid(f32x4 (&)[2][2][4][2], const Unit&, int, int, int, int) const {}
    __device__ __forceinline__ void operator()(const f32x4 (&acc)[2][2][4][2], const Unit& u, int wr, int wc, int fr, int fq) const {
        const int col0 = (u.pn >> 1) * 256 + (u.pn & 1) * 128 + wc * 32 + 8 * fq;
        f32x4 lwq[8];
#pragma unroll
        for (int q = 0; q < 8; ++q) { int i = u.x1 + (q >> 2) * HALF + wr * 64 + (q & 3) * 16 + fr; i = i < u.x2 ? i : u.x2 - 1; lwq[q] = lw[(size_t)u.x0 * NT + i]; }
#pragma unroll
        for (int ai = 0; ai < 2; ++ai)
#pragma unroll
            for (int m = 0; m < 4; ++m) { const int r = ai * HALF + wr * 64 + m * 16 + fr;
                const f32x4 lwv = lwq[ai * 4 + m]; const float w = (u.pn >> 1) ? lwv[1] : lwv[0], rs = lwv[2];
                const f32x4 g0 = acc[ai][0][m][0], g1 = acc[ai][0][m][1], u0 = acc[ai][1][m][0], u1 = acc[ai][1][m][1]; float v[8];
#pragma unroll
                for (int j = 0; j < 4; ++j) { const float ga = g0[j] * rs, gb = g1[j] * rs; v[j] = ga * sigmoidf_(ga) * (u0[j] * rs) * w; v[4 + j] = gb * sigmoidf_(gb) * (u1[j] * rs) * w; }
                store16_wt(ACT + (size_t)(u.pm * BM + r) * 512 + col0, (u32x4){cvt_pk_bf16(v[0], v[1]), cvt_pk_bf16(v[2], v[3]), cvt_pk_bf16(v[4], v[5]), cvt_pk_bf16(v[6], v[7])}); }
    }
};
template <bool DRY> struct EpiMoeDown {
    static constexpr bool PERM = true; bf16* XB; const int* ltok; float* SS;
    __device__ __forceinline__ void mid(f32x4 (&)[2][2][4][2], const Unit&, int, int, int, int) const {}
    __device__ __forceinline__ void operator()(const f32x4 (&acc)[2][2][4][2], const Unit& u, int wr, int wc, int fr, int fq) const {
        const int col0 = u.pn * BM + wc * 32 + 8 * fq; const int lane = fr + 16 * fq;
        int tok[8];
#pragma unroll
        for (int q = 0; q < 8; ++q) { const int i = u.x1 + (q >> 2) * HALF + wr * 64 + (q & 3) * 16 + fr; tok[q] = ltok[(size_t)u.x0 * NT + (i < u.x2 ? i : u.x2 - 1)]; }
#pragma unroll
        for (int ai = 0; ai < 2; ++ai) { u32x4 xv[4][2];
#pragma unroll
            for (int m = 0; m < 4; ++m)
#pragma unroll
                for (int bj = 0; bj < 2; ++bj) xv[m][bj] = *(const u32x4*)(XB + (size_t)tok[ai * 4 + m] * DM + col0 + bj * HALF);
#pragma unroll
            for (int m = 0; m < 4; ++m) { const int i = u.x1 + ai * HALF + wr * 64 + m * 16 + fr; const bool ok = i < u.x2; const size_t ro = (size_t)tok[ai * 4 + m] * DM + col0;
                float ssq = 0.f;
#pragma unroll
                for (int bj = 0; bj < 2; ++bj) { float b[8]; unpack8(xv[m][bj], b); const f32x4 a0 = acc[ai][bj][m][0], a1 = acc[ai][bj][m][1];
                    if (!DRY) { b[0] += a0[0]; b[1] += a0[1]; b[2] += a0[2]; b[3] += a0[3]; b[4] += a1[0]; b[5] += a1[1]; b[6] += a1[2]; b[7] += a1[3]; }
                    const u32x4 o = (u32x4){cvt_pk_bf16(b[0], b[1]), cvt_pk_bf16(b[2], b[3]), cvt_pk_bf16(b[4], b[5]), cvt_pk_bf16(b[6], b[7])};
                    float rb[8]; unpack8(o, rb);
#pragma unroll
                    for (int e = 0; e < 8; ++e) ssq += rb[e] * rb[e];
                    if (ok) *(u32x4*)(XB + ro + bj * HALF) = o; }
                ssq += lane_xor(ssq, lane, 16); ssq += lane_xor(ssq, lane, 32);
                if (ok && fq == 0 && !DRY) SS[(size_t)tok[ai * 4 + m] * 16 + u.pn * 4 + wc] = ssq; }
            asm volatile("" ::: "memory"); }
    }
};
}


namespace attn {
typedef short bf16x8 __attribute__((ext_vector_type(8)));
typedef short s16x4 __attribute__((ext_vector_type(4)));
typedef float f32x16 __attribute__((ext_vector_type(16)));
__device__ __forceinline__ unsigned cvtpk(float lo, float hi) { typedef float f2 __attribute__((ext_vector_type(2))); typedef __bf16 b2 __attribute__((ext_vector_type(2))); f2 v = {lo, hi}; b2 b = __builtin_convertvector(v, b2); return __builtin_bit_cast(unsigned, b); }
__device__ __forceinline__ s16x4 vtr(const LAS unsigned char* p) { return __builtin_bit_cast(s16x4, __builtin_amdgcn_ds_read_tr16_b64_v4i16((LAS s16x4*)p)); }
constexpr int N_ITEMS = NB * NH * 48, N_STEPS = N_ITEMS / 2;
__device__ __forceinline__ void attn_phase(const int tid, LAS unsigned char* lds, const bf16* PROJ, bf16* OB, float* LSE, int G, int bx) {
    const int lane = tid & 63, wid = __builtin_amdgcn_readfirstlane(tid >> 6), half = wid >> 2, w = wid & 3, tid4 = tid & 255;
    const int r32 = lane & 31, hi = lane >> 5;
    LAS unsigned char* Kt = lds + half * 65536;
    LAS unsigned char* Vt = Kt + 32768;
    for (int step = bx; step < N_STEPS; step += G) {
        const int it = step * 2 + half; const int bh = it / 48, rem = it % 48, br = rem >> 4, tile = rem & 15;
        const int b = bh >> 3, h = bh & 7;
        const int dil = br == 0 ? 1 : (br == 1 ? 4 : 16); const int rr = br == 0 ? 0 : (br == 1 ? (tile & 3) : tile); const int blk = br == 0 ? tile : (br == 1 ? (tile >> 2) : 0);
        const bool first = (blk == 0);
        const size_t tokbase = (size_t)b * SEQ;
#pragma unroll
        for (int j = 0; j < 8; ++j) { const int row = j * 32 + (tid4 >> 3), ch = tid4 & 7; const bool valid = !(first && row < 128);
            u32x4 kv = (u32x4){0u, 0u, 0u, 0u}, vv = (u32x4){0u, 0u, 0u, 0u};
            if (valid) { const int pos = dil * (128 * (blk - 1) + row) + rr; const bf16* src = PROJ + (tokbase + pos) * INW + AW + h * HD + ch * 8; kv = *(const u32x4*)src; vv = *(const u32x4*)(src + AW); }
            *(LAS u32x4*)(Kt + ch * 4096 + ((row ^ ch) * 16)) = kv;
            *(LAS u32x4*)(Vt + (ch >> 2) * 16384 + row * 64 + (ch & 3) * 16) = vv; }
        const int qrow = 32 * w + r32; const int qpos = dil * (128 * blk + qrow) + rr;
        const bf16* qp = PROJ + (tokbase + qpos) * INW + h * HD + hi * 8;
        bf16x8 qf[4];
#pragma unroll
        for (int d0 = 0; d0 < 4; ++d0) qf[d0] = *(const bf16x8*)(qp + d0 * 16);
        __syncthreads();
        const int kt_lo = first ? (4 - w) : 0;
        f32x16 p[5];
#pragma unroll
        for (int kt = 0; kt < 5; ++kt) { p[kt] = f32x16{};
            if (kt >= kt_lo) {
#pragma unroll
                for (int d0 = 0; d0 < 4; ++d0) { const int ch = 2 * d0 + hi; const int kpos = 32 * w + 32 * kt + r32;
                    const bf16x8 kf = *(const LAS bf16x8*)(Kt + ch * 4096 + ((kpos ^ ch) * 16));
                    p[kt] = __builtin_amdgcn_mfma_f32_32x32x16_bf16(kf, qf[d0], p[kt], 0, 0, 0); } } }
        const float SC = 0.125f * 1.4426950408889634f;
        float mx = -INFINITY;
#pragma unroll
        for (int kt = 0; kt < 5; ++kt) if (kt >= kt_lo) {
#pragma unroll
            for (int r = 0; r < 16; ++r) { const int c = (r & 3) + 8 * (r >> 2) + 4 * hi; bool ok = true; if (kt == 0) ok = (c >= r32); if (kt == 4) ok = (c <= r32);
                const float sv = ok ? p[kt][r] * SC : -INFINITY; p[kt][r] = sv; mx = fmaxf(mx, sv); } }
        mx = fmaxf(mx, lane_xor(mx, lane, 32));
        float lsum = 0.f;
#pragma unroll
        for (int kt = 0; kt < 5; ++kt) if (kt >= kt_lo) {
#pragma unroll
            for (int r = 0; r < 16; ++r) { const float e = __builtin_amdgcn_exp2f(p[kt][r] - mx); p[kt][r] = e; lsum += e; } }
        lsum += lane_xor(lsum, lane, 32);
        f32x16 o[2]; o[0] = f32x16{}; o[1] = f32x16{};
        const LAS unsigned char* vbase = Vt + (32 * w + 4 * hi + ((lane & 15) >> 2)) * 64 + ((lane >> 4) & 1) * 32 + (lane & 3) * 8;
#pragma unroll
        for (int kt = 0; kt < 5; ++kt) if (kt >= kt_lo) {
#pragma unroll
            for (int ks = 0; ks < 2; ++ks) {
                u32x4 pw; pw.x = cvtpk(p[kt][8 * ks + 0], p[kt][8 * ks + 1]); pw.y = cvtpk(p[kt][8 * ks + 2], p[kt][8 * ks + 3]); pw.z = cvtpk(p[kt][8 * ks + 4], p[kt][8 * ks + 5]); pw.w = cvtpk(p[kt][8 * ks + 6], p[kt][8 * ks + 7]);
                const bf16x8 pf = __builtin_bit_cast(bf16x8, pw);
#pragma unroll
                for (int dh = 0; dh < 2; ++dh) { const LAS unsigned char* va = vbase + dh * 16384 + (32 * kt + 16 * ks) * 64;
                    const s16x4 lo = vtr(va), hi8 = vtr(va + 512);
                    const bf16x8 vf = (bf16x8){lo[0], lo[1], lo[2], lo[3], hi8[0], hi8[1], hi8[2], hi8[3]};
                    o[dh] = __builtin_amdgcn_mfma_f32_32x32x16_bf16(vf, pf, o[dh], 0, 0, 0); } } }
        const float inv = 1.f / lsum; const size_t tok = tokbase + qpos;
        bf16* op = OB + ((size_t)br * NT + tok) * AW + h * HD + 4 * hi;
#pragma unroll
        for (int dh = 0; dh < 2; ++dh)
#pragma unroll
            for (int g4 = 0; g4 < 4; ++g4) *(u32x2*)(op + 32 * dh + 8 * g4) = (u32x2){cvtpk(o[dh][4 * g4] * inv, o[dh][4 * g4 + 1] * inv), cvtpk(o[dh][4 * g4 + 2] * inv, o[dh][4 * g4 + 3] * inv)};
        if (hi == 0) LSE[((size_t)br * NT + tok) * NH + h] = (mx + __builtin_amdgcn_logf(lsum)) * 0.6931471805599453f;
        __syncthreads();
    }
}
}

namespace ssm {
typedef short bf16x8 __attribute__((ext_vector_type(8)));
__device__ __forceinline__ void ssm_phase(const int tid, LAS unsigned char* lds, unsigned char* ws, unsigned char* pj, int l, int G, int bx) {
    typedef float f32x2 __attribute__((ext_vector_type(2)));
    const int lane = tid & 63, wid = __builtin_amdgcn_readfirstlane(tid >> 6), nt4 = wid & 3, ih = wid >> 2;
    const bf16* UGM = (const bf16*)(ws + WS_UGM); bf16* YG = (bf16*)(ws + WS_YG); (void)pj;
    LAS float* Ef = (LAS float*)lds;
    LAS f32x2* Tot = (LAS f32x2*)(lds + 32768);
    LAS unsigned char* Kl = lds + 36864;
    for (int it = bx; it < NG * NB; it += G) {
        const int g = it % NG, b = it / NG, lg = l * NG + g;
        const bf16* Bb2 = (const bf16*)(ws + WS_BB2) + (size_t)lg * 128 * 32; const bf16* Ccm = (const bf16*)(ws + WS_CC) + (size_t)lg * 16 * 128;
        const unsigned char* Ktg = ws + WS_KTAB + (size_t)lg * 33 * 512; const float* Lams = (const float*)(ws + WS_LAMS) + (size_t)lg * 64 * 6;
        const int c = 16 * nt4 + (lane & 15), jj = lane >> 5, h0 = 8 * ((lane >> 4) & 1), q4 = lane >> 4;
        const u32x4 kt0 = *(const u32x4*)(Ktg + tid * 16), kt1 = *(const u32x4*)(Ktg + (tid + MKT) * 16); u32x4 kt2 = (u32x4){0u, 0u, 0u, 0u}; if (tid < 32) kt2 = *(const u32x4*)(Ktg + (tid + 2 * MKT) * 16);
        bf16x8 Uf[16];
        { const bf16* up = UGM + ((size_t)g * NT + (size_t)b * SEQ + (size_t)c * CL + jj) * 16 + h0;
#pragma unroll
          for (int ks = 0; ks < 16; ++ks) Uf[ks] = *(const bf16x8*)(up + (size_t)(2 * ks) * 16); }
        bf16x8 Af[4]; float l2r[4][2], l2i[4][2];
#pragma unroll
        for (int mi = 0; mi < 4; ++mi) { const int m = ih * 4 + mi; Af[mi] = *(const bf16x8*)(Bb2 + (size_t)(16 * m + (lane & 15)) * 32 + 8 * q4);
#pragma unroll
            for (int e = 0; e < 2; ++e) { const int p = 8 * m + 2 * q4 + e; l2r[mi][e] = Lams[p * 6 + 2]; l2i[mi][e] = Lams[p * 6 + 3]; } }
        const float sc_ar = Lams[(tid & 63) * 6 + 4], sc_ai = Lams[(tid & 63) * 6 + 5];
        *(LAS u32x4*)(Kl + tid * 16) = kt0; *(LAS u32x4*)(Kl + (tid + MKT) * 16) = kt1; if (tid < 32) *(LAS u32x4*)(Kl + (tid + 2 * MKT) * 16) = kt2;
        { f32x4 acc[4];
#pragma unroll
          for (int mi = 0; mi < 4; ++mi) acc[mi] = (f32x4){0.f, 0.f, 0.f, 0.f};
#pragma unroll
          for (int ks = 0; ks < 16; ++ks) {
#pragma unroll
              for (int mi = 0; mi < 4; ++mi) { f32x4 a = acc[mi];
                  if (ks > 0) a = (f32x4){l2r[mi][0] * a[0] - l2i[mi][0] * a[1], l2r[mi][0] * a[1] + l2i[mi][0] * a[0], l2r[mi][1] * a[2] - l2i[mi][1] * a[3], l2r[mi][1] * a[3] + l2i[mi][1] * a[2]};
                  acc[mi] = __builtin_amdgcn_mfma_f32_16x16x32_bf16(Af[mi], Uf[ks], a, 0, 0, 0); } }
#pragma unroll
          for (int mi = 0; mi < 4; ++mi) *(LAS f32x4*)(Ef + c * 128 + 16 * (ih * 4 + mi) + 4 * q4) = acc[mi]; }
        __syncthreads();
        { const int p = tid & 63, seg = tid >> 6; const float ar = sc_ar, ai = sc_ai;
          float lr[8], li[8]; float sr = 0.f, si = 0.f;
#pragma unroll
          for (int cc = 0; cc < 8; ++cc) { lr[cc] = sr; li[cc] = si; const f32x2 e = *(const LAS f32x2*)(Ef + (seg * 8 + cc) * 128 + 2 * p);
              const float nr = ar * sr - ai * si + e.x, ni = ar * si + ai * sr + e.y; sr = nr; si = ni; }
          Tot[seg * 64 + p] = (f32x2){sr, si};
          float a8r = ar, a8i = ai;
#pragma unroll
          for (int q = 0; q < 3; ++q) { const float tr = a8r * a8r - a8i * a8i, ti = 2.f * a8r * a8i; a8r = tr; a8i = ti; }
          __syncthreads();
          float cr = 0.f, ci = 0.f;
          for (int s2 = 0; s2 < seg; ++s2) { const f32x2 t = Tot[s2 * 64 + p]; const float nr = a8r * cr - a8i * ci + t.x, ni = a8r * ci + a8i * cr + t.y; cr = nr; ci = ni; }
          float pr = 1.f, pi = 0.f;
#pragma unroll
          for (int cc = 0; cc < 8; ++cc) { *(LAS f32x2*)(Ef + (seg * 8 + cc) * 128 + 2 * p) = (f32x2){lr[cc] + pr * cr - pi * ci, li[cc] + pr * ci + pi * cr};
              const float tr = pr * ar - pi * ai, ti = pr * ai + pi * ar; pr = tr; pi = ti; } }
        __syncthreads();
        { bf16x8 Cf[4]; float zr[4][4], zi[4][4], l2r[4][4], l2i[4][4];
#pragma unroll
          for (int k2 = 0; k2 < 4; ++k2) { Cf[k2] = *(const bf16x8*)(Ccm + (size_t)(lane & 15) * 128 + 32 * k2 + 8 * q4);
              const f32x4 s0 = *(const LAS f32x4*)(Ef + c * 128 + 32 * k2 + 8 * q4), s1 = *(const LAS f32x4*)(Ef + c * 128 + 32 * k2 + 8 * q4 + 4);
              const float sre[4] = {s0[0], s0[2], s1[0], s1[2]}, sim[4] = {s0[1], s0[3], s1[1], s1[3]};
#pragma unroll
              for (int e = 0; e < 4; ++e) { const int p = 16 * k2 + 4 * q4 + e; const float* lp = Lams + p * 6; l2r[k2][e] = lp[2]; l2i[k2][e] = lp[3];
                  const float fr_ = ih ? lp[2] : lp[0], fi_ = ih ? lp[3] : lp[1];
                  zr[k2][e] = fr_ * sre[e] - fi_ * sim[e]; zi[k2][e] = fr_ * sim[e] + fi_ * sre[e]; } }
          const LAS unsigned char* kbase = Kl + (lane & 15) * 32 + h0 * 2;
#pragma unroll
          for (int gq = 0; gq < 4; ++gq)
#pragma unroll 1
          for (int ii4 = 0; ii4 < 4; ++ii4) { const int ii = 4 * gq + ii4; const int i = 2 * ii + ih; f32x4 acc = (f32x4){0.f, 0.f, 0.f, 0.f};
#pragma unroll
              for (int k2 = 0; k2 < 4; ++k2) { u32x4 zw; zw.x = attn::cvtpk(zr[k2][0], zi[k2][0]); zw.y = attn::cvtpk(zr[k2][1], zi[k2][1]); zw.z = attn::cvtpk(zr[k2][2], zi[k2][2]); zw.w = attn::cvtpk(zr[k2][3], zi[k2][3]);
                  acc = __builtin_amdgcn_mfma_f32_16x16x32_bf16(Cf[k2], __builtin_bit_cast(bf16x8, zw), acc, 0, 0, 0);
#pragma unroll
                  for (int e = 0; e < 4; ++e) { const float nr = l2r[k2][e] * zr[k2][e] - l2i[k2][e] * zi[k2][e], ni = l2r[k2][e] * zi[k2][e] + l2i[k2][e] * zr[k2][e]; zr[k2][e] = nr; zi[k2][e] = ni; } }
              const LAS unsigned char* kp = kbase + (i - jj + 1) * 512;
#pragma unroll
              for (int ks = 0; ks < 4 * gq; ++ks) { const bf16x8 af = *(const LAS bf16x8*)(kp - ks * 1024); acc = __builtin_amdgcn_mfma_f32_16x16x32_bf16(af, Uf[ks], acc, 0, 0, 0); }
#pragma unroll
              for (int ks = 4 * gq; ks < 4 * gq + 4; ++ks) if (ks <= ii) { const bf16x8 af = *(const LAS bf16x8*)(kp - ks * 1024); acc = __builtin_amdgcn_mfma_f32_16x16x32_bf16(af, Uf[ks], acc, 0, 0, 0); }
              const size_t tok = (size_t)b * SEQ + (size_t)c * CL + i;
              *(u32x2*)(YG + ((size_t)g * NT + tok) * 16 + 4 * q4) = (u32x2){pk2(gelu_tanh(acc[0]), gelu_tanh(acc[1])), pk2(gelu_tanh(acc[2]), gelu_tanh(acc[3]))}; } }
        __syncthreads();
    }
}
}

#define XB_TMO      128
#define XB_XCNT(j)  (256  + 64 * (j))
#define XB_XSUB(j)  (1280 + 64 * (j))
#define XB_XGEN(j)  (2304 + 64 * (j))
#define XB_TOP      3328
#define XB_TOPGEN   3392
#define XCD_BAR_WORDS 3456
#define XB_SPIN_CAP (1u << 18)
__device__ __forceinline__ unsigned xb_ld(unsigned* p)              { return __hip_atomic_load(p, __ATOMIC_RELAXED, __HIP_MEMORY_SCOPE_AGENT); }
__device__ __forceinline__ unsigned xb_add(unsigned* p, unsigned v) { return __hip_atomic_fetch_add(p, v, __ATOMIC_RELAXED, __HIP_MEMORY_SCOPE_AGENT); }
__device__ __forceinline__ unsigned xb_xcc_id() { return (unsigned)__builtin_amdgcn_s_getreg((3 << 11) | 20) & 0xFu; }
#define XB_SPIN(cond, bar) do { unsigned _sp = 0; while (cond) { __builtin_amdgcn_s_sleep(1); \
    if ((++_sp & 255u) == 0u) { if (xb_ld(&(bar)[XB_TMO])) break; if (_sp > XB_SPIN_CAP) { atomicAdd(&(bar)[XB_TMO], 1u); break; } } } } while (0)
struct XcdBarrier { unsigned* bar; unsigned x; volatile LAS unsigned* st; };
__device__ __forceinline__ XcdBarrier xcd_barrier_post(unsigned* bar, volatile LAS unsigned* st) {
    XcdBarrier b; b.bar = bar; b.x = xb_xcc_id(); b.st = st;
    if (threadIdx.x == 0) (void)xb_add(&bar[XB_XCNT(b.x)], 1u);
    return b;
}
__device__ __forceinline__ void xcd_barrier_complete(unsigned* bar, unsigned x, unsigned& nloc, unsigned& nx) {
    const unsigned G = gridDim.x * gridDim.y * gridDim.z;
    unsigned sum, cnt, mine, sp = 0u;
    for (;;) {
        sum = 0u; cnt = 0u; mine = 0u;
#pragma unroll
        for (unsigned j = 0; j < 16; ++j) { const unsigned c = xb_ld(&bar[XB_XCNT(j)]); sum += c; cnt += (c > 0u) ? 1u : 0u; mine = (j == x) ? c : mine; }
        if (sum == G) break;
        __builtin_amdgcn_s_sleep(1);
        if ((++sp & 255u) == 0u) { if (xb_ld(&bar[XB_TMO])) break; if (sp > XB_SPIN_CAP) { atomicAdd(&bar[XB_TMO], 1u); break; } }
    }
    nloc = mine > 0u ? mine : 1u; nx = cnt > 0u ? cnt : 1u;
}
__device__ __forceinline__ void xcd_barrier(const XcdBarrier& b) {
    asm volatile("s_waitcnt vmcnt(0)" ::: "memory");
    __syncthreads();
    if (threadIdx.x == 0) {
        unsigned* bar = b.bar; unsigned bx_ = b.x;
        asm volatile("" : "+s"(bar), "+s"(bx_));
        __builtin_amdgcn_s_waitcnt(0);
        unsigned nloc = b.st[0], nx = b.st[1];
        if (nloc == 0u) { xcd_barrier_complete(bar, bx_, nloc, nx); b.st[0] = nloc; b.st[1] = nx; }
        const unsigned old = xb_add(&bar[XB_XSUB(bx_)], 1u);
        const unsigned gen = old / nloc;
        if (old + 1u == (gen + 1u) * nloc) {
            __builtin_amdgcn_fence(__ATOMIC_RELEASE, "agent");
            asm volatile("s_waitcnt vmcnt(0)" ::: "memory");
            const unsigned og = xb_add(&bar[XB_TOP], 1u);
            const unsigned tg = og / nx;
            if (og + 1u == (tg + 1u) * nx) xb_add(&bar[XB_TOPGEN], 1u);
            else XB_SPIN(xb_ld(&bar[XB_TOPGEN]) == tg, bar);
            __builtin_amdgcn_fence(__ATOMIC_ACQUIRE, "agent");
            xb_add(&bar[XB_XGEN(bx_)], 1u);
            asm volatile("s_waitcnt vmcnt(0)" ::: "memory");
        } else {
            XB_SPIN(xb_ld(&bar[XB_XGEN(bx_)]) == gen, bar);
            __builtin_amdgcn_fence(__ATOMIC_ACQUIRE, "agent");
            asm volatile("s_waitcnt vmcnt(0)" ::: "memory");
        }
    }
    __syncthreads();
}

__device__ __forceinline__ void norm_rows(const float* x, bf16* xn, float* outf, const float* g, int mode, int gw, int ngw, int lane) {
    for (int row = gw; row < NT; row += ngw) {
        const f32x4* xr = (const f32x4*)(x + (size_t)row * DM) + lane; f32x4 v[4]; float s = 0.f;
#pragma unroll
        for (int j = 0; j < 4; ++j) { v[j] = xr[64 * j]; s += v[j].x * v[j].x + v[j].y * v[j].y + v[j].z * v[j].z + v[j].w * v[j].w; }
        const float ssq = wave_sum(s, lane); const float rstd = 1.f / sqrtf(ssq * (1.f / DM) + RMS_EPS);
        if (mode == 0) { u32x2* o = (u32x2*)(xn + (size_t)row * DM) + lane;
#pragma unroll
            for (int j = 0; j < 4; ++j) o[64 * j] = (u32x2){pk2(v[j].x * rstd, v[j].y * rstd), pk2(v[j].z * rstd, v[j].w * rstd)};
        } else if (mode == 1) { u32x2* o = (u32x2*)(xn + (size_t)row * DM) + lane;
#pragma unroll
            for (int j = 0; j < 4; ++j) o[64 * j] = (u32x2){pk2(v[j].x, v[j].y), pk2(v[j].z, v[j].w)};
            if (lane < 16) outf[(size_t)row * 16 + lane] = lane == 0 ? ssq : 0.f;
        } else { f32x4* o = (f32x4*)(outf + (size_t)row * DM) + lane; const f32x4* gg = (const f32x4*)g + lane;
#pragma unroll
            for (int j = 0; j < 4; ++j) { const f32x4 gv = gg[64 * j]; o[64 * j] = (f32x4){v[j].x * rstd * gv.x, v[j].y * rstd * gv.y, v[j].z * rstd * gv.z, v[j].w * rstd * gv.w}; } }
    }
}

__device__ __forceinline__ void final_rows(const bf16* XB, float* out, const float* g, int gw, int ngw, int lane) {
    for (int row = gw; row < NT; row += ngw) { const u32x4* xr = (const u32x4*)(XB + (size_t)row * DM) + lane; float v[2][8]; float s = 0.f;
#pragma unroll
        for (int j = 0; j < 2; ++j) { unpack8(xr[64 * j], v[j]);
#pragma unroll
            for (int c = 0; c < 8; ++c) s += v[j][c] * v[j][c]; }
        const float rstd = 1.f / sqrtf(wave_sum(s, lane) * (1.f / DM) + RMS_EPS);
#pragma unroll
        for (int j = 0; j < 2; ++j) { const f32x4* gp = (const f32x4*)(g + 512 * j + 8 * lane); const f32x4 g0 = gp[0], g1 = gp[1]; f32x4* op = (f32x4*)(out + (size_t)row * DM + 512 * j + 8 * lane);
            op[0] = (f32x4){v[j][0] * rstd * g0[0], v[j][1] * rstd * g0[1], v[j][2] * rstd * g0[2], v[j][3] * rstd * g0[3]};
            op[1] = (f32x4){v[j][4] * rstd * g1[0], v[j][5] * rstd * g1[1], v[j][6] * rstd * g1[2], v[j][7] * rstd * g1[3]}; } }
}

#ifndef TL_MASK
#define TL_MASK 0ull
#endif
#define TL_K 4ull
#ifndef REP_ATTN
#define REP_ATTN 1
#endif
#ifndef REP_P0
#define REP_P0 1
#endif
#ifndef REP_NORM
#define REP_NORM 1
#endif
#ifndef REP_INPROJ
#define REP_INPROJ 1
#endif
#ifndef REP_GLU
#define REP_GLU 1
#endif
#ifndef REP_MIX
#define REP_MIX 1
#endif
#ifndef REP_OUT
#define REP_OUT 1
#endif
#ifndef REP_ROUTE
#define REP_ROUTE 1
#endif
#ifndef REP_MOEUP
#define REP_MOEUP 1
#endif
#ifndef REP_MOEDN
#define REP_MOEDN 1
#endif

#ifndef REP_SSM
#define REP_SSM 1
#endif
constexpr int MK_THREADS = 512, MK_LDS = 147456;
constexpr int CW_BAR = 4096;
constexpr int LDS_CTL_OFF = 131072, LDS_MISC_OFF = LDS_CTL_OFF + 512;
enum { ST_P0 = 0, ST_NORM = 1, ST_INPROJ = 2, ST_MIXERS = 3, ST_GLU = 4, ST_MIX = 5, ST_OUT = 6, ST_ROUTE = 7, ST_MOEUP = 8, ST_MOEDN = 9, ST_FINAL = 10 };
constexpr int PROG_LEN = 2 + 9 * NL;
__host__ __device__ __forceinline__ void prog_decode(int pi, int& step, int& layer) {
    if (pi == 0) { step = ST_P0; layer = 0; return; }
    if (pi == PROG_LEN - 1) { step = ST_FINAL; layer = NL - 1; return; }
    int q = pi - 1;
    if (q < 8) { layer = 0; step = ST_INPROJ + q; return; }
    q -= 8; layer = 1 + q / 9; step = ST_NORM + q % 9;
}
struct MkArgs { Ptrs P; int s_lo, s_hi, flags, pad1; };
#if defined(__HIP_DEVICE_COMPILE__)
#define CAS __attribute__((address_space(4)))
#else
#define CAS
#endif
__global__ void __launch_bounds__(MK_THREADS, 2) mk(MkArgs args) {
    extern __shared__ __attribute__((aligned(16))) unsigned char lds_raw[];
    LAS unsigned char* const lds0 = (LAS unsigned char*)lds_raw;
    const CAS MkArgs* ap = (const CAS MkArgs*)__builtin_amdgcn_kernarg_segment_ptr();
    const int G0 = gridDim.x; const int bx0 = blockIdx.x;
    const int tid0 = threadIdx.x;
    for (int u = tid0; u < (MK_LDS - LDS_CTL_OFF) / 4; u += MK_THREADS) ((LAS unsigned*)(lds0 + LDS_CTL_OFF))[u] = 0u;
    __syncthreads();
    const int lo = args.s_lo, hi = args.s_hi;
#if TL_MASK
    unsigned long long tl_prev = __builtin_amdgcn_s_memrealtime(), tl_sum = 0;
#endif
    XcdBarrier bar; bar.bar = (unsigned*)(args.P.ws + WS_CTL) + CW_BAR; bar.x = 0; bar.st = nullptr;
    if (hi - lo > 1) bar = xcd_barrier_post(bar.bar, (volatile LAS unsigned*)(lds0 + LDS_MISC_OFF));
#if TL_MASK
#define TL_MARK(k) { const unsigned long long tn_ = __builtin_amdgcn_s_memrealtime(); if ((TL_MASK >> (k)) & 1ull) tl_sum += tn_ - tl_prev; tl_prev = tn_; }
#else
#define TL_MARK(k)
#endif
#define STEP_BEGIN(k) if (lo <= (k) && (k) < hi) { int G = G0, bx = bx0, tid = tid0; unsigned ldsv = (unsigned)(uintptr_t)lds0; asm volatile("" : "+s"(ap), "+s"(G), "+s"(bx), "+v"(tid), "+s"(ldsv)); \
    LAS unsigned char* const lds = (LAS unsigned char*)(uintptr_t)ldsv; const int lane = tid & 63, wave = __builtin_amdgcn_readfirstlane(tid >> 6); (void)lane; const int gw = bx * 8 + wave, ngw = G * 8; (void)gw; (void)ngw; const Ptrs P = ap->P; unsigned char* const ws = P.ws; unsigned char* const pj = (unsigned char*)P.out; (void)pj; unsigned* const ctl = (unsigned*)(ws + WS_CTL); (void)ctl;
#define STEP_OFF(k) if (0) { const int G = 1, bx = 0, gw = 0, ngw = 1, tid = 0, lane = 0, wave = 0; LAS unsigned char* const lds = lds0; (void)lane; (void)wave; const Ptrs P{}; unsigned char* const ws = nullptr; unsigned char* const pj = nullptr; unsigned* const ctl = nullptr; (void)ctl;
#define STEP_END(k) if ((k) + 1 < hi) xcd_barrier(bar); TL_MARK(k) }
    STEP_BEGIN(0)
      for (int rep = 0; rep < REP_P0; ++rep) {
        for (int ti = bx; ti < 2 * NL * NG; ti += G) p0_tables_item(P, ti >> 1, ti & 1, (LAS float*)lds, tid, MK_THREADS);
        __syncthreads();
        p0_transposes(P, (LAS float*)lds + wave * 64 * 64, gw, ngw, lane);
        norm_rows(P.x, (bf16*)(ws + WS_XB), (float*)(ws + WS_SS1), nullptr, 1, gw, ngw, lane);
        __syncthreads(); }
    STEP_END(0)
#pragma unroll 1
    for (int l = 0; l < NL; ++l) {
        const int kb = 1 + 9 * l;
        STEP_BEGIN(kb + 1)
            LAS float* rtab = (LAS float*)(lds + LDS_CTL_OFF + 4096);
            pg8::InSched S{(const char*)(ws + WS_XB), (const char*)(ws + WS_WIN) + (size_t)l * INW * DM * 2, NT / 256, INW / 256, G, bx, (size_t)256 * DM * 2, (size_t)256 * DM * 2, (const float*)(ws + WS_SS1), rtab};
            pg8::EpiStoreBf16 E{(bf16*)(pj), INW, rtab, (bf16*)(ws + WS_UGM)};
            pg8::gemm_phase<pg8::EpiStoreBf16, pg8::InSched, false, true>(tid, lds, DM, DM, DM, S, E);
        STEP_END(kb + 1)
        STEP_BEGIN(kb + 2)
            for (int rep = 0; rep < REP_ATTN; ++rep) attn::attn_phase(tid, lds, (const bf16*)(pj), (bf16*)(ws + WS_OB), (float*)(ws + WS_LSE), G, bx);
            TL_MARK(40)
            for (int rep = 0; rep < REP_SSM; ++rep) ssm::ssm_phase(tid, lds, ws, pj, l, G, bx);
        STEP_END(kb + 2)
        STEP_BEGIN(kb + 3)
            { pg8::GluSched S{(const char*)(ws + WS_YG), (const char*)(ws + WS_WGLU) + (size_t)l * SW * SW * 2, NT / 256, SW / 256, G, bx};
              pg8::EpiGlu E{(bf16*)(ws + WS_AB) + AW, (const bf16*)(ws + WS_YG), DM, (float*)(ws + WS_SSG)};
              pg8::gemm_phase<pg8::EpiGlu, pg8::GluSched, false, true>(tid, lds, SW, SW, SW, S, E, (size_t)4 * NT * 32); }
            { const int nglu = (NT / 256) * (SW / 256); const bf16* OBp = (const bf16*)(ws + WS_OB); const float* LSEp = (const float*)(ws + WS_LSE); bf16* ABp = (bf16*)(ws + WS_AB);
              if (G == 2 * nglu) {
                  constexpr int NA = 128 * 8 * 14;
                  if (bx >= nglu) { const int w0 = (bx - nglu) * 8 + wave;
#pragma unroll 1
                      for (int q = 0; q < 3; ++q) mix_rows_attn<4>(w0 + q * 4096, 1024, lane, OBp, LSEp, ABp);
                      mix_rows_attn<2>(w0 + 12288, 1024, lane, OBp, LSEp, ABp); }
                  else mix_rows_attn<2>(NA + bx * 8 + wave, 1024, lane, OBp, LSEp, ABp);
              } else { const int mb = G > nglu ? bx - nglu : bx, nmb = G > nglu ? G - nglu : G;
                  if (mb >= 0) for (int row = mb * 8 + wave; row < NT; row += nmb * 8) mix_rows_attn<1>(row, 0, lane, OBp, LSEp, ABp); } }
        STEP_END(kb + 3)
        STEP_BEGIN(kb + 5)
            LAS float* rtab = (LAS float*)(lds + LDS_CTL_OFF + 4096);
            pg8::OutSched S{(const char*)(ws + WS_AB), (const char*)(ws + WS_WOUT) + (size_t)l * DM * DM * 2, G, bx, (const float*)(ws + WS_SSG), rtab};
            pg8::EpiResid E{(bf16*)(ws + WS_XB), DM, rtab};
            pg8::gemm_phase<pg8::EpiResid, pg8::OutSched, false, false>(tid, lds, DM, DM, SW, S, E);
        STEP_END(kb + 5)
        STEP_BEGIN(kb + 6)
            LAS f32x4* GW = (LAS f32x4*)lds; LAS int* lcnt = (LAS int*)(lds + 98304); LAS int* lbase = lcnt + 32; LAS int* lpart = lcnt + 64;
            if (tid < 32) lcnt[tid] = 0;
            route_build_lds(P, l, GW, tid);
            int* cnt2 = (int*)(ws + WS_CNT2) + (size_t)l * 1024 * 32;
            {
              { const bf16* XBp = (const bf16*)(ws + WS_XB); u32x4 nx[2][2];
#pragma unroll
                for (int q = 0; q < 2; ++q)
#pragma unroll
                    for (int j = 0; j < 2; ++j) nx[q][j] = *((const u32x4*)(XBp + (size_t)(gw + q * ngw) * DM) + lane + 64 * j);
#pragma unroll 1
                for (int r0 = gw; r0 < NT; r0 += 2 * ngw) { u32x4 cur[2][2];
#pragma unroll
                    for (int q = 0; q < 2; ++q)
#pragma unroll
                        for (int j = 0; j < 2; ++j) cur[q][j] = nx[q][j];
                    if (r0 + 2 * ngw < NT) {
#pragma unroll
                        for (int q = 0; q < 2; ++q)
#pragma unroll
                            for (int j = 0; j < 2; ++j) nx[q][j] = *((const u32x4*)(XBp + (size_t)(r0 + 2 * ngw + q * ngw) * DM) + lane + 64 * j); }
                    route_rows<2>(P, l, r0, ngw, lane, GW, cur, (unsigned*)(ws + WS_TROUTE), (f32x4*)(ws + WS_TW), lcnt); } }
              __syncthreads();
              if (tid < 32) cnt2[bx * 32 + tid] = lcnt[tid];
              xcd_barrier(bar);
              { const int c = tid >> 4, part = tid & 15; int sum = 0, tot = 0;
                for (int b0 = 0; b0 < G; b0 += 256) { int vv[16];
#pragma unroll
                    for (int q = 0; q < 16; ++q) { const int b2 = b0 + part + 16 * q; vv[q] = b2 < G ? __hip_atomic_load(cnt2 + b2 * 32 + c, __ATOMIC_RELAXED, __HIP_MEMORY_SCOPE_AGENT) : 0; }
#pragma unroll
                    for (int q = 0; q < 16; ++q) { const int b2 = b0 + part + 16 * q; tot += vv[q]; if (b2 < bx) sum += vv[q]; } }
                lpart[tid] = sum; lpart[512 + tid] = tot; }
              __syncthreads();
              if (tid < 32) { int sum = 0, tot = 0; for (int q = 0; q < 16; ++q) { sum += lpart[tid * 16 + q]; tot += lpart[512 + tid * 16 + q]; } lbase[tid] = sum; ((LAS int*)(lds + LDS_CTL_OFF))[32 + tid] = tot; }
              __syncthreads();
              pg8::moe_build_prefix_lds(tid, (LAS int*)(lds + LDS_CTL_OFF));
              { int* ltok = (int*)(ws + WS_LTOK); f32x4* lw = (f32x4*)(ws + WS_LW); const unsigned* troute = (const unsigned*)(ws + WS_TROUTE); const f32x4* tw = (const f32x4*)(ws + WS_TW);
#pragma unroll 1
                for (int rb = gw; rb < NT; rb += 64 * ngw) { const int row = rb + lane * ngw;
                    if (row < NT) { const unsigned rt = troute[row]; const int cls = (int)((rt >> 16) & 255u), slot = lbase[cls] + (int)(rt >> 24);
                        ltok[(size_t)cls * NT + slot] = row; lw[(size_t)cls * NT + slot] = tw[row]; } } } }
        STEP_END(kb + 6)
        STEP_BEGIN(kb + 7)
            LAS int* tpre = (LAS int*)(lds + LDS_CTL_OFF);
            unsigned* ucnt = ctl + CW_UCNT + l * 128; unsigned* tmo = ctl + CW_BAR + XB_TMO;
            { pg8::MoeSched S{tpre, (const int*)(ws + WS_LTOK), (const char*)(ws + WS_XB), (const char*)(ws + WS_WGU), G, bx, l, 1, ucnt, tmo};
              pg8::EpiMoeUp E{(bf16*)(pj), (const f32x4*)(ws + WS_LW)};
              pg8::gemm_phase<pg8::EpiMoeUp, pg8::MoeSched, true, true>(tid, lds, DM, DM, DM, S, E); }
            { pg8::MoeSched S{tpre, (const int*)(ws + WS_LTOK), (const char*)(pj), (const char*)(ws + WS_WD), G, bx, l, 0, ucnt, tmo};
              pg8::EpiMoeDown<false> E{(bf16*)(ws + WS_XB), (const int*)(ws + WS_LTOK), (float*)(ws + WS_SS1)};
              pg8::gemm_phase<pg8::EpiMoeDown<false>, pg8::MoeSched, false, true>(tid, lds, 512, EFF, EFF, S, E); }
        STEP_END(kb + 7)
    }
    STEP_BEGIN(1 + 9 * NL)
        final_rows((const bf16*)(ws + WS_XB), P.out, P.final_g, gw, ngw, lane);
    STEP_END(1 + 9 * NL)
#if TL_MASK
    if (bx0 == 0) { const unsigned long long t0_ = __builtin_amdgcn_s_memrealtime(); while (__builtin_amdgcn_s_memrealtime() - t0_ < TL_K * tl_sum) __builtin_amdgcn_s_sleep(8); }
#endif
#undef STEP_BEGIN
#undef STEP_OFF
#undef STEP_END
}

#ifndef MK_SPLIT
#define MK_SPLIT 0
#endif
extern "C" void kernel_launch(void* const* d_in, const int* in_sizes, int n_in, void* d_out, int out_size, void* d_ws, size_t ws_size, hipStream_t stream) {
    if (n_in != 24 || out_size != NT * DM || ws_size < WS_END) { fprintf(stderr, "kernel_launch: unexpected shapes n_in %d out %d ws %zu (need %zu)\n", n_in, out_size, ws_size, (size_t)WS_END); return; }
    static int grid = 0;
    if (grid == 0) {
        int dev = 0, cus = 0, per_cu = 0;
        if (hipFuncSetAttribute((const void*)mk, hipFuncAttributeMaxDynamicSharedMemorySize, MK_LDS) != hipSuccess) { fprintf(stderr, "kernel_launch: hipFuncSetAttribute failed\n"); grid = -1; return; }
        if (hipGetDevice(&dev) != hipSuccess || hipDeviceGetAttribute(&cus, hipDeviceAttributeMultiprocessorCount, dev) != hipSuccess) { fprintf(stderr, "kernel_launch: device query failed\n"); grid = -1; return; }
        if (hipOccupancyMaxActiveBlocksPerMultiprocessor(&per_cu, (const void*)mk, MK_THREADS, MK_LDS) != hipSuccess || per_cu < 1) { fprintf(stderr, "kernel_launch: occupancy query failed (%d)\n", per_cu); grid = -1; return; }
        grid = cus * per_cu;
        fprintf(stderr, "kernel_launch: %d CUs x %d blocks/CU -> grid %d\n", cus, per_cu, grid);
    }
    if (grid < 0) return;
    Ptrs P{};
    const float** pf = (const float**)&P;
    for (int i = 0; i < 24; ++i) pf[i] = (const float*)d_in[i];
    P.out = (float*)d_out; P.ws = (unsigned char*)d_ws;
    (void)hipMemsetAsync(P.ws + WS_CTL, 0, 65536, stream);
    MkArgs a{}; a.P = P;
#if MK_SPLIT
    for (int pi = 0; pi < PROG_LEN; ++pi) { a.s_lo = pi; a.s_hi = pi + 1; hipLaunchKernelGGL(mk, dim3(grid), dim3(MK_THREADS), MK_LDS, stream, a); }
#else
    a.s_lo = 0; a.s_hi = PROG_LEN;
    void* kargs[] = {&a};
    const hipError_t e = hipLaunchCooperativeKernel((const void*)mk, dim3(grid), dim3(MK_THREADS), kargs, MK_LDS, stream);
    if (e != hipSuccess) fprintf(stderr, "kernel_launch: cooperative launch failed: %s (grid %d)\n", hipGetErrorString(e), grid);
#endif
}
```
